# Optimizing an MI355X kernel written in HIP

```python
import jax, jax.numpy as jnp
from jax import lax
import numpy as np

D_MODEL = 1024
BATCH = 16
SEQ = 256
DEPTH = 2
DEC_BATCH = 2
DEC_SEQ = 2048
PAST_LEN = 256

GRID_W = 64
N_HEADS = 8
QK_NOPE = 64
QK_ROPE = 32
V_HEAD = 64
Q_LORA = 384
KV_LORA = 256
AXIS_ROPE = QK_ROPE // 2
ROPE_THETA = 10000.0
Q_BLOCK = 128
W_CONF = D_MODEL // 4
CONF_K = 31
W_SC = D_MODEL // 4
SC_K = 3
W_FN = D_MODEL // 4
FN_GROUPS = 4
FN_GROUP_W = W_FN // FN_GROUPS
N_BRANCH = 4
FF_HIDDEN = ((8 * D_MODEL // 3 + 255) // 256) * 256
EPS = 1e-6
OFF_QA = 0
OFF_KVA = OFF_QA + Q_LORA
OFF_CONF = OFF_KVA + KV_LORA + QK_ROPE
OFF_SC = OFF_CONF + 2 * W_CONF
OFF_FN = OFF_SC + 3 * W_SC
OFF_GATE = OFF_FN + W_FN
IN_COLS = OFF_GATE + N_BRANCH * D_MODEL

kernel_name = 'hybrid_mla_conv_fourier_diffusion_step'


def _rmsnorm(x, g):
    xf = x.astype(jnp.float32)
    y = xf * lax.rsqrt(jnp.mean(xf * xf, axis=-1, keepdims=True) + EPS)
    return (y * g.astype(jnp.float32)).astype(x.dtype)


def _layernorm(x, g, b):
    xf = x.astype(jnp.float32)
    mu = jnp.mean(xf, axis=-1, keepdims=True)
    var = jnp.mean(jnp.square(xf - mu), axis=-1, keepdims=True)
    y = (xf - mu) * lax.rsqrt(var + EPS)
    return (y * g.astype(jnp.float32) + b.astype(jnp.float32)).astype(x.dtype)


def _dwconv(x, w):
    k = w.shape[0]
    return lax.conv_general_dilated(
        x, w[:, None, :].astype(x.dtype), window_strides=(1,),
        padding=[(k // 2, k // 2)], dimension_numbers=('NWC', 'WIO', 'NWC'),
        feature_group_count=x.shape[-1])


def _axial_rope_tables(n_tokens):
    rows = n_tokens // GRID_W
    row_pos = jnp.repeat(jnp.arange(rows, dtype=jnp.float32), GRID_W)
    col_pos = jnp.tile(jnp.arange(GRID_W, dtype=jnp.float32), rows)
    inv = ROPE_THETA ** (-jnp.arange(0, AXIS_ROPE, 2, dtype=jnp.float32) / AXIS_ROPE)
    ang_r = row_pos[:, None] * inv
    ang_c = col_pos[:, None] * inv
    return (jnp.cos(ang_r), jnp.sin(ang_r), jnp.cos(ang_c), jnp.sin(ang_c))


def _rotate(x, cos, sin):
    half = x.shape[-1] // 2
    x1, x2 = x[..., :half], x[..., half:]
    cos = cos.astype(x.dtype)
    sin = sin.astype(x.dtype)
    return jnp.concatenate([x1 * cos - x2 * sin, x2 * cos + x1 * sin], axis=-1)


def _apply_axial_rope(x, tabs):
    cr, sr, cc, sc = tabs
    shape = (x.shape[1],) + (1,) * (x.ndim - 3) + (AXIS_ROPE // 2,)
    xr = _rotate(x[..., :AXIS_ROPE], cr.reshape(shape), sr.reshape(shape))
    xc = _rotate(x[..., AXIS_ROPE:], cc.reshape(shape), sc.reshape(shape))
    return jnp.concatenate([xr, xc], axis=-1)


def _attend(q, k, v):
    b, lq, h, dqk = q.shape
    scale = dqk ** -0.5
    nb = lq // Q_BLOCK
    qb = q.reshape(b, nb, Q_BLOCK, h, dqk).transpose(1, 0, 2, 3, 4)

    def one_block(qi):
        s = jnp.einsum('bqhd,bkhd->bhqk', qi, k, preferred_element_type=jnp.float32) * scale
        p = jax.nn.softmax(s, axis=-1).astype(v.dtype)
        return jnp.einsum('bhqk,bkhd->bqhd', p, v)

    o = lax.map(one_block, qb)
    return o.transpose(1, 0, 2, 3, 4).reshape(b, lq, h, v.shape[-1])


def _mla_keys(c_kv, k_rope, w_kvb):
    b, l, _ = c_kv.shape
    kv = (c_kv @ w_kvb).reshape(b, l, N_HEADS, QK_NOPE + V_HEAD)
    k = jnp.concatenate(
        [kv[..., :QK_NOPE], jnp.broadcast_to(k_rope[:, :, None, :], (b, l, N_HEADS, QK_ROPE))], axis=-1)
    return k, kv[..., QK_NOPE:]


def _fourier(u):
    b, l, _ = u.shape
    ug = u.reshape(b, l, FN_GROUPS, FN_GROUP_W).astype(jnp.float32)
    f = jnp.fft.fft2(ug, axes=(1, 3), norm='ortho').real
    return f.reshape(b, l, W_FN).astype(u.dtype)


def _token_mixers(h, lp, rope, ctx):
    b, l, _ = h.shape
    proj = h @ lp['w_in']
    q_a = proj[..., OFF_QA:OFF_KVA]
    c_kv = _rmsnorm(proj[..., OFF_KVA:OFF_KVA + KV_LORA], lp['g_kva'])
    k_rope = proj[..., OFF_KVA + KV_LORA:OFF_CONF]
    conf_in = proj[..., OFF_CONF:OFF_SC]
    sc_in = proj[..., OFF_SC:OFF_FN]
    fn_in = proj[..., OFF_FN:OFF_GATE]
    gates = jax.nn.sigmoid(proj[..., OFF_GATE:].reshape(b, l, N_BRANCH, D_MODEL))

    q = (_rmsnorm(q_a, lp['g_qa']) @ lp['w_qb']).reshape(b, l, N_HEADS, QK_NOPE + QK_ROPE)
    q_nope, q_rope = q[..., :QK_NOPE], q[..., QK_NOPE:]
    k_rope_pos = k_rope
    if rope is not None:
        q_rope = _apply_axial_rope(q_rope, rope)
        k_rope_pos = _apply_axial_rope(k_rope, rope)
    k, v = _mla_keys(c_kv, k_rope_pos, lp['w_kvb'])
    if ctx is not None:
        k_ctx, v_ctx = _mla_keys(ctx[0], ctx[1], lp['w_kvb'])
        k = jnp.concatenate([k_ctx, k], axis=1)
        v = jnp.concatenate([v_ctx, v], axis=1)
    o = _attend(jnp.concatenate([q_nope, q_rope], axis=-1), k, v)
    y_a = o.reshape(b, l, N_HEADS * V_HEAD) @ lp['w_o_mla']

    u = conf_in[..., :W_CONF] * jax.nn.sigmoid(conf_in[..., W_CONF:])
    u = _dwconv(u, lp['w_conf_dw']) + lp['b_conf_dw']
    u = jax.nn.silu(_layernorm(u, lp['g_conf_ln'], lp['b_conf_ln']))
    y_b = u @ lp['w_conf_pw']

    gb, gc, xs = jnp.split(sc_in, 3, axis=-1)
    y_c = (gb * _dwconv(gc * xs, lp['w_sc_conv'])) @ lp['w_sc_out']

    y_d = _fourier(fn_in) @ lp['w_fn']

    merged = (gates[..., 0, :] * y_a + gates[..., 1, :] * y_b
              + gates[..., 2, :] * y_c + gates[..., 3, :] * y_d)
    return merged @ lp['w_out'], (c_kv, k_rope)


def _swiglu(h, lp):
    return (jax.nn.silu(h @ lp['w_ffn_gate']) * (h @ lp['w_ffn_up'])) @ lp['w_ffn_down']


def _block(x, mod, lp, rope, ctx):
    sh1, sc1, g1, sh2, sc2, g2 = jnp.split(mod, 6, axis=-1)
    h = _rmsnorm(x, lp['g_norm1']) * (1 + sc1) + sh1
    y, ctx_kv = _token_mixers(h, lp, rope, ctx)
    x = x + g1 * y
    h = _rmsnorm(x, lp['g_norm2']) * (1 + sc2) + sh2
    x = x + g2 * _swiglu(h, lp)
    return x, ctx_kv


def setup_inputs(seed: int = 0) -> dict:
    key = jax.random.key(seed)
    ks = iter(jax.random.split(key, 40))

    def nrm(shape, scale):
        return jax.random.normal(next(ks), shape, jnp.float32) * scale

    def gain(shape):
        return 1.0 + nrm(shape, 0.02)

    d = D_MODEL
    return {
        'x_prompt': nrm((BATCH, SEQ, d), 1.0),
        'x_sample': nrm((DEC_BATCH, DEC_SEQ, d), 1.0),
        'cache_ckv': nrm((DEC_BATCH, DEPTH, PAST_LEN, KV_LORA), 1.0),
        'cache_krope': nrm((DEC_BATCH, DEPTH, PAST_LEN, QK_ROPE), 1.0),
        'c': nrm((DEC_BATCH, d), 1.0),
        'c_ctx': nrm((d,), 1.0),
        'w_ada': nrm((DEPTH, d, 6 * d), 0.5 * d ** -0.5),
        'b_ada': nrm((DEPTH, 6 * d), 0.01),
        'g_norm1': gain((DEPTH, d)),
        'g_norm2': gain((DEPTH, d)),
        'w_in': nrm((DEPTH, d, IN_COLS), d ** -0.5),
        'g_qa': gain((DEPTH, Q_LORA)),
        'w_qb': nrm((DEPTH, Q_LORA, N_HEADS * (QK_NOPE + QK_ROPE)), Q_LORA ** -0.5),
        'g_kva': gain((DEPTH, KV_LORA)),
        'w_kvb': nrm((DEPTH, KV_LORA, N_HEADS * (QK_NOPE + V_HEAD)), KV_LORA ** -0.5),
        'w_o_mla': nrm((DEPTH, N_HEADS * V_HEAD, d), (N_HEADS * V_HEAD) ** -0.5),
        'w_conf_dw': nrm((DEPTH, CONF_K, W_CONF), CONF_K ** -0.5),
        'b_conf_dw': nrm((DEPTH, W_CONF), 0.01),
        'g_conf_ln': gain((DEPTH, W_CONF)),
        'b_conf_ln': nrm((DEPTH, W_CONF), 0.01),
        'w_conf_pw': nrm((DEPTH, W_CONF, d), W_CONF ** -0.5),
        'w_sc_conv': nrm((DEPTH, SC_K, W_SC), SC_K ** -0.5),
        'w_sc_out': nrm((DEPTH, W_SC, d), W_SC ** -0.5),
        'w_fn': nrm((DEPTH, W_FN, d), W_FN ** -0.5),
        'w_out': nrm((DEPTH, d, d), d ** -0.5),
        'w_ffn_gate': nrm((DEPTH, d, FF_HIDDEN), d ** -0.5),
        'w_ffn_up': nrm((DEPTH, d, FF_HIDDEN), d ** -0.5),
        'w_ffn_down': nrm((DEPTH, FF_HIDDEN, d), FF_HIDDEN ** -0.5),
        'g_final': gain((d,)),
    }


def reference(x_prompt, x_sample, cache_ckv, cache_krope, c, c_ctx, w_ada, b_ada,
              g_norm1, g_norm2, w_in, g_qa, w_qb, g_kva, w_kvb, w_o_mla,
              w_conf_dw, b_conf_dw, g_conf_ln, b_conf_ln, w_conf_pw,
              w_sc_conv, w_sc_out, w_fn, w_out, w_ffn_gate, w_ffn_up, w_ffn_down, g_final):
    rope = _axial_rope_tables(x_sample.shape[1])
    xp = x_prompt
    xs = x_sample
    new_ckv = []
    new_krope = []
    for l in range(DEPTH):
        lp = {
            'g_norm1': g_norm1[l], 'g_norm2': g_norm2[l], 'w_in': w_in[l],
            'g_qa': g_qa[l], 'w_qb': w_qb[l], 'g_kva': g_kva[l], 'w_kvb': w_kvb[l],
            'w_o_mla': w_o_mla[l], 'w_conf_dw': w_conf_dw[l], 'b_conf_dw': b_conf_dw[l],
            'g_conf_ln': g_conf_ln[l], 'b_conf_ln': b_conf_ln[l], 'w_conf_pw': w_conf_pw[l],
            'w_sc_conv': w_sc_conv[l], 'w_sc_out': w_sc_out[l], 'w_fn': w_fn[l],
            'w_out': w_out[l], 'w_ffn_gate': w_ffn_gate[l], 'w_ffn_up': w_ffn_up[l],
            'w_ffn_down': w_ffn_down[l],
        }
        mod_ctx = (jax.nn.silu(c_ctx) @ w_ada[l] + b_ada[l])[None, None, :]
        mod_lat = (jax.nn.silu(c) @ w_ada[l] + b_ada[l])[:, None, :]
        xp, (ckv_l, krope_l) = _block(xp, mod_ctx, lp, None, None)
        new_ckv.append(ckv_l)
        new_krope.append(krope_l)
        xs, _ = _block(xs, mod_lat, lp, rope, (cache_ckv[:, l], cache_krope[:, l]))
    y_prompt = _rmsnorm(xp, g_final)
    y_sample = _rmsnorm(xs, g_final)
    ckv_out = jnp.stack(new_ckv, axis=1)
    krope_out = jnp.stack(new_krope, axis=1)
    return (y_prompt, y_sample, ckv_out, krope_out)
```

```cpp
#include <hip/hip_runtime.h>
#include <hip/hip_bf16.h>
#include <cstdio>
#include <cstdint>

#ifndef MK_N_LAUNCHES
#define MK_N_LAUNCHES 1
#endif

#define LAS __attribute__((address_space(3)))
#define GAS __attribute__((address_space(1)))
typedef unsigned short bf16_t;
typedef short bf16x8 __attribute__((ext_vector_type(8)));
typedef short s16x4 __attribute__((ext_vector_type(4)));
typedef float f32x4 __attribute__((ext_vector_type(4)));
typedef float f32x2 __attribute__((ext_vector_type(2)));
typedef float f32x16 __attribute__((ext_vector_type(16)));
typedef unsigned u32x4 __attribute__((ext_vector_type(4)));
typedef unsigned u32x2 __attribute__((ext_vector_type(2)));

constexpr int D = 1024, NCTX = 4096, NLAT = 4096, MROWS = 8192, DEPTH = 2;
constexpr int SEQ = 256, DEC_SEQ = 2048, PAST = 256, NBC = 16, NBL = 2;
constexpr int NH = 8, QKN = 64, QKR = 32, VH = 64, QL = 384, KVL = 256;
constexpr int IN_COLS = 6304, FF = 2816;
constexpr int OFF_KVA = 384, OFF_KR = 640, OFF_CONF = 672, OFF_SC = 1184, OFF_FN = 1952, OFF_GATE = 2208;
constexpr int PROJ_LD = 2464;
constexpr int WIN_N = 6656;
constexpr int KVROWS = 8704;
constexpr float EPS = 1e-6f;
constexpr float QSCALE = 0.10206207261596577f * 1.4426950408889634f;

constexpr size_t al256(size_t x) { return (x + 255) & ~(size_t)255; }
constexpr size_t WS_CTL = 0, CTL_ZERO_BYTES = 65536;
constexpr size_t WS_MOD = 65536;
constexpr size_t WS_ROPE = WS_MOD + al256(2 * 3 * 6144 * 4);
constexpr size_t WS_DFTL = WS_ROPE + 4096;
constexpr size_t WS_DFTC = WS_DFTL + (size_t)2048 * 4096 * 2;
constexpr size_t WS_W = WS_DFTC + (size_t)256 * 512 * 2;
constexpr size_t W_IN = 0;
constexpr size_t W_QB = W_IN + (size_t)WIN_N * 1024 * 2;
constexpr size_t W_KVB = W_QB + (size_t)768 * 384 * 2;
constexpr size_t W_O = W_KVB + (size_t)1024 * 256 * 2;
constexpr size_t W_CPW = W_O + (size_t)1024 * 512 * 2;
constexpr size_t W_SCO = W_CPW + (size_t)1024 * 256 * 2;
constexpr size_t W_FN = W_SCO + (size_t)1024 * 256 * 2;
constexpr size_t W_OUT = W_FN + (size_t)1024 * 256 * 2;
constexpr size_t W_GU = W_OUT + (size_t)1024 * 1024 * 2;
constexpr size_t W_DN = W_GU + (size_t)5632 * 1024 * 2;
constexpr size_t W_LAYER = W_DN + (size_t)1024 * 2816 * 2;
constexpr size_t WS_XN = WS_W + 2 * W_LAYER;
constexpr size_t XN_QN = 0, XN_CKV = XN_QN + (size_t)MROWS * 384 * 2, XN_KR = XN_CKV + (size_t)KVROWS * 256 * 2, XN_UC = XN_KR + (size_t)KVROWS * 32 * 2;
static_assert(XN_UC + (size_t)MROWS * 256 * 2 <= (size_t)MROWS * 1024 * 2, "XN overlay");
constexpr size_t WS_PROJ = WS_XN + (size_t)MROWS * 1024 * 2;
constexpr size_t PJ_Q = 0, PJ_KV = PJ_Q + (size_t)MROWS * 768 * 2, PJ_O = PJ_KV + (size_t)KVROWS * 1024 * 2;
static_assert(PJ_O + (size_t)MROWS * 512 * 2 <= (size_t)MROWS * PROJ_LD * 2, "PROJ overlay");
constexpr size_t WS_GATES = WS_PROJ + (size_t)MROWS * PROJ_LD * 2;
constexpr size_t WS_SC = WS_GATES + (size_t)MROWS * 4096 * 2;
constexpr size_t WS_PQL = WS_SC + (size_t)MROWS * 256 * 2;
constexpr size_t WS_PQC = WS_PQL + (size_t)2 * 256 * 4096 * 2;
constexpr size_t WS_F = WS_PQC + (size_t)16 * 256 * 512 * 2;
constexpr size_t WS_DFTP = WS_F + (size_t)MROWS * 256 * 2;
constexpr size_t WS_END = WS_DFTP + (size_t)2 * 8 * 2048 * 256 * 4;
static_assert(WS_END <= 268435456, "workspace map exceeds 256 MiB");

constexpr int RING_BYTES = 131072, MISC_OFF = RING_BYTES, LDS_BYTES = 147456;

__device__ __forceinline__ unsigned cvt_pk_bf16(float lo, float hi) { unsigned r; asm volatile("v_cvt_pk_bf16_f32 %0, %1, %2" : "=v"(r) : "v"(lo), "v"(hi)); return r; }
__device__ __forceinline__ float bf_lo(unsigned u) { return __uint_as_float(u << 16); }
__device__ __forceinline__ float bf_hi(unsigned u) { return __uint_as_float(u & 0xffff0000u); }
__device__ __forceinline__ float bf1(bf16_t u) { return __uint_as_float((unsigned)u << 16); }
__device__ __forceinline__ bf16_t f2bf(float f) { return (bf16_t)(cvt_pk_bf16(f, 0.f) & 0xffffu); }
__device__ __forceinline__ float sigmoidf_(float x) { return __builtin_amdgcn_rcpf(1.f + __expf(-x)); }
__device__ __forceinline__ float wave_sum(float v) {
#pragma unroll
    for (int o = 1; o < 64; o <<= 1) v += __shfl_xor(v, o);
    return v;
}
#define LDS_WAIT() asm volatile("s_waitcnt lgkmcnt(0)" ::: "memory")
#define VM_WAIT() asm volatile("s_waitcnt vmcnt(0)" ::: "memory")

namespace pg8 {
constexpr int BM = 256, BK = 64, HALF = 128, HTB = HALF * BK * 2, STAGE_BYTES = 8 * HTB;
__device__ __forceinline__ int lds_byte(int r, int c) { const int st = (r >> 4) * 2 + (c >> 5), rr = r & 15, cc = c & 31, ob = rr * 64 + cc * 2; return st * 1024 + (ob ^ (((ob >> 9) & 1) << 5)); }
__device__ __forceinline__ void stage_rc(int b, int& R, int& C) { const int st = b / 1024, sb = b % 1024, swz = sb ^ (((sb >> 9) & 1) << 5); R = (st >> 1) * 16 + swz / 64; C = (st & 1) * 32 + (swz % 64) / 2; }
__device__ __forceinline__ int perm32(int rho) { const int n = rho >> 4, i = rho & 15; return 8 * (i >> 2) + 4 * n + (i & 3); }

struct Unit { int pm, pn, z; };
struct Job {
    const char* A; const char* Bt; int lda, ldb, K; long a_lo, a_hi, b_lo, b_hi;
    int nM, nN, nZ;
    int kind;
    void* o0; void* o1; const void* p0; const void* p1; int ldc; long zso; int aux;
};
enum { EK_PROJ = 0, EK_Q, EK_BF16, EK_F32, EK_MERGE, EK_RESID, EK_SWIGLU };

struct Order {
    int nM, nN, nZ, nwg, G, c;
    __device__ __forceinline__ void init(const Job& j, int G_, int c_) { nM = j.nM; nN = j.nN; nZ = j.nZ; nwg = nM * nN * nZ; G = G_; c = c_; }
    __device__ __forceinline__ bool next(int i, Unit& u) const {
        const long L = (long)i * G + c; if (L >= nwg) return false;
        if (nZ > 1) { const int per = nM * nN; u.z = (int)L / per; const int r = (int)L % per; u.pn = r / nM; u.pm = r % nM; return true; }
        constexpr int NXCD = 8, WGM = 8;
        int wgid = (int)L; { const int q = nwg / NXCD, r = nwg % NXCD, xcd = wgid % NXCD, off = wgid / NXCD; wgid = (xcd < r ? xcd * (q + 1) : r * (q + 1) + (xcd - r) * q) + off; }
        const int nig = WGM * nN, gid = wgid / nig, fm = gid * WGM, gsz = (nM - fm) < WGM ? (nM - fm) : WGM;
        u.pm = fm + ((wgid % nig) % gsz); u.pn = (wgid % nig) / gsz; u.z = 0; return true;
    }
};

__device__ __forceinline__ void epilogue(const Job& J, const f32x4 (&acc)[2][2][4][2], const Unit& u, int wr, int wc, int fr, int fq) {
    const int row0 = u.pm * BM + wr * 64 + fr;
    const int cl = wc * 32 + 8 * fq;
    if (J.kind == EK_PROJ) {
        const bool isg = u.pn >= 10;
        bf16_t* base = isg ? (bf16_t*)J.o1 : (bf16_t*)J.o0; const int ldc = isg ? 4096 : PROJ_LD;
        const int col0 = (isg ? (u.pn - 10) * BM : u.pn * BM) + cl;
#pragma unroll
        for (int ai = 0; ai < 2; ++ai)
#pragma unroll
            for (int m = 0; m < 4; ++m) { bf16_t* rowp = base + (size_t)(row0 + ai * HALF + m * 16) * ldc + col0;
#pragma unroll
                for (int bj = 0; bj < 2; ++bj) { f32x4 v0 = acc[ai][bj][m][0], v1 = acc[ai][bj][m][1];
                    if (isg) {
#pragma unroll
                        for (int e = 0; e < 4; ++e) { v0[e] = sigmoidf_(v0[e]); v1[e] = sigmoidf_(v1[e]); } }
                    u32x4 w; w.x = cvt_pk_bf16(v0[0], v0[1]); w.y = cvt_pk_bf16(v0[2], v0[3]); w.z = cvt_pk_bf16(v1[0], v1[1]); w.w = cvt_pk_bf16(v1[2], v1[3]);
                    if (isg || col0 + bj * HALF + 8 <= PROJ_LD) *(u32x4*)(rowp + bj * HALF) = w; } }
    } else if (J.kind == EK_Q) {
        bf16_t* Q = (bf16_t*)J.o0; const float* rope = (const float*)J.p0; const bool lat = u.pm >= 16;
#pragma unroll
        for (int bj = 0; bj < 2; ++bj) {
            const int G = 8 * u.pn + 4 * bj + wc; const bool isrope = lat && (G % 3 == 2);
#pragma unroll
            for (int ai = 0; ai < 2; ++ai)
#pragma unroll
                for (int m = 0; m < 4; ++m) { const int row = row0 + ai * HALF + m * 16;
                    float v[8];
#pragma unroll
                    for (int e = 0; e < 4; ++e) { v[e] = acc[ai][bj][m][0][e] * QSCALE; v[4 + e] = acc[ai][bj][m][1][e] * QSCALE; }
                    if (isrope) { const int t = (row - NCTX) & (DEC_SEQ - 1); const int pos = (fq < 2) ? (t >> 6) : (t & 63);
                        const f32x4* cs = (const f32x4*)(rope + pos * 16);
                        const f32x4 c0 = cs[0], c1 = cs[1], c2 = cs[2], c3 = cs[3];
                        const float cc[8] = {c0[0], c0[2], c1[0], c1[2], c2[0], c2[2], c3[0], c3[2]}, ss[8] = {c0[1], c0[3], c1[1], c1[3], c2[1], c2[3], c3[1], c3[3]};
#pragma unroll
                        for (int e = 0; e < 8; ++e) { const float p = __shfl_xor(v[e], 16); v[e] = (fq & 1) ? (v[e] * cc[e] + p * ss[e]) : (v[e] * cc[e] - p * ss[e]); } }
                    u32x4 w; w.x = cvt_pk_bf16(v[0], v[1]); w.y = cvt_pk_bf16(v[2], v[3]); w.z = cvt_pk_bf16(v[4], v[5]); w.w = cvt_pk_bf16(v[6], v[7]);
                    *(u32x4*)(Q + (size_t)row * 768 + u.pn * BM + bj * HALF + cl) = w; } }
    } else if (J.kind == EK_BF16) {
        bf16_t* O = (bf16_t*)J.o0 + (size_t)u.z * J.zso;
#pragma unroll
        for (int ai = 0; ai < 2; ++ai)
#pragma unroll
            for (int m = 0; m < 4; ++m) { bf16_t* rowp = O + (size_t)(row0 + ai * HALF + m * 16) * J.ldc + u.pn * BM + cl;
#pragma unroll
                for (int bj = 0; bj < 2; ++bj) { const f32x4 v0 = acc[ai][bj][m][0], v1 = acc[ai][bj][m][1];
                    u32x4 w; w.x = cvt_pk_bf16(v0[0], v0[1]); w.y = cvt_pk_bf16(v0[2], v0[3]); w.z = cvt_pk_bf16(v1[0], v1[1]); w.w = cvt_pk_bf16(v1[2], v1[3]);
                    *(u32x4*)(rowp + bj * HALF) = w; } }
    } else if (J.kind == EK_F32) {
        float* O = (float*)J.o0 + (size_t)u.z * J.zso;
#pragma unroll
        for (int ai = 0; ai < 2; ++ai)
#pragma unroll
            for (int m = 0; m < 4; ++m) { float* rowp = O + (size_t)(row0 + ai * HALF + m * 16) * J.ldc + u.pn * BM + cl;
#pragma unroll
                for (int bj = 0; bj < 2; ++bj) { *(f32x4*)(rowp + bj * HALF) = acc[ai][bj][m][0]; *(f32x4*)(rowp + bj * HALF + 4) = acc[ai][bj][m][1]; } }
    } else if (J.kind == EK_MERGE) {
        const bf16_t* gates = (const bf16_t*)J.p0 + J.aux * 1024; float* M = (float*)J.o0; bf16_t* MB = (bf16_t*)J.o1;
#pragma unroll
        for (int ai = 0; ai < 2; ++ai)
#pragma unroll
            for (int m = 0; m < 4; ++m) { const size_t row = (size_t)(row0 + ai * HALF + m * 16);
#pragma unroll
                for (int bj = 0; bj < 2; ++bj) { const int col = u.pn * BM + bj * HALF + cl;
                    const u32x4 g = *(const u32x4*)(gates + row * 4096 + col);
                    f32x4 v0 = acc[ai][bj][m][0], v1 = acc[ai][bj][m][1];
                    v0[0] *= bf_lo(g.x); v0[1] *= bf_hi(g.x); v0[2] *= bf_lo(g.y); v0[3] *= bf_hi(g.y); v1[0] *= bf_lo(g.z); v1[1] *= bf_hi(g.z); v1[2] *= bf_lo(g.w); v1[3] *= bf_hi(g.w);
                    float* mp = M + row * 1024 + col;
                    if (J.aux > 0) { v0 += *(const f32x4*)mp; v1 += *(const f32x4*)(mp + 4); }
                    if (J.aux < 3) { *(f32x4*)mp = v0; *(f32x4*)(mp + 4) = v1; }
                    else { u32x4 w; w.x = cvt_pk_bf16(v0[0], v0[1]); w.y = cvt_pk_bf16(v0[2], v0[3]); w.z = cvt_pk_bf16(v1[0], v1[1]); w.w = cvt_pk_bf16(v1[2], v1[3]); *(u32x4*)(MB + row * 1024 + col) = w; } } }
    } else if (J.kind == EK_RESID) {
        float* X = (float*)J.o0; const int mi = u.pm < 16 ? 0 : (u.pm < 24 ? 1 : 2); const float* gv = (const float*)J.p0 + mi * 6144 + J.aux;
#pragma unroll
        for (int bj = 0; bj < 2; ++bj) { const int col = u.pn * BM + bj * HALF + cl; const f32x4 g0 = *(const f32x4*)(gv + col), g1 = *(const f32x4*)(gv + col + 4);
#pragma unroll
            for (int ai = 0; ai < 2; ++ai)
#pragma unroll
                for (int m = 0; m < 4; ++m) { float* xp = X + (size_t)(row0 + ai * HALF + m * 16) * 1024 + col;
                    const f32x4 a = *(const f32x4*)xp, b = *(const f32x4*)(xp + 4);
                    *(f32x4*)xp = a + g0 * acc[ai][bj][m][0]; *(f32x4*)(xp + 4) = b + g1 * acc[ai][bj][m][1]; } }
    } else {
        bf16_t* ACT = (bf16_t*)J.o0;
#pragma unroll
        for (int ai = 0; ai < 2; ++ai)
#pragma unroll
            for (int m = 0; m < 4; ++m) { f32x4 v0, v1;
#pragma unroll
                for (int e = 0; e < 4; ++e) { const float g0 = acc[ai][0][m][0][e], g1 = acc[ai][0][m][1][e]; v0[e] = g0 * sigmoidf_(g0) * acc[ai][1][m][0][e]; v1[e] = g1 * sigmoidf_(g1) * acc[ai][1][m][1][e]; }
                u32x4 w; w.x = cvt_pk_bf16(v0[0], v0[1]); w.y = cvt_pk_bf16(v0[2], v0[3]); w.z = cvt_pk_bf16(v1[0], v1[1]); w.w = cvt_pk_bf16(v1[2], v1[3]);
                *(u32x4*)(ACT + (size_t)(row0 + ai * HALF + m * 16) * FF + u.pn * HALF + cl) = w; }
    }
}

__device__ __forceinline__ void gemm_phase(LAS unsigned char* lds, const Job& g, const Order& S, const int tid) {
    const int wid = __builtin_amdgcn_readfirstlane(tid >> 6), lane = tid & 63, wr = wid >> 2, wc = wid & 3, fr = lane & 15, fq = lane >> 4;
    const int K = g.K, nt = K / BK;
    unsigned voffA[2], voffB[2];
#pragma unroll
    for (int i = 0; i < 2; ++i) { int R, C; stage_rc(tid * 16 + i * 8192, R, C); const int Rb = (R & ~31) + perm32(R & 31);
        voffA[i] = (unsigned)(R * g.lda + C) * 2u; voffB[i] = (unsigned)(Rb * g.ldb + C) * 2u; }
    const size_t kstep = (size_t)(BK * 2);
    const size_t hstepA = (size_t)HALF * g.lda * 2, hstepB = (size_t)HALF * g.ldb * 2;
    const size_t tstepA = 2 * hstepA, tstepB = 2 * hstepB;
    const unsigned ldsw = (unsigned)wid * 1024u;
    const int aoff = lds_byte(wr * 64 + fr, fq * 8), boff = lds_byte(wc * 32 + fr, fq * 8);
#define PG8_SA(b, h) (((b) * 2 + (h)) * HTB)
#define PG8_SB(b, h) ((4 + (b) * 2 + (h)) * HTB)
#define PG8_STAGE(bufoff, gbase, voff) do { _Pragma("unroll") for (int _i = 0; _i < 2; ++_i) \
        __builtin_amdgcn_global_load_lds((const unsigned*)((const char*)(gbase) + (voff)[_i]), (LAS unsigned*)(lds + (bufoff) + ldsw + _i * 8192), 16, 0, 0); } while (0)
#define PG8_LDA(dst, b, h) do { _Pragma("unroll") for (int m = 0; m < 4; ++m) _Pragma("unroll") for (int k = 0; k < 2; ++k) dst[m][k] = *(const LAS bf16x8*)(lds + PG8_SA(b, h) + aoff + m * 2048 + k * 1024); } while (0)
#define PG8_LDB(dst, b, h) do { _Pragma("unroll") for (int n = 0; n < 2; ++n) _Pragma("unroll") for (int k = 0; k < 2; ++k) dst[n][k] = *(const LAS bf16x8*)(lds + PG8_SB(b, h) + boff + n * 2048 + k * 1024); } while (0)
#define PG8_MMA(ai, bj, At, Bt) do { __builtin_amdgcn_s_setprio(1); _Pragma("unroll") for (int m = 0; m < 4; ++m) _Pragma("unroll") for (int n = 0; n < 2; ++n) _Pragma("unroll") for (int k = 0; k < 2; ++k) \
        acc[ai][bj][m][n] = __builtin_amdgcn_mfma_f32_16x16x32_bf16(Bt[n][k], At[m][k], acc[ai][bj][m][n], 0, 0, 0); __builtin_amdgcn_s_setprio(0); } while (0)
#define PG8_WAIT_V(n) asm volatile("s_waitcnt vmcnt(" #n ")" ::: "memory")
#define PG8_WAIT_L(n) asm volatile("s_waitcnt lgkmcnt(" #n ")" ::: "memory")
#define PG8_BAR __builtin_amdgcn_s_barrier()
#define PG8_SCHED __builtin_amdgcn_sched_barrier(0)
#define PG8_UA(u) (g.A + (size_t)((u).z & 7) * g.a_lo + (size_t)((u).z >> 3) * g.a_hi + (size_t)(u).pm * tstepA)
#define PG8_UB(u) (g.Bt + (size_t)((u).z & 7) * g.b_lo + (size_t)((u).z >> 3) * g.b_hi + (size_t)(u).pn * tstepB)
    Unit cur, nxt; int ui = 0;
    if (!S.next(0, cur)) return;
    f32x4 acc[2][2][4][2];
#pragma unroll
    for (int a = 0; a < 2; ++a)
#pragma unroll
        for (int b = 0; b < 2; ++b)
#pragma unroll
            for (int m = 0; m < 4; ++m)
#pragma unroll
                for (int n = 0; n < 2; ++n) acc[a][b][m][n] = (f32x4){0.f, 0.f, 0.f, 0.f};
    bf16x8 At[4][2], B0[2][2], B1[2][2];
    const char* cA = PG8_UA(cur); const char* cB = PG8_UB(cur);
    PG8_STAGE(PG8_SB(0, 0), cB, voffB); PG8_STAGE(PG8_SB(0, 1), cB + hstepB, voffB); PG8_STAGE(PG8_SA(0, 0), cA, voffA); PG8_STAGE(PG8_SA(0, 1), cA + hstepA, voffA);
    if (wr == 1) PG8_BAR;
    PG8_WAIT_V(2); PG8_BAR;
    PG8_STAGE(PG8_SB(1, 0), cB + kstep, voffB); PG8_STAGE(PG8_SA(1, 0), cA + kstep, voffA); PG8_STAGE(PG8_SB(1, 1), cB + hstepB + kstep, voffB);
    PG8_WAIT_V(6); PG8_BAR;
    for (;;) {
        const bool has_next = S.next(ui + 1, nxt);
        const char* nA = has_next ? PG8_UA(nxt) : cA; const char* nB = has_next ? PG8_UB(nxt) : cB;
        for (int t = 0; t < nt; t += 2) {
            const bool last = (t == nt - 2);
            const char* a1 = cA + (size_t)(t + 1) * kstep;
            const char* a2 = last ? nA : cA + (size_t)(t + 2) * kstep; const char* b2 = last ? nB : cB + (size_t)(t + 2) * kstep;
            const char* a3 = a2 + kstep; const char* b3 = b2 + kstep;
            PG8_LDB(B0, 0, 0); PG8_LDB(B1, 0, 1); PG8_SCHED; PG8_LDA(At, 0, 0); PG8_STAGE(PG8_SA(1, 1), a1 + hstepA, voffA);
            PG8_WAIT_V(8); PG8_WAIT_L(0); PG8_BAR; PG8_MMA(0, 0, At, B0); PG8_MMA(0, 1, At, B1); PG8_BAR; PG8_SCHED;
            PG8_LDA(At, 0, 1); PG8_STAGE(PG8_SB(0, 0), b2, voffB); PG8_STAGE(PG8_SB(0, 1), b2 + hstepB, voffB); PG8_STAGE(PG8_SA(0, 0), a2, voffA);
            PG8_WAIT_V(8); PG8_WAIT_L(0); PG8_BAR; PG8_MMA(1, 0, At, B0); PG8_MMA(1, 1, At, B1); PG8_BAR; PG8_SCHED;
            PG8_LDB(B0, 1, 0); PG8_LDB(B1, 1, 1); PG8_SCHED; PG8_LDA(At, 1, 0); PG8_STAGE(PG8_SA(0, 1), a2 + hstepA, voffA);
            PG8_WAIT_V(8); PG8_WAIT_L(0); PG8_BAR; PG8_MMA(0, 0, At, B0); PG8_MMA(0, 1, At, B1); PG8_BAR; PG8_SCHED;
            PG8_LDA(At, 1, 1); PG8_STAGE(PG8_SB(1, 0), b3, voffB); PG8_STAGE(PG8_SB(1, 1), b3 + hstepB, voffB); PG8_STAGE(PG8_SA(1, 0), a3, voffA);
            PG8_WAIT_V(8); PG8_WAIT_L(0); PG8_BAR; PG8_MMA(1, 0, At, B0); PG8_MMA(1, 1, At, B1); PG8_BAR; PG8_SCHED;
        }
        if (wr == 0) PG8_BAR;
        epilogue(g, acc, cur, wr, wc, fr, fq);
        if (!has_next) break;
#pragma unroll
        for (int a = 0; a < 2; ++a)
#pragma unroll
            for (int b = 0; b < 2; ++b)
#pragma unroll
                for (int m = 0; m < 4; ++m)
#pragma unroll
                    for (int n = 0; n < 2; ++n) acc[a][b][m][n] = (f32x4){0.f, 0.f, 0.f, 0.f};
        cur = nxt; cA = nA; cB = nB; ++ui;
        if (wr == 1) PG8_BAR;
    }
    PG8_WAIT_V(0);
    PG8_BAR;
#undef PG8_SA
#undef PG8_SB
#undef PG8_STAGE
#undef PG8_LDA
#undef PG8_LDB
#undef PG8_MMA
#undef PG8_WAIT_V
#undef PG8_WAIT_L
#undef PG8_BAR
#undef PG8_SCHED
#undef PG8_UA
#undef PG8_UB
}
}

namespace attn {
constexpr int KSLOT = 12288, VSLOT = 8192, BUFB = 2 * KSLOT + 2 * VSLOT;
constexpr int LDS_WS = 2 * BUFB;
constexpr int LDS_CM = LDS_WS + 2048;
constexpr int LDS_CL = LDS_CM + 1024;
constexpr int LDS_OST = LDS_CL + 512;
constexpr int LDS_END = LDS_OST + 8 * 4096;
static_assert(LDS_END <= RING_BYTES, "attention LDS");
__device__ __forceinline__ int crow(int r, int hi) { return (r & 3) + 8 * (r >> 2) + 4 * hi; }
__device__ __forceinline__ void glds16(const void* gsrc, unsigned lds_dst) { unsigned keep;
    asm volatile("s_mov_b32 %0, m0\n\ts_mov_b32 m0, %2\n\ts_nop 0\n\tglobal_load_lds_dwordx4 %1, off\n\ts_mov_b32 m0, %0" : "=&s"(keep) : "v"(gsrc), "s"(lds_dst) : "memory"); }
typedef __bf16 bf16x2_t __attribute__((ext_vector_type(2)));
__device__ __forceinline__ unsigned cvtpk_s(float lo, float hi) { f32x2 v = {lo, hi}; bf16x2_t b = __builtin_convertvector(v, bf16x2_t); return __builtin_bit_cast(unsigned, b); }
typedef LAS const char* lds_cptr;
typedef short v4i16_t __attribute__((ext_vector_type(4)));
__device__ __forceinline__ s16x4 vtr(lds_cptr p) { return __builtin_bit_cast(s16x4, __builtin_amdgcn_ds_read_tr16_b64_v4i16((LAS v4i16_t*)p)); }
__device__ __forceinline__ float swapmax(float m) { auto rr = __builtin_amdgcn_permlane32_swap(__float_as_uint(m), __float_as_uint(m), false, false); return fmaxf(__uint_as_float(rr[0]), __uint_as_float(rr[1])); }
__device__ __forceinline__ float swapsum(float m) { auto rr = __builtin_amdgcn_permlane32_swap(__float_as_uint(m), __float_as_uint(m), false, false); return __uint_as_float(rr[0]) + __uint_as_float(rr[1]); }

struct Tensors { const bf16_t* Q; const bf16_t* KV; const bf16_t* KR; bf16_t* O; };

__device__ __forceinline__ void dma_step(const Tensors& T, int krow0, int h, unsigned ldsbuf, int wid, int lane) {
#pragma unroll
    for (int i = 0; i < 5; ++i) {
        const int p = wid + 8 * i;
        const void* src; unsigned dst;
        if (p < 24) { const int j = p / 12, c = p % 12; const int row = krow0 + j * 64 + lane;
            src = (c < 8) ? (const void*)(T.KV + (size_t)row * 1024 + h * 128 + c * 8) : (const void*)(T.KR + (size_t)row * 32 + (c - 8) * 8);
            dst = ldsbuf + j * KSLOT + c * 1024; }
        else { const int pv = p - 24, j = pv >> 3, q = pv & 7; const int row = krow0 + j * 64 + 16 * (q & 3) + (lane >> 2);
            src = (const void*)(T.KV + (size_t)row * 1024 + h * 128 + 64 + (q >> 2) * 32 + (lane & 3) * 8);
            dst = ldsbuf + 2 * KSLOT + j * VSLOT + q * 1024; }
        glds16(src, (unsigned)__builtin_amdgcn_readfirstlane(dst));
    }
}

__device__ __forceinline__ void unit(const Tensors& T, int qrow0, int krow0, int nsteps, int h, char* shm, const int tid) {
    const int lane = tid & 63, r32 = lane & 31, hi = lane >> 5; const int wid = __builtin_amdgcn_readfirstlane(tid >> 6);
    const int qb = wid & 3, kh = wid >> 2;
    const unsigned lds0 = (unsigned)(uintptr_t)shm;
    float* wsf = (float*)(shm + LDS_WS) + wid * 64;
    dma_step(T, krow0, h, lds0, wid, lane);
    const bf16_t* Qw = T.Q + (size_t)(qrow0 + qb * 32 + r32) * 768 + h * 96 + hi * 8;
    bf16x8 qr[6];
#pragma unroll
    for (int d0 = 0; d0 < 6; ++d0) qr[d0] = *(const bf16x8*)(Qw + d0 * 16);
    float mhat = 0.f, l_reg = 0.f; f32x16 o[2]; o[0] = f32x16{}; o[1] = f32x16{}; f32x16 negm = f32x16{};
    const lds_cptr shm3 = (lds_cptr)shm;
    for (int s = 0; s < nsteps; ++s) {
        asm volatile("s_waitcnt vmcnt(0)" ::: "memory"); __builtin_amdgcn_s_barrier(); asm volatile("" ::: "memory");
        if (s + 1 < nsteps) dma_step(T, krow0 + (s + 1) * 128, h, lds0 + ((s + 1) & 1) * BUFB, wid, lane);
        const int bufo = (s & 1) * BUFB;
        const lds_cptr kp = shm3 + bufo + kh * KSLOT + hi * 1024 + r32 * 16;
        const lds_cptr vp = shm3 + bufo + 2 * KSLOT + kh * VSLOT + ((lane >> 4) & 1) * 32 + (lane & 3) * 8 + (4 * hi + ((lane & 15) >> 2)) * 64;
        f32x16 p0, p1;
#pragma unroll
        for (int d0 = 0; d0 < 6; ++d0) {
            const bf16x8 b0 = *(const LAS bf16x8*)(kp + d0 * 2048), b1 = *(const LAS bf16x8*)(kp + d0 * 2048 + 512);
            if (d0 == 0) { p0 = __builtin_amdgcn_mfma_f32_32x32x16_bf16(b0, qr[0], negm, 0, 0, 0); p1 = __builtin_amdgcn_mfma_f32_32x32x16_bf16(b1, qr[0], negm, 0, 0, 0); }
            else { p0 = __builtin_amdgcn_mfma_f32_32x32x16_bf16(b0, qr[d0], p0, 0, 0, 0); p1 = __builtin_amdgcn_mfma_f32_32x32x16_bf16(b1, qr[d0], p1, 0, 0, 0); } }
        float rm = fmaxf(p0[0], p1[0]);
#pragma unroll
        for (int r = 1; r < 16; ++r) rm = fmaxf(rm, fmaxf(p0[r], p1[r]));
        rm = swapmax(rm);
        bool resc = false;
        if (s == 0 || __any(rm > 8.0f)) {
            const float dl = (s == 0) ? rm : fmaxf(rm, 0.f); mhat += dl;
#pragma unroll
            for (int r = 0; r < 16; ++r) { p0[r] -= dl; p1[r] -= dl; negm[r] = -mhat; }
            if (s != 0) { const float f = __builtin_amdgcn_exp2f(-dl); l_reg *= f; if (hi == 0) wsf[r32] = f; resc = true; }
        }
        float sacc = 0.f;
#pragma unroll
        for (int r = 0; r < 16; ++r) { p0[r] = __builtin_amdgcn_exp2f(p0[r]); p1[r] = __builtin_amdgcn_exp2f(p1[r]); sacc += p0[r] + p1[r]; }
        l_reg += sacc;
        if (resc) { asm volatile("s_waitcnt lgkmcnt(0)" ::: "memory");
#pragma unroll
            for (int d_ = 0; d_ < 2; ++d_)
#pragma unroll
                for (int r = 0; r < 16; ++r) o[d_][r] *= wsf[crow(r, hi)]; }
        u32x4 pw[4];
        pw[0] = (u32x4){cvtpk_s(p0[0], p0[1]), cvtpk_s(p0[2], p0[3]), cvtpk_s(p0[4], p0[5]), cvtpk_s(p0[6], p0[7])};
        pw[1] = (u32x4){cvtpk_s(p0[8], p0[9]), cvtpk_s(p0[10], p0[11]), cvtpk_s(p0[12], p0[13]), cvtpk_s(p0[14], p0[15])};
        pw[2] = (u32x4){cvtpk_s(p1[0], p1[1]), cvtpk_s(p1[2], p1[3]), cvtpk_s(p1[4], p1[5]), cvtpk_s(p1[6], p1[7])};
        pw[3] = (u32x4){cvtpk_s(p1[8], p1[9]), cvtpk_s(p1[10], p1[11]), cvtpk_s(p1[12], p1[13]), cvtpk_s(p1[14], p1[15])};
#pragma unroll
        for (int d0 = 0; d0 < 2; ++d0)
#pragma unroll
            for (int ks = 0; ks < 4; ++ks) {
                const s16x4 lo = vtr(vp + d0 * 4096 + ks * 1024), hh = vtr(vp + d0 * 4096 + ks * 1024 + 512);
                const bf16x8 vf = (bf16x8){lo[0], lo[1], lo[2], lo[3], hh[0], hh[1], hh[2], hh[3]};
                o[d0] = __builtin_amdgcn_mfma_f32_32x32x16_bf16(__builtin_bit_cast(bf16x8, pw[ks]), vf, o[d0], 0, 0, 0); }
    }
    l_reg = swapsum(l_reg);
    float* cm = (float*)(shm + LDS_CM); float* cl = (float*)(shm + LDS_CL);
    if (hi == 0) cm[(kh * 4 + qb) * 32 + r32] = mhat;
    asm volatile("s_waitcnt lgkmcnt(0)" ::: "memory"); __builtin_amdgcn_s_barrier(); asm volatile("" ::: "memory");
    { const float mo = cm[((kh ^ 1) * 4 + qb) * 32 + r32]; const float ms = fmaxf(mhat, mo); const float f = __builtin_amdgcn_exp2f(mhat - ms); l_reg *= f;
      if (hi == 0) wsf[r32] = f; asm volatile("s_waitcnt lgkmcnt(0)" ::: "memory");
#pragma unroll
      for (int d_ = 0; d_ < 2; ++d_)
#pragma unroll
          for (int r = 0; r < 16; ++r) o[d_][r] *= wsf[crow(r, hi)]; }
    float* co = (float*)shm + qb * 2048;
    if (kh == 1) {
#pragma unroll
        for (int d_ = 0; d_ < 2; ++d_)
#pragma unroll
            for (int r = 0; r < 16; ++r) co[(d_ * 16 + r) * 64 + lane] = o[d_][r];
        if (hi == 0) cl[qb * 32 + r32] = l_reg;
    }
    asm volatile("s_waitcnt lgkmcnt(0)" ::: "memory"); __builtin_amdgcn_s_barrier(); asm volatile("" ::: "memory");
    if (kh == 0) {
#pragma unroll
        for (int d_ = 0; d_ < 2; ++d_)
#pragma unroll
            for (int r = 0; r < 16; ++r) o[d_][r] += co[(d_ * 16 + r) * 64 + lane];
        l_reg += cl[qb * 32 + r32];
        if (hi == 0) wsf[32 + r32] = l_reg; asm volatile("s_waitcnt lgkmcnt(0)" ::: "memory");
        float rli[16];
#pragma unroll
        for (int r = 0; r < 16; ++r) rli[r] = __builtin_amdgcn_rcpf(wsf[32 + crow(r, hi)]);
        bf16_t* stg = (bf16_t*)(shm + LDS_OST) + wid * 2048;
#pragma unroll
        for (int r = 0; r < 16; ++r) { const int orow = crow(r, hi);
#pragma unroll
            for (int d0 = 0; d0 < 2; ++d0) stg[orow * 64 + d0 * 32 + r32] = f2bf(o[d0][r] * rli[r]); }
        asm volatile("s_waitcnt lgkmcnt(0)" ::: "memory");
        bf16_t* Ow = T.O + (size_t)(qrow0 + qb * 32) * 512 + h * 64;
#pragma unroll
        for (int i = 0; i < 4; ++i) { const int row = i * 8 + (lane >> 3), ch = lane & 7; const u32x4 v = *(const u32x4*)(stg + row * 64 + ch * 8); *(u32x4*)(Ow + (size_t)row * 512 + ch * 8) = v; }
    }
    asm volatile("s_waitcnt lgkmcnt(0)" ::: "memory"); __builtin_amdgcn_s_barrier(); asm volatile("" ::: "memory");
}
}

#define XB_TMO      128
#define XB_XCNT(j)  (256  + 64 * (j))
#define XB_XSUB(j)  (1280 + 64 * (j))
#define XB_XGEN(j)  (2304 + 64 * (j))
#define XB_TOP      3328
#define XB_TOPGEN   3392
#define XCD_BAR_WORDS 3456
#define XB_SPIN_CAP (1u << 18)
__device__ __forceinline__ unsigned xb_ld(unsigned* p)              { return __hip_atomic_load(p, __ATOMIC_RELAXED, __HIP_MEMORY_SCOPE_AGENT); }
__device__ __forceinline__ unsigned xb_add(unsigned* p, unsigned v) { return __hip_atomic_fetch_add(p, v, __ATOMIC_RELAXED, __HIP_MEMORY_SCOPE_AGENT); }
__device__ __forceinline__ unsigned xb_xcc_id() { return (unsigned)__builtin_amdgcn_s_getreg((3 << 11) | 20) & 0xFu; }
#define XB_SPIN(cond, bar) do { unsigned _sp = 0; while (cond) { __builtin_amdgcn_s_sleep(1); \
    if ((++_sp & 255u) == 0u) { if (xb_ld(&(bar)[XB_TMO])) break; if (_sp > XB_SPIN_CAP) { atomicAdd(&(bar)[XB_TMO], 1u); break; } } } } while (0)
struct XcdBarrier { unsigned* bar; unsigned x; volatile LAS unsigned* st; };
__device__ __forceinline__ XcdBarrier xcd_barrier_post(unsigned* bar, volatile LAS unsigned* st) {
    XcdBarrier b; b.bar = bar; b.x = xb_xcc_id(); b.st = st;
    if (threadIdx.x == 0) (void)xb_add(&bar[XB_XCNT(b.x)], 1u);
    return b;
}
__device__ __forceinline__ void xcd_barrier_complete(unsigned* bar, unsigned x, unsigned& nloc, unsigned& nx) {
    const unsigned G = gridDim.x * gridDim.y * gridDim.z;
    unsigned sum, cnt, mine, sp = 0u;
    for (;;) {
        sum = 0u; cnt = 0u; mine = 0u;
#pragma unroll
        for (unsigned j = 0; j < 16; ++j) { const unsigned c = xb_ld(&bar[XB_XCNT(j)]); sum += c; cnt += (c > 0u) ? 1u : 0u; mine = (j == x) ? c : mine; }
        if (sum == G) break;
        __builtin_amdgcn_s_sleep(1);
        if ((++sp & 255u) == 0u) { if (xb_ld(&bar[XB_TMO])) break; if (sp > XB_SPIN_CAP) { atomicAdd(&bar[XB_TMO], 1u); break; } }
    }
    nloc = mine > 0u ? mine : 1u; nx = cnt > 0u ? cnt : 1u;
}
__device__ __forceinline__ void xcd_barrier(const XcdBarrier& b) {
    asm volatile("s_waitcnt vmcnt(0)" ::: "memory");
    __syncthreads();
    if (threadIdx.x == 0) {
        unsigned* bar = b.bar;
        __builtin_amdgcn_s_waitcnt(0);
        unsigned nloc = b.st[0], nx = b.st[1];
        if (nloc == 0u) { xcd_barrier_complete(bar, b.x, nloc, nx); b.st[0] = nloc; b.st[1] = nx; }
        const unsigned old = xb_add(&bar[XB_XSUB(b.x)], 1u);
        const unsigned gen = old / nloc;
        if (old + 1u == (gen + 1u) * nloc) {
            __builtin_amdgcn_fence(__ATOMIC_RELEASE, "agent");
            asm volatile("s_waitcnt vmcnt(0)" ::: "memory");
            const unsigned og = xb_add(&bar[XB_TOP], 1u);
            const unsigned tg = og / nx;
            if (og + 1u == (tg + 1u) * nx) xb_add(&bar[XB_TOPGEN], 1u);
            else XB_SPIN(xb_ld(&bar[XB_TOPGEN]) == tg, bar);
            __builtin_amdgcn_fence(__ATOMIC_ACQUIRE, "agent");
            xb_add(&bar[XB_XGEN(b.x)], 1u);
            asm volatile("s_waitcnt vmcnt(0)" ::: "memory");
        } else {
            XB_SPIN(xb_ld(&bar[XB_XGEN(b.x)]) == gen, bar);
            __builtin_amdgcn_fence(__ATOMIC_ACQUIRE, "agent");
            asm volatile("s_waitcnt vmcnt(0)" ::: "memory");
        }
    }
    __syncthreads();
}

struct Args { const float* in[29]; float* out; unsigned char* ws; int step_lo, step_hi; };
static_assert(sizeof(Args) == 31 * 8 + 8, "Args has no padding");

struct Ctx {
    LAS unsigned char* lds; int tid, lane, wave, G, gw, NGW, bid;
    float* out; unsigned char* ws;
};
__device__ __forceinline__ const float* ldarg(int i) { const char* kp = (const char*)__builtin_amdgcn_kernarg_segment_ptr(); asm volatile("" : "+s"(kp)); return *(const float* const*)(kp + 8 * i); }
#define INP(i) ldarg(i)

__device__ __forceinline__ void transpose_item(const float* W, int N, bf16_t* WT, int ldt, int k0, int n0, int drow0, LAS float* scr, int lane) {
#pragma unroll 8
    for (int i = 0; i < 32; ++i) { const int kk = 2 * i + (lane >> 5); scr[kk * 33 + (lane & 31)] = W[(size_t)(k0 + kk) * N + n0 + (lane & 31)]; }
    LDS_WAIT(); asm volatile("" ::: "memory");
    const int c = lane & 7;
#pragma unroll
    for (int j = 0; j < 4; ++j) { const int n = (lane >> 3) + 8 * j; const LAS float* s = scr + (8 * c) * 33 + n;
        u32x4 o; o.x = cvt_pk_bf16(s[0 * 33], s[1 * 33]); o.y = cvt_pk_bf16(s[2 * 33], s[3 * 33]); o.z = cvt_pk_bf16(s[4 * 33], s[5 * 33]); o.w = cvt_pk_bf16(s[6 * 33], s[7 * 33]);
        *(u32x4*)(WT + (size_t)(drow0 + n) * ldt + k0 + 8 * c) = o; }
    LDS_WAIT(); asm volatile("" ::: "memory");
}

__device__ __forceinline__ void prologue(Ctx& F) {
    unsigned char* ws = F.ws;
    LAS float* misc = (LAS float*)(F.lds + MISC_OFF + 1024);
    if (F.tid < 64) { misc[F.tid] = __builtin_amdgcn_cosf((float)F.tid * (1.f / 64.f)); misc[64 + F.tid] = __builtin_amdgcn_sinf((float)F.tid * (1.f / 64.f)); }
    if (F.bid < 192) {
        LAS float* scv = (LAS float*)F.lds;
        LAS float* red = (LAS float*)(F.lds + 16384);
        for (int i = F.tid; i < 3072; i += 512) { const int m = i >> 10, k = i & 1023; const float v = (m == 0) ? INP(5)[k] : INP(4)[(m - 1) * 1024 + k]; scv[i] = v * sigmoidf_(v); }
        __syncthreads();
        const int l = F.bid / 96, c0 = (F.bid % 96) * 64;
        const float* w = INP(6) + (size_t)l * 1024 * 6144 + c0 + F.lane;
        float a0 = 0.f, a1 = 0.f, a2 = 0.f;
        const int kb = F.wave * 128;
#pragma unroll 8
        for (int k = 0; k < 128; ++k) { const float wv = w[(size_t)(kb + k) * 6144]; a0 += scv[kb + k] * wv; a1 += scv[1024 + kb + k] * wv; a2 += scv[2048 + kb + k] * wv; }
        red[(F.wave * 3 + 0) * 64 + F.lane] = a0; red[(F.wave * 3 + 1) * 64 + F.lane] = a1; red[(F.wave * 3 + 2) * 64 + F.lane] = a2;
        __syncthreads();
        if (F.wave < 3) { float s = INP(7)[l * 6144 + c0 + F.lane];
#pragma unroll
            for (int w8 = 0; w8 < 8; ++w8) s += red[(w8 * 3 + F.wave) * 64 + F.lane];
            ((float*)(ws + WS_MOD))[(l * 3 + F.wave) * 6144 + c0 + F.lane] = s; }
        __syncthreads();
    } else __syncthreads();
    LAS float* scr = (LAS float*)(F.lds + F.wave * 16384);
    for (int l = 0; l < DEPTH; ++l) {
        unsigned char* wl = ws + WS_W + (size_t)l * W_LAYER;
        {
            const float* W = INP(10) + (size_t)l * 1024 * IN_COLS; bf16_t* WT = (bf16_t*)(wl + W_IN); constexpr int nblk = IN_COLS / 32;
            for (int it = F.gw; it < 16 * nblk; it += F.NGW) { const int kb = it / nblk, nb = it % nblk, n0 = nb * 32;
                if (n0 >= OFF_FN && n0 < OFF_GATE) continue;
                const int dr = (n0 < OFF_FN) ? n0 : 2560 + (n0 - OFF_GATE);
                transpose_item(W, IN_COLS, WT, 1024, kb * 64, n0, dr, scr, F.lane); }
            for (int it = F.gw; it < 96 * 2; it += F.NGW) { const int r = 2464 + it / 2, h = it & 1; *(u32x4*)(WT + (size_t)r * 1024 + h * 512 + F.lane * 8) = (u32x4){0u, 0u, 0u, 0u}; }
        }
#define TR_SIMPLE(idx, KK, NN, OFF) { const float* W = INP(idx) + (size_t)l * (KK) * (NN); bf16_t* WT = (bf16_t*)(wl + (OFF)); constexpr int nblk = (NN) / 32; \
            for (int it = F.gw; it < ((KK) / 64) * nblk; it += F.NGW) { const int kb = it / nblk, nb = it % nblk; transpose_item(W, (NN), WT, (KK), kb * 64, nb * 32, nb * 32, scr, F.lane); } }
        TR_SIMPLE(12, 384, 768, W_QB)
        TR_SIMPLE(14, 256, 1024, W_KVB)
        TR_SIMPLE(15, 512, 1024, W_O)
        TR_SIMPLE(20, 256, 1024, W_CPW)
        TR_SIMPLE(22, 256, 1024, W_SCO)
        TR_SIMPLE(23, 256, 1024, W_FN)
        TR_SIMPLE(24, 1024, 1024, W_OUT)
        TR_SIMPLE(27, 2816, 1024, W_DN)
#undef TR_SIMPLE
        for (int gu = 0; gu < 2; ++gu) {
            const float* W = (gu ? INP(26) : INP(25)) + (size_t)l * 1024 * FF; bf16_t* WT = (bf16_t*)(wl + W_GU); constexpr int nblk = FF / 32;
            for (int it = F.gw; it < 16 * nblk; it += F.NGW) { const int kb = it / nblk, nb = it % nblk, n0 = nb * 32;
                transpose_item(W, FF, WT, 1024, kb * 64, n0, (n0 / 128) * 256 + gu * 128 + (n0 % 128), scr, F.lane); }
        }
        {
            const float* W = INP(10) + (size_t)l * 1024 * IN_COLS; bf16_t* WT = (bf16_t*)(wl + W_IN);
            for (int it = F.gw; it < 64; it += F.NGW) { const int kc = it >> 2, g = it & 3, k0 = kc * 64;
                for (int i = 0; i < 64; ++i) scr[i * 64 + ((F.lane + i) & 63)] = W[(size_t)(k0 + i) * IN_COLS + OFF_FN + g * 64 + F.lane];
                LDS_WAIT(); asm volatile("" ::: "memory");
                float t[64];
#pragma unroll
                for (int n = 0; n < 64; ++n) t[n] = scr[F.lane * 64 + ((n + F.lane) & 63)];
                for (int m = 0; m < 64; ++m) { float ap = 0.f, aq = 0.f;
#pragma unroll
                    for (int n = 0; n < 64; ++n) { const int ix = (m * n) & 63; ap += t[n] * misc[ix]; aq += t[n] * misc[64 + ix]; }
                    WT[(size_t)(OFF_FN + g * 64 + m) * 1024 + k0 + F.lane] = f2bf(ap * 0.125f);
                    WT[(size_t)(OFF_GATE + g * 64 + m) * 1024 + k0 + F.lane] = f2bf(aq * 0.125f); }
                LDS_WAIT(); asm volatile("" ::: "memory");
            }
        }
    }
    {
        bf16_t* TL = (bf16_t*)(ws + WS_DFTL); const int gt = F.gw * 64 + F.lane, NT = F.NGW * 64;
        for (int it = gt; it < 2048 * 512; it += NT) { const int k = it >> 9, c8 = (it & 511) * 8; float v[8];
#pragma unroll
            for (int e = 0; e < 8; ++e) { const int c = c8 + e, t = c & 2047; const float fr = (float)((k * t) & 2047) * (1.f / 2048.f);
                v[e] = ((c < 2048) ? __builtin_amdgcn_cosf(fr) : -__builtin_amdgcn_sinf(fr)) * 0.022097086912079608f; }
            *(u32x4*)(TL + (size_t)k * 4096 + c8) = (u32x4){cvt_pk_bf16(v[0], v[1]), cvt_pk_bf16(v[2], v[3]), cvt_pk_bf16(v[4], v[5]), cvt_pk_bf16(v[6], v[7])}; }
        bf16_t* TC = (bf16_t*)(ws + WS_DFTC);
        for (int it = gt; it < 256 * 64; it += NT) { const int k = it >> 6, c8 = (it & 63) * 8; float v[8];
#pragma unroll
            for (int e = 0; e < 8; ++e) { const int c = c8 + e, t = c & 255; const float fr = (float)((k * t) & 255) * (1.f / 256.f);
                v[e] = ((c < 256) ? __builtin_amdgcn_cosf(fr) : -__builtin_amdgcn_sinf(fr)) * 0.0625f; }
            *(u32x4*)(TC + (size_t)k * 512 + c8) = (u32x4){cvt_pk_bf16(v[0], v[1]), cvt_pk_bf16(v[2], v[3]), cvt_pk_bf16(v[4], v[5]), cvt_pk_bf16(v[6], v[7])}; }
        if (F.gw == F.NGW - 1) { float* R = (float*)(ws + WS_ROPE);
            for (int i = F.lane; i < 512; i += 64) { const int pos = i >> 3, f = i & 7; const float inv = __builtin_amdgcn_exp2f(-(float)f * 1.6609640474436813f);
                const float rev = ((float)pos * inv) * 0.15915494309189535f; R[2 * i] = __builtin_amdgcn_cosf(rev); R[2 * i + 1] = __builtin_amdgcn_sinf(rev); } }
    }
}

__device__ __forceinline__ void norm_row(const float* xrow, float* xcopy, const float* g, const float* sc, const float* sh, bf16_t* orow, int lane) {
    const f32x4* xr = (const f32x4*)xrow + lane; f32x4 v[4]; float s = 0.f;
#pragma unroll
    for (int j = 0; j < 4; ++j) { v[j] = xr[64 * j]; s += (v[j].x * v[j].x + v[j].y * v[j].y) + (v[j].z * v[j].z + v[j].w * v[j].w); }
    if (xcopy) {
#pragma unroll
        for (int j = 0; j < 4; ++j) ((f32x4*)xcopy + lane)[64 * j] = v[j]; }
    const float rstd = 1.f / sqrtf(wave_sum(s) * (1.f / D) + EPS);
#pragma unroll
    for (int j = 0; j < 4; ++j) { const int c = 4 * (64 * j + lane); const f32x4 gg = *(const f32x4*)(g + c), ss = *(const f32x4*)(sc + c), hh = *(const f32x4*)(sh + c);
        const f32x4 y = v[j] * rstd * gg * (ss + 1.f) + hh;
        *(u32x2*)(orow + c) = (u32x2){cvt_pk_bf16(y.x, y.y), cvt_pk_bf16(y.z, y.w)}; }
}
__device__ __forceinline__ int mod_of_row(int r) { return r < NCTX ? 0 : 1 + ((r - NCTX) >> 11); }
__device__ __forceinline__ int kvrow_of_row(int r) { return r < NCTX ? r : NCTX + ((r - NCTX) >> 11) * 2304 + 256 + ((r - NCTX) & 2047); }

__device__ __forceinline__ void phase_norm(Ctx& F, int l, int which  ) {
    const float* mod = (const float*)(F.ws + WS_MOD) + l * 3 * 6144; const float* g = (which ? INP(9) : INP(8)) + l * D;
    bf16_t* XN = (bf16_t*)(F.ws + WS_XN); const float* x0 = INP(0); const float* x1 = INP(1);
    for (int r = F.gw; r < MROWS; r += F.NGW) { const float* m = mod + mod_of_row(r) * 6144 + (which ? 3072 : 0);
        const bool first = (l == 0 && which == 0);
        const float* xrow = first ? (r < NCTX ? x0 + (size_t)r * D : x1 + (size_t)(r - NCTX) * D) : F.out + (size_t)r * D;
        norm_row(xrow, first ? F.out + (size_t)r * D : nullptr, g, m + 1024, m, XN + (size_t)r * D, F.lane); }
}

__device__ __forceinline__ void phase_prep(Ctx& F, int l) {
    unsigned char* ws = F.ws; const int lane = F.lane;
    const bf16_t* PROJ = (const bf16_t*)(ws + WS_PROJ);
    bf16_t* QN = (bf16_t*)(ws + WS_XN + XN_QN); bf16_t* CKV = (bf16_t*)(ws + WS_XN + XN_CKV); bf16_t* KR = (bf16_t*)(ws + WS_XN + XN_KR); bf16_t* UC = (bf16_t*)(ws + WS_XN + XN_UC);
    bf16_t* SC = (bf16_t*)(ws + WS_SC);
    float* out_ckv = F.out + (size_t)MROWS * D; float* out_kr = out_ckv + (size_t)NBC * DEPTH * SEQ * KVL;
    const float* rope = (const float*)(ws + WS_ROPE);
    {
        LAS float* ut = (LAS float*)F.lds;
        LAS float* wl = (LAS float*)(F.lds + 65536);
        const float* wdw = INP(16) + l * 31 * 256; const float* bdw = INP(17) + l * 256; const float* gln = INP(18) + l * 256; const float* bln = INP(19) + l * 256;
        for (int i = F.tid; i < 31 * 256; i += 512) wl[i] = wdw[i];
        for (int item = F.bid; item < 256; item += F.G) {
            const int r0 = item * 32; const int s0 = r0 < NCTX ? (r0 & ~255) : NCTX + ((r0 - NCTX) & ~2047); const int s1 = s0 + (r0 < NCTX ? 256 : 2048);
            __syncthreads();
            for (int idx = F.tid; idx < 62 * 128; idx += 512) { const int rr = idx >> 7, cp = idx & 127; const int row = r0 - 15 + rr; float u0 = 0.f, u1 = 0.f;
                if (row >= s0 && row < s1) { const unsigned a = *(const unsigned*)(PROJ + (size_t)row * PROJ_LD + OFF_CONF + 2 * cp), b = *(const unsigned*)(PROJ + (size_t)row * PROJ_LD + OFF_CONF + 256 + 2 * cp);
                    u0 = bf_lo(a) * sigmoidf_(bf_lo(b)); u1 = bf_hi(a) * sigmoidf_(bf_hi(b)); }
                ut[rr * 256 + 2 * cp] = u0; ut[rr * 256 + 2 * cp + 1] = u1; }
            __syncthreads();
            float acc[4][4];
#pragma unroll
            for (int q = 0; q < 4; ++q) { const float b = bdw[lane + 64 * q];
#pragma unroll
                for (int ri = 0; ri < 4; ++ri) acc[ri][q] = b; }
            for (int j = 0; j < 31; ++j) {
#pragma unroll
                for (int q = 0; q < 4; ++q) { const float w = wl[j * 256 + lane + 64 * q];
#pragma unroll
                    for (int ri = 0; ri < 4; ++ri) acc[ri][q] += ut[(4 * F.wave + ri + j) * 256 + lane + 64 * q] * w; } }
#pragma unroll
            for (int ri = 0; ri < 4; ++ri) { const float mean = wave_sum(acc[ri][0] + acc[ri][1] + acc[ri][2] + acc[ri][3]) * (1.f / 256.f); float q2 = 0.f;
#pragma unroll
                for (int q = 0; q < 4; ++q) { const float d = acc[ri][q] - mean; q2 += d * d; }
                const float rstd = 1.f / sqrtf(wave_sum(q2) * (1.f / 256.f) + EPS);
#pragma unroll
                for (int q = 0; q < 4; ++q) { const int c = lane + 64 * q; const float y = (acc[ri][q] - mean) * rstd * gln[c] + bln[c]; UC[(size_t)(r0 + 4 * F.wave + ri) * 256 + c] = f2bf(y * sigmoidf_(y)); } }
        }
        __syncthreads();
    }
    const float* gqa = INP(11) + l * QL; const float* gkva = INP(13) + l * KVL; const float* wc3 = INP(21) + l * 3 * 256;
    for (int r = F.gw; r < MROWS; r += F.NGW) {
        const bf16_t* pr = PROJ + (size_t)r * PROJ_LD; const int mr = kvrow_of_row(r);
        {
            float v[6]; float s = 0.f;
#pragma unroll
            for (int j = 0; j < 3; ++j) { const unsigned u = *(const unsigned*)(pr + 2 * lane + 128 * j); v[2 * j] = bf_lo(u); v[2 * j + 1] = bf_hi(u); s += v[2 * j] * v[2 * j] + v[2 * j + 1] * v[2 * j + 1]; }
            const float rstd = 1.f / sqrtf(wave_sum(s) * (1.f / QL) + EPS);
#pragma unroll
            for (int j = 0; j < 3; ++j) { const int c = 2 * lane + 128 * j; *(unsigned*)(QN + (size_t)r * QL + c) = cvt_pk_bf16(v[2 * j] * rstd * gqa[c], v[2 * j + 1] * rstd * gqa[c + 1]); }
        }
        {
            const u32x2 u = *(const u32x2*)(pr + OFF_KVA + 4 * lane); f32x4 v = {bf_lo(u.x), bf_hi(u.x), bf_lo(u.y), bf_hi(u.y)};
            const float rstd = 1.f / sqrtf(wave_sum((v.x * v.x + v.y * v.y) + (v.z * v.z + v.w * v.w)) * (1.f / KVL) + EPS);
            v = v * rstd * *(const f32x4*)(gkva + 4 * lane);
            *(u32x2*)(CKV + (size_t)mr * KVL + 4 * lane) = (u32x2){cvt_pk_bf16(v.x, v.y), cvt_pk_bf16(v.z, v.w)};
            if (r < NCTX) { const int b = r >> 8, t = r & 255; *(f32x4*)(out_ckv + ((size_t)(b * DEPTH + l) * SEQ + t) * KVL + 4 * lane) = v; }
        }
        {
            const float v = bf1(pr[OFF_KR + (lane & 31)]);
            if (r < NCTX) { if (lane < 32) { const int b = r >> 8, t = r & 255; out_kr[((size_t)(b * DEPTH + l) * SEQ + t) * QKR + lane] = v; KR[(size_t)mr * QKR + lane] = f2bf(v); } }
            else { const int t = (r - NCTX) & 2047, j = lane & 31; const int pos = (j & 16) ? (t & 63) : (t >> 6); const float c = rope[(pos * 8 + (j & 7)) * 2], s = rope[(pos * 8 + (j & 7)) * 2 + 1];
                const float p = __shfl_xor(v, 8); const float o = (j & 8) ? (v * c + p * s) : (v * c - p * s);
                if (lane < 32) KR[(size_t)mr * QKR + lane] = f2bf(o); }
        }
        {
            const int s0 = r < NCTX ? (r & ~255) : NCTX + ((r - NCTX) & ~2047); const int s1 = s0 + (r < NCTX ? 256 : 2048);
            f32x4 a = {0.f, 0.f, 0.f, 0.f};
#pragma unroll
            for (int d = 0; d < 3; ++d) { const int row = r + d - 1;
                if (row >= s0 && row < s1) { const bf16_t* q = PROJ + (size_t)row * PROJ_LD + OFF_SC; const u32x2 gc = *(const u32x2*)(q + 256 + 4 * lane), xs = *(const u32x2*)(q + 512 + 4 * lane);
                    const f32x4 w = *(const f32x4*)(wc3 + d * 256 + 4 * lane);
                    a.x += w.x * bf_lo(gc.x) * bf_lo(xs.x); a.y += w.y * bf_hi(gc.x) * bf_hi(xs.x); a.z += w.z * bf_lo(gc.y) * bf_lo(xs.y); a.w += w.w * bf_hi(gc.y) * bf_hi(xs.y); } }
            const u32x2 gb = *(const u32x2*)(pr + OFF_SC + 4 * lane);
            *(u32x2*)(SC + (size_t)r * 256 + 4 * lane) = (u32x2){cvt_pk_bf16(a.x * bf_lo(gb.x), a.y * bf_hi(gb.x)), cvt_pk_bf16(a.z * bf_lo(gb.y), a.w * bf_hi(gb.y))};
        }
    }
    const float* cckv = INP(2); const float* ckr = INP(3);
    for (int i = F.gw; i < NBL * PAST; i += F.NGW) { const int b = i >> 8, p = i & 255; const int mr = NCTX + b * 2304 + p;
        const f32x4 v = *(const f32x4*)(cckv + ((size_t)(b * DEPTH + l) * PAST + p) * KVL + 4 * lane);
        *(u32x2*)(CKV + (size_t)mr * KVL + 4 * lane) = (u32x2){cvt_pk_bf16(v.x, v.y), cvt_pk_bf16(v.z, v.w)};
        if (lane < 32) KR[(size_t)mr * QKR + lane] = f2bf(ckr[((size_t)(b * DEPTH + l) * PAST + p) * QKR + lane]); }
    {
        LAS bf16_t* tl = (LAS bf16_t*)(F.lds + F.wave * 16384);
        bf16_t* PQL = (bf16_t*)(ws + WS_PQL); bf16_t* PQC = (bf16_t*)(ws + WS_PQC);
        for (int it = F.gw; it < 128 * 8; it += F.NGW) { const int rc = it >> 3, part = (it >> 2) & 1, cq = it & 3;
            const int col0 = (part ? OFF_GATE : OFF_FN) + cq * 64;
#pragma unroll 4
            for (int i = 0; i < 32; ++i) { const int t = 2 * i + (lane >> 5), c2 = lane & 31; const unsigned u = *(const unsigned*)(PROJ + (size_t)(rc * 64 + t) * PROJ_LD + col0 + 2 * c2);
                tl[(2 * c2) * 72 + t] = (bf16_t)(u & 0xffffu); tl[(2 * c2 + 1) * 72 + t] = (bf16_t)(u >> 16); }
            LDS_WAIT(); asm volatile("" ::: "memory");
            bf16_t* dst; int ldd;
            if (rc < 64) { const int b = rc >> 2, t0 = (rc & 3) * 64; dst = PQC + ((size_t)b * 256 + cq * 64) * 512 + part * 256 + t0; ldd = 512; }
            else { const int b = (rc - 64) >> 5, t0 = ((rc - 64) & 31) * 64; dst = PQL + ((size_t)b * 256 + cq * 64) * 4096 + part * 2048 + t0; ldd = 4096; }
#pragma unroll
            for (int i = 0; i < 8; ++i) { const int ch = 8 * i + (lane >> 3), t8 = (lane & 7) * 8; const u32x4 v = *(const LAS u32x4*)(tl + ch * 72 + t8); *(u32x4*)(dst + (size_t)ch * ldd + t8) = v; }
            LDS_WAIT(); asm volatile("" ::: "memory");
        }
    }
}

__device__ __forceinline__ void phase_attn(Ctx& F) {
    unsigned char* ws = F.ws;
    {
        const float* P = (const float*)(ws + WS_DFTP); bf16_t* Fo = (bf16_t*)(ws + WS_F) + (size_t)NCTX * 256;
        const int gt = F.gw * 64 + F.lane, NT = F.NGW * 64;
        for (int it = gt; it < NLAT * 64; it += NT) { const int row = it >> 6, c4 = (it & 63) * 4; const int b = row >> 11, k = row & 2047; f32x4 s = {0.f, 0.f, 0.f, 0.f};
#pragma unroll
            for (int ks = 0; ks < 8; ++ks) s += *(const f32x4*)(P + ((size_t)(b * 8 + ks) * 2048 + k) * 256 + c4);
            *(u32x2*)(Fo + (size_t)row * 256 + c4) = (u32x2){cvt_pk_bf16(s.x, s.y), cvt_pk_bf16(s.z, s.w)}; }
    }
    attn::Tensors T{(const bf16_t*)(ws + WS_PROJ + PJ_Q), (const bf16_t*)(ws + WS_PROJ + PJ_KV), (const bf16_t*)(ws + WS_XN + XN_KR), (bf16_t*)(ws + WS_PROJ + PJ_O)};
    for (int u = F.bid; u < 512; u += F.G) {
        if (u < 256) { const int b = u >> 7, h = (u >> 4) & 7, qb = u & 15;
            attn::unit(T, NCTX + b * 2048 + qb * 128, NCTX + b * 2304, 18, h, (char*)F.lds, F.tid); }
        else { const int v = u - 256; const int b = v >> 4, h = (v >> 1) & 7, qb = v & 1;
            attn::unit(T, b * 256 + qb * 128, b * 256, 2, h, (char*)F.lds, F.tid); }
    }
}

__device__ __forceinline__ void phase_final(Ctx& F) {
    const float* g = INP(28);
    for (int r = F.gw; r < MROWS; r += F.NGW) { f32x4* xr = (f32x4*)(F.out + (size_t)r * D) + F.lane; f32x4 v[4]; float s = 0.f;
#pragma unroll
        for (int j = 0; j < 4; ++j) { v[j] = xr[64 * j]; s += (v[j].x * v[j].x + v[j].y * v[j].y) + (v[j].z * v[j].z + v[j].w * v[j].w); }
        const float rstd = 1.f / sqrtf(wave_sum(s) * (1.f / D) + EPS);
#pragma unroll
        for (int j = 0; j < 4; ++j) xr[64 * j] = v[j] * rstd * *(const f32x4*)(g + 4 * (64 * j + F.lane)); }
}

constexpr int STEPS_PER_LAYER = 16, N_STEPS = 2 + DEPTH * STEPS_PER_LAYER;
__host__ __device__ constexpr bool barrier_after(int s) {
    if (s == 0) return true; if (s >= N_STEPS - 1) return false;
    const int k = (s - 1) % STEPS_PER_LAYER;
    return !(k == 3 || k == 4 || k == 5 || k == 8 || k == 9 || k == 10);
}

__global__ void __launch_bounds__(512, 2) mk_fwd(Args args) {
    extern __shared__ __attribute__((aligned(16))) unsigned char lds_raw[];
    volatile LAS unsigned* MISC = (volatile LAS unsigned*)((LAS unsigned char*)lds_raw + MISC_OFF);
    if (threadIdx.x < 64) MISC[threadIdx.x] = 0u;
    __syncthreads();
    XcdBarrier bar; bar.bar = (unsigned*)(args.ws + WS_CTL) + 1024; bar.x = 0; bar.st = nullptr;
    if (MK_N_LAUNCHES == 1) bar = xcd_barrier_post((unsigned*)(args.ws + WS_CTL) + 1024, MISC + 8);
    for (int step = args.step_lo; step < args.step_hi; ++step) {
        unsigned char* ws = args.ws; float* outp = args.out; int tid_ = threadIdx.x; int bid_ = blockIdx.x;
        asm volatile("" : "+s"(ws), "+s"(outp), "+v"(tid_), "+s"(bid_));
        Ctx F; F.lds = (LAS unsigned char*)lds_raw; F.tid = tid_; F.lane = F.tid & 63; F.wave = __builtin_amdgcn_readfirstlane(F.tid >> 6);
        F.G = gridDim.x; F.gw = bid_ * 8 + F.wave; F.NGW = F.G * 8; F.out = outp; F.ws = ws; F.bid = bid_;
        bool isgemm = false; pg8::Job J{};
        if (step == 0) prologue(F);
        else if (step == N_STEPS - 1) phase_final(F);
        else {
            const int l = (step - 1) / STEPS_PER_LAYER, k = (step - 1) % STEPS_PER_LAYER;
            unsigned char* wl = ws + WS_W + (size_t)l * W_LAYER;
            const float* modl = (const float*)(ws + WS_MOD) + l * 3 * 6144;
            J.nZ = 1; J.a_lo = J.a_hi = J.b_lo = J.b_hi = 0; J.zso = 0; J.aux = 0; J.ldc = 0;
            switch (k) {
            case 0: phase_norm(F, l, 0); break;
            case 1: isgemm = true; J.A = (const char*)(ws + WS_XN); J.Bt = (const char*)(wl + W_IN); J.lda = 1024; J.ldb = 1024; J.K = 1024; J.nM = 32; J.nN = 26; J.kind = pg8::EK_PROJ;
                    J.o0 = ws + WS_PROJ; J.o1 = ws + WS_GATES; break;
            case 2: phase_prep(F, l); break;
            case 3: isgemm = true; J.A = (const char*)(ws + WS_XN + XN_QN); J.Bt = (const char*)(wl + W_QB); J.lda = 384; J.ldb = 384; J.K = 384; J.nM = 32; J.nN = 3; J.kind = pg8::EK_Q;
                    J.o0 = ws + WS_PROJ + PJ_Q; J.p0 = ws + WS_ROPE; break;
            case 4: isgemm = true; J.A = (const char*)(ws + WS_XN + XN_CKV); J.Bt = (const char*)(wl + W_KVB); J.lda = 256; J.ldb = 256; J.K = 256; J.nM = 34; J.nN = 4; J.kind = pg8::EK_BF16;
                    J.o0 = ws + WS_PROJ + PJ_KV; J.ldc = 1024; break;
            case 5: isgemm = true; J.A = (const char*)(ws + WS_DFTL); J.Bt = (const char*)(ws + WS_PQL); J.lda = 4096; J.ldb = 4096; J.K = 512; J.nM = 8; J.nN = 1; J.nZ = 16; J.kind = pg8::EK_F32;
                    J.a_lo = 1024; J.a_hi = 0; J.b_lo = 1024; J.b_hi = (long)256 * 4096 * 2; J.o0 = ws + WS_DFTP; J.ldc = 256; J.zso = (long)2048 * 256; break;
            case 6: isgemm = true; J.A = (const char*)(ws + WS_DFTC); J.Bt = (const char*)(ws + WS_PQC); J.lda = 512; J.ldb = 512; J.K = 512; J.nM = 1; J.nN = 1; J.nZ = 16; J.kind = pg8::EK_BF16;
                    J.b_lo = (long)256 * 512 * 2; J.b_hi = (long)8 * 256 * 512 * 2; J.o0 = ws + WS_F; J.ldc = 256; J.zso = (long)256 * 256; break;
            case 7: phase_attn(F); break;
            case 8: isgemm = true; J.A = (const char*)(ws + WS_PROJ + PJ_O); J.Bt = (const char*)(wl + W_O); J.lda = 512; J.ldb = 512; J.K = 512; J.aux = 0; goto merge_common;
            case 9: isgemm = true; J.A = (const char*)(ws + WS_XN + XN_UC); J.Bt = (const char*)(wl + W_CPW); J.lda = 256; J.ldb = 256; J.K = 256; J.aux = 1; goto merge_common;
            case 10: isgemm = true; J.A = (const char*)(ws + WS_SC); J.Bt = (const char*)(wl + W_SCO); J.lda = 256; J.ldb = 256; J.K = 256; J.aux = 2; goto merge_common;
            case 11: isgemm = true; J.A = (const char*)(ws + WS_F); J.Bt = (const char*)(wl + W_FN); J.lda = 256; J.ldb = 256; J.K = 256; J.aux = 3;
            merge_common: J.nM = 32; J.nN = 4; J.kind = pg8::EK_MERGE; J.o0 = ws + WS_DFTP; J.o1 = ws + WS_PROJ + PJ_Q; J.p0 = ws + WS_GATES; break;
            case 12: isgemm = true; J.A = (const char*)(ws + WS_PROJ + PJ_Q); J.Bt = (const char*)(wl + W_OUT); J.lda = 1024; J.ldb = 1024; J.K = 1024; J.nM = 32; J.nN = 4; J.kind = pg8::EK_RESID;
                    J.o0 = F.out; J.p0 = modl; J.aux = 2048; break;
            case 13: phase_norm(F, l, 1); break;
            case 14: isgemm = true; J.A = (const char*)(ws + WS_XN); J.Bt = (const char*)(wl + W_GU); J.lda = 1024; J.ldb = 1024; J.K = 1024; J.nM = 32; J.nN = 22; J.kind = pg8::EK_SWIGLU;
                    J.o0 = ws + WS_GATES; break;
            default: isgemm = true; J.A = (const char*)(ws + WS_GATES); J.Bt = (const char*)(wl + W_DN); J.lda = FF; J.ldb = FF; J.K = FF; J.nM = 32; J.nN = 4; J.kind = pg8::EK_RESID;
                    J.o0 = F.out; J.p0 = modl; J.aux = 5120; break;
            }
        }
        if (isgemm) { pg8::Order S; S.init(J, F.G, F.bid); pg8::gemm_phase(F.lds, J, S, F.tid); }
        if (step + 1 < args.step_hi && barrier_after(step)) xcd_barrier(bar);
    }
}

extern "C" void kernel_launch(void* const* d_in, const int* in_sizes, int n_in, void* d_out, int out_size, void* d_ws, size_t ws_size, hipStream_t stream) {
    static int grid = 0;
    if (grid == 0) {
        if (n_in != 29 || ws_size < WS_END) { fprintf(stderr, "kernel_launch: expected 29 inputs and >= %zu bytes of workspace; got %d, %zu\n", (size_t)WS_END, n_in, ws_size); grid = -1; return; }
        int dev = 0, cus = 0, per_cu = 0;
        if (hipGetDevice(&dev) != hipSuccess || hipDeviceGetAttribute(&cus, hipDeviceAttributeMultiprocessorCount, dev) != hipSuccess) { grid = -1; return; }
        if (hipFuncSetAttribute((const void*)mk_fwd, hipFuncAttributeMaxDynamicSharedMemorySize, LDS_BYTES) != hipSuccess) { fprintf(stderr, "kernel_launch: hipFuncSetAttribute failed\n"); grid = -1; return; }
        if (hipOccupancyMaxActiveBlocksPerMultiprocessor(&per_cu, (const void*)mk_fwd, 512, LDS_BYTES) != hipSuccess || per_cu < 1) fprintf(stderr, "kernel_launch: occupancy query reports %d\n", per_cu);
        (void)hipGetLastError();
        grid = cus;
    }
    if (grid < 0) return;
    (void)hipMemsetAsync((char*)d_ws + WS_CTL, 0, CTL_ZERO_BYTES, stream);
    Args a{};
    for (int i = 0; i < 29; ++i) a.in[i] = (const float*)d_in[i];
    a.out = (float*)d_out; a.ws = (unsigned char*)d_ws;
    if (MK_N_LAUNCHES == 1) { a.step_lo = 0; a.step_hi = N_STEPS; hipLaunchKernelGGL(mk_fwd, dim3(grid), dim3(512), LDS_BYTES, stream, a); }
    else {
        int lo = 0;
        for (int s = 0; s < N_STEPS; ++s) if (barrier_after(s) || s == N_STEPS - 1) { a.step_lo = lo; a.step_hi = s + 1; hipLaunchKernelGGL(mk_fwd, dim3(grid), dim3(512), LDS_BYTES, stream, a); lo = s + 1; }
    }
}
```

```cpp
#include <hip/hip_runtime.h>
#include <hip/hip_bf16.h>
#include <cstdio>
#include <cstdint>

#ifndef MK_N_LAUNCHES
#define MK_N_LAUNCHES 1
#endif
#ifndef PROBE_MASK
#define PROBE_MASK 0
#endif

#define LAS __attribute__((address_space(3)))
#define GAS __attribute__((address_space(1)))
typedef unsigned short bf16_t;
typedef short bf16x8 __attribute__((ext_vector_type(8)));
typedef short s16x4 __attribute__((ext_vector_type(4)));
typedef float f32x4 __attribute__((ext_vector_type(4)));
typedef float f32x2 __attribute__((ext_vector_type(2)));
typedef float f32x16 __attribute__((ext_vector_type(16)));
typedef unsigned u32x4 __attribute__((ext_vector_type(4)));
typedef unsigned u32x2 __attribute__((ext_vector_type(2)));

constexpr int D = 1024, NCTX = 4096, NLAT = 4096, MROWS = 8192, DEPTH = 2;
constexpr int SEQ = 256, DEC_SEQ = 2048, PAST = 256, NBC = 16, NBL = 2;
constexpr int NH = 8, QKN = 64, QKR = 32, VH = 64, QL = 384, KVL = 256;
constexpr int IN_COLS = 6304, FF = 2816;
constexpr int OFF_KVA = 384, OFF_KR = 640, OFF_CONF = 672, OFF_SC = 1184, OFF_FN = 1952, OFF_GATE = 2208;
constexpr int PROJ_LD = 2464;
constexpr int WIN_N = 6656;
constexpr int KVROWS = 8704;
constexpr float EPS = 1e-6f;
constexpr float QSCALE = 0.10206207261596577f * 1.4426950408889634f;

constexpr size_t al256(size_t x) { return (x + 255) & ~(size_t)255; }
constexpr size_t WS_CTL = 0, CTL_ZERO_BYTES = 65536;
constexpr size_t WS_MOD = 65536;
constexpr size_t WS_ROPE = WS_MOD + al256(2 * 3 * 6144 * 4);
constexpr size_t WS_DFTL = WS_ROPE + 4096;
constexpr size_t WS_DFTC = WS_DFTL + (size_t)2048 * 4096 * 2;
constexpr size_t WS_W = WS_DFTC + (size_t)256 * 512 * 2;
constexpr size_t W_IN = 0;
constexpr size_t W_QB = W_IN + (size_t)WIN_N * 1024 * 2;
constexpr size_t W_KVB = W_QB + (size_t)768 * 384 * 2;
constexpr size_t W_O = W_KVB + (size_t)1024 * 256 * 2;
constexpr size_t W_CPW = W_O + (size_t)1024 * 512 * 2;
constexpr size_t W_SCO = W_CPW + (size_t)1024 * 256 * 2;
constexpr size_t W_FN = W_SCO + (size_t)1024 * 256 * 2;
constexpr size_t W_OUT = W_FN + (size_t)1024 * 256 * 2;
constexpr size_t W_GU = W_OUT + (size_t)1024 * 1024 * 2;
constexpr size_t W_DN = W_GU + (size_t)5632 * 1024 * 2;
constexpr size_t W_LAYER = W_DN + (size_t)1024 * 2816 * 2;
constexpr size_t WS_XN = WS_W + 2 * W_LAYER;
constexpr size_t XN_QN = 0, XN_CKV = XN_QN + (size_t)MROWS * 384 * 2, XN_KR = XN_CKV + (size_t)KVROWS * 256 * 2, XN_UC = XN_KR + (size_t)KVROWS * 32 * 2;
static_assert(XN_UC + (size_t)MROWS * 256 * 2 <= (size_t)MROWS * 1024 * 2, "XN overlay");
constexpr size_t WS_PROJ = WS_XN + (size_t)MROWS * 1024 * 2;
constexpr size_t PJ_Q = 0, PJ_KV = PJ_Q + (size_t)MROWS * 768 * 2, PJ_O = PJ_KV + (size_t)KVROWS * 1024 * 2;
static_assert(PJ_O + (size_t)MROWS * 512 * 2 <= (size_t)MROWS * PROJ_LD * 2, "PROJ overlay");
constexpr size_t WS_GATES = WS_PROJ + (size_t)MROWS * PROJ_LD * 2;
constexpr size_t WS_SC = WS_GATES + (size_t)MROWS * 4096 * 2;
constexpr size_t WS_PQL = WS_SC + (size_t)MROWS * 256 * 2;
constexpr size_t WS_PQC = WS_PQL + (size_t)2 * 256 * 4096 * 2;
constexpr size_t WS_F = WS_PQC + (size_t)16 * 256 * 512 * 2;
constexpr size_t WS_DFTP = WS_F + (size_t)MROWS * 256 * 2;
constexpr size_t WS_END = WS_DFTP + (size_t)2 * 8 * 2048 * 256 * 4;
static_assert(WS_END <= 268435456, "workspace map exceeds 256 MiB");

constexpr int RING_BYTES = 131072, MISC_OFF = RING_BYTES, LDS_BYTES = 147456;

__device__ __forceinline__ unsigned cvt_pk_bf16(float lo, float hi) { unsigned r; asm volatile("v_cvt_pk_bf16_f32 %0, %1, %2" : "=v"(r) : "v"(lo), "v"(hi)); return r; }
__device__ __forceinline__ float bf_lo(unsigned u) { return __uint_as_float(u << 16); }
__device__ __forceinline__ float bf_hi(unsigned u) { return __uint_as_float(u & 0xffff0000u); }
__device__ __forceinline__ float bf1(bf16_t u) { return __uint_as_float((unsigned)u << 16); }
__device__ __forceinline__ bf16_t f2bf(float f) { return (bf16_t)(cvt_pk_bf16(f, 0.f) & 0xffffu); }
__device__ __forceinline__ float sigmoidf_(float x) { return __builtin_amdgcn_rcpf(1.f + __expf(-x)); }
__device__ __forceinline__ float wave_sum(float v) {
#pragma unroll
    for (int o = 1; o < 64; o <<= 1) v += __shfl_xor(v, o);
    return v;
}
#define LDS_WAIT() asm volatile("s_waitcnt lgkmcnt(0)" ::: "memory")
#define VM_WAIT() asm volatile("s_waitcnt vmcnt(0)" ::: "memory")

namespace pg8 {
constexpr int BM = 256, BK = 64, HALF = 128, HTB = HALF * BK * 2, STAGE_BYTES = 8 * HTB;
__device__ __forceinline__ int lds_byte(int r, int c) { const int st = (r >> 4) * 2 + (c >> 5), rr = r & 15, cc = c & 31, ob = rr * 64 + cc * 2; return st * 1024 + (ob ^ (((ob >> 9) & 1) << 5)); }
__device__ __forceinline__ void stage_rc(int b, int& R, int& C) { const int st = b / 1024, sb = b % 1024, swz = sb ^ (((sb >> 9) & 1) << 5); R = (st >> 1) * 16 + swz / 64; C = (st & 1) * 32 + (swz % 64) / 2; }
__device__ __forceinline__ int perm32(int rho) { const int n = rho >> 4, i = rho & 15; return 8 * (i >> 2) + 4 * n + (i & 3); }

struct Unit { int pm, pn, z; };
struct Job {
    const char* A; const char* Bt; int lda, ldb, K; long a_lo, a_hi, b_lo, b_hi;
    int nM, nN, nZ;
    int kind;
    void* o0; void* o1; const void* p0; const void* p1; int ldc; long zso; int aux;
};
enum { EK_PROJ = 0, EK_Q, EK_BF16, EK_F32, EK_MERGE, EK_RESID, EK_SWIGLU };

struct Order {
    int nM, nN, nZ, nwg, G, c;
    __device__ __forceinline__ void init(const Job& j, int G_, int c_) { nM = j.nM; nN = j.nN; nZ = j.nZ; nwg = nM * nN * nZ; G = G_; c = c_; }
    __device__ __forceinline__ bool next(int i, Unit& u) const {
        const long L = (long)i * G + c; if (L >= nwg) return false;
        if (nZ > 1) { const int per = nM * nN; u.z = (int)L / per; const int r = (int)L % per; u.pn = r / nM; u.pm = r % nM; return true; }
        constexpr int NXCD = 8, WGM = 8;
        int wgid = (int)L; { const int q = nwg / NXCD, r = nwg % NXCD, xcd = wgid % NXCD, off = wgid / NXCD; wgid = (xcd < r ? xcd * (q + 1) : r * (q + 1) + (xcd - r) * q) + off; }
        const int nig = WGM * nN, gid = wgid / nig, fm = gid * WGM, gsz = (nM - fm) < WGM ? (nM - fm) : WGM;
        u.pm = fm + ((wgid % nig) % gsz); u.pn = (wgid % nig) / gsz; u.z = 0; return true;
    }
};

__device__ __forceinline__ void epilogue(const Job& J, const f32x4 (&acc)[2][2][4][2], const Unit& u, int wr, int wc, int fr, int fq) {
    const int row0 = u.pm * BM + wr * 64 + fr;
    const int cl = wc * 32 + 8 * fq;
    if (J.kind == EK_PROJ) {
        const bool isg = u.pn >= 10;
        bf16_t* base = isg ? (bf16_t*)J.o1 : (bf16_t*)J.o0; const int ldc = isg ? 4096 : PROJ_LD;
        const int col0 = (isg ? (u.pn - 10) * BM : u.pn * BM) + cl;
#pragma unroll
        for (int ai = 0; ai < 2; ++ai)
#pragma unroll
            for (int m = 0; m < 4; ++m) { bf16_t* rowp = base + (size_t)(row0 + ai * HALF + m * 16) * ldc + col0;
#pragma unroll
                for (int bj = 0; bj < 2; ++bj) { f32x4 v0 = acc[ai][bj][m][0], v1 = acc[ai][bj][m][1];
                    if (isg) {
#pragma unroll
                        for (int e = 0; e < 4; ++e) { v0[e] = sigmoidf_(v0[e]); v1[e] = sigmoidf_(v1[e]); } }
                    u32x4 w; w.x = cvt_pk_bf16(v0[0], v0[1]); w.y = cvt_pk_bf16(v0[2], v0[3]); w.z = cvt_pk_bf16(v1[0], v1[1]); w.w = cvt_pk_bf16(v1[2], v1[3]);
                    if (isg || col0 + bj * HALF + 8 <= PROJ_LD) *(u32x4*)(rowp + bj * HALF) = w; } }
    } else if (J.kind == EK_Q) {
        bf16_t* Q = (bf16_t*)J.o0; const float* rope = (const float*)J.p0; const bool lat = u.pm >= 16;
#pragma unroll
        for (int bj = 0; bj < 2; ++bj) {
            const int G = 8 * u.pn + 4 * bj + wc; const bool isrope = lat && (G % 3 == 2);
#pragma unroll
            for (int ai = 0; ai < 2; ++ai)
#pragma unroll
                for (int m = 0; m < 4; ++m) { const int row = row0 + ai * HALF + m * 16;
                    float v[8];
#pragma unroll
                    for (int e = 0; e < 4; ++e) { v[e] = acc[ai][bj][m][0][e] * QSCALE; v[4 + e] = acc[ai][bj][m][1][e] * QSCALE; }
                    if (isrope) { const int t = (row - NCTX) & (DEC_SEQ - 1); const int pos = (fq < 2) ? (t >> 6) : (t & 63);
                        const f32x4* cs = (const f32x4*)(rope + pos * 16);
                        const f32x4 c0 = cs[0], c1 = cs[1], c2 = cs[2], c3 = cs[3];
                        const float cc[8] = {c0[0], c0[2], c1[0], c1[2], c2[0], c2[2], c3[0], c3[2]}, ss[8] = {c0[1], c0[3], c1[1], c1[3], c2[1], c2[3], c3[1], c3[3]};
#pragma unroll
                        for (int e = 0; e < 8; ++e) { const float p = __shfl_xor(v[e], 16); v[e] = (fq & 1) ? (v[e] * cc[e] + p * ss[e]) : (v[e] * cc[e] - p * ss[e]); } }
                    u32x4 w; w.x = cvt_pk_bf16(v[0], v[1]); w.y = cvt_pk_bf16(v[2], v[3]); w.z = cvt_pk_bf16(v[4], v[5]); w.w = cvt_pk_bf16(v[6], v[7]);
                    *(u32x4*)(Q + (size_t)row * 768 + u.pn * BM + bj * HALF + cl) = w; } }
    } else if (J.kind == EK_BF16) {
        bf16_t* O = (bf16_t*)J.o0 + (size_t)u.z * J.zso;
#pragma unroll
        for (int ai = 0; ai < 2; ++ai)
#pragma unroll
            for (int m = 0; m < 4; ++m) { bf16_t* rowp = O + (size_t)(row0 + ai * HALF + m * 16) * J.ldc + u.pn * BM + cl;
#pragma unroll
                for (int bj = 0; bj < 2; ++bj) { const f32x4 v0 = acc[ai][bj][m][0], v1 = acc[ai][bj][m][1];
                    u32x4 w; w.x = cvt_pk_bf16(v0[0], v0[1]); w.y = cvt_pk_bf16(v0[2], v0[3]); w.z = cvt_pk_bf16(v1[0], v1[1]); w.w = cvt_pk_bf16(v1[2], v1[3]);
                    *(u32x4*)(rowp + bj * HALF) = w; } }
    } else if (J.kind == EK_F32) {
        float* O = (float*)J.o0 + (size_t)u.z * J.zso;
#pragma unroll
        for (int ai = 0; ai < 2; ++ai)
#pragma unroll
            for (int m = 0; m < 4; ++m) { float* rowp = O + (size_t)(row0 + ai * HALF + m * 16) * J.ldc + u.pn * BM + cl;
#pragma unroll
                for (int bj = 0; bj < 2; ++bj) { *(f32x4*)(rowp + bj * HALF) = acc[ai][bj][m][0]; *(f32x4*)(rowp + bj * HALF + 4) = acc[ai][bj][m][1]; } }
    } else if (J.kind == EK_MERGE) {
        const bf16_t* gates = (const bf16_t*)J.p0 + J.aux * 1024; float* M = (float*)J.o0; bf16_t* MB = (bf16_t*)J.o1;
#pragma unroll
        for (int ai = 0; ai < 2; ++ai)
#pragma unroll
            for (int m = 0; m < 4; ++m) { const size_t row = (size_t)(row0 + ai * HALF + m * 16);
#pragma unroll
                for (int bj = 0; bj < 2; ++bj) { const int col = u.pn * BM + bj * HALF + cl;
                    const u32x4 g = *(const u32x4*)(gates + row * 4096 + col);
                    f32x4 v0 = acc[ai][bj][m][0], v1 = acc[ai][bj][m][1];
                    v0[0] *= bf_lo(g.x); v0[1] *= bf_hi(g.x); v0[2] *= bf_lo(g.y); v0[3] *= bf_hi(g.y); v1[0] *= bf_lo(g.z); v1[1] *= bf_hi(g.z); v1[2] *= bf_lo(g.w); v1[3] *= bf_hi(g.w);
                    float* mp = M + row * 1024 + col;
                    if (J.aux > 0) { v0 += *(const f32x4*)mp; v1 += *(const f32x4*)(mp + 4); }
                    if (J.aux < 3) { *(f32x4*)mp = v0; *(f32x4*)(mp + 4) = v1; }
                    else { u32x4 w; w.x = cvt_pk_bf16(v0[0], v0[1]); w.y = cvt_pk_bf16(v0[2], v0[3]); w.z = cvt_pk_bf16(v1[0], v1[1]); w.w = cvt_pk_bf16(v1[2], v1[3]); *(u32x4*)(MB + row * 1024 + col) = w; } } }
    } else if (J.kind == EK_RESID) {
        float* X = (float*)J.o0; const float* XI = (const float*)J.p1; const int mi = u.pm < 16 ? 0 : (u.pm < 24 ? 1 : 2); const float* gv = (const float*)J.p0 + mi * 6144 + J.aux;
#pragma unroll
        for (int bj = 0; bj < 2; ++bj) { const int col = u.pn * BM + bj * HALF + cl; const f32x4 g0 = *(const f32x4*)(gv + col), g1 = *(const f32x4*)(gv + col + 4);
#pragma unroll
            for (int ai = 0; ai < 2; ++ai)
#pragma unroll
                for (int m = 0; m < 4; ++m) { float* xp = X + (size_t)(row0 + ai * HALF + m * 16) * 1024 + col; const float* xi = XI + (size_t)(row0 + ai * HALF + m * 16) * 1024 + col;
                    const f32x4 a = *(const f32x4*)xi, b = *(const f32x4*)(xi + 4);
                    *(f32x4*)xp = a + g0 * acc[ai][bj][m][0]; *(f32x4*)(xp + 4) = b + g1 * acc[ai][bj][m][1]; } }
    } else {
        bf16_t* ACT = (bf16_t*)J.o0;
#pragma unroll
        for (int ai = 0; ai < 2; ++ai)
#pragma unroll
            for (int m = 0; m < 4; ++m) { f32x4 v0, v1;
#pragma unroll
                for (int e = 0; e < 4; ++e) { const float g0 = acc[ai][0][m][0][e], g1 = acc[ai][0][m][1][e]; v0[e] = g0 * sigmoidf_(g0) * acc[ai][1][m][0][e]; v1[e] = g1 * sigmoidf_(g1) * acc[ai][1][m][1][e]; }
                u32x4 w; w.x = cvt_pk_bf16(v0[0], v0[1]); w.y = cvt_pk_bf16(v0[2], v0[3]); w.z = cvt_pk_bf16(v1[0], v1[1]); w.w = cvt_pk_bf16(v1[2], v1[3]);
                *(u32x4*)(ACT + (size_t)(row0 + ai * HALF + m * 16) * FF + u.pn * HALF + cl) = w; }
    }
}

__device__ __forceinline__ void gemm_phase(LAS unsigned char* lds, const Job& g, const Order& S, const int tid) {
    const int wid = __builtin_amdgcn_readfirstlane(tid >> 6), lane = tid & 63, wr = wid >> 2, wc = wid & 3, fr = lane & 15, fq = lane >> 4;
    const int K = g.K, nt = K / BK;
    unsigned voffA[2], voffB[2];
#pragma unroll
    for (int i = 0; i < 2; ++i) { int R, C; stage_rc(tid * 16 + i * 8192, R, C); const int Rb = (R & ~31) + perm32(R & 31);
        voffA[i] = (unsigned)(R * g.lda + C) * 2u; voffB[i] = (unsigned)(Rb * g.ldb + C) * 2u; }
    const size_t kstep = (size_t)(BK * 2);
    const size_t hstepA = (size_t)HALF * g.lda * 2, hstepB = (size_t)HALF * g.ldb * 2;
    const size_t tstepA = 2 * hstepA, tstepB = 2 * hstepB;
    const unsigned ldsw = (unsigned)wid * 1024u;
    const int aoff = lds_byte(wr * 64 + fr, fq * 8), boff = lds_byte(wc * 32 + fr, fq * 8);
#define PG8_SA(b, h) (((b) * 2 + (h)) * HTB)
#define PG8_SB(b, h) ((4 + (b) * 2 + (h)) * HTB)
#define PG8_STAGE(bufoff, gbase, voff) do { _Pragma("unroll") for (int _i = 0; _i < 2; ++_i) \
        __builtin_amdgcn_global_load_lds((const unsigned*)((const char*)(gbase) + (voff)[_i]), (LAS unsigned*)(lds + (bufoff) + ldsw + _i * 8192), 16, 0, 0); } while (0)
#define PG8_LDA(dst, b, h) do { _Pragma("unroll") for (int m = 0; m < 4; ++m) _Pragma("unroll") for (int k = 0; k < 2; ++k) dst[m][k] = *(const LAS bf16x8*)(lds + PG8_SA(b, h) + aoff + m * 2048 + k * 1024); } while (0)
#define PG8_LDB(dst, b, h) do { _Pragma("unroll") for (int n = 0; n < 2; ++n) _Pragma("unroll") for (int k = 0; k < 2; ++k) dst[n][k] = *(const LAS bf16x8*)(lds + PG8_SB(b, h) + boff + n * 2048 + k * 1024); } while (0)
#define PG8_MMA(ai, bj, At, Bt) do { __builtin_amdgcn_s_setprio(1); _Pragma("unroll") for (int m = 0; m < 4; ++m) _Pragma("unroll") for (int n = 0; n < 2; ++n) _Pragma("unroll") for (int k = 0; k < 2; ++k) \
        acc[ai][bj][m][n] = __builtin_amdgcn_mfma_f32_16x16x32_bf16(Bt[n][k], At[m][k], acc[ai][bj][m][n], 0, 0, 0); __builtin_amdgcn_s_setprio(0); } while (0)
#define PG8_WAIT_V(n) asm volatile("s_waitcnt vmcnt(" #n ")" ::: "memory")
#define PG8_WAIT_L(n) asm volatile("s_waitcnt lgkmcnt(" #n ")" ::: "memory")
#define PG8_BAR __builtin_amdgcn_s_barrier()
#define PG8_SCHED __builtin_amdgcn_sched_barrier(0)
#define PG8_UA(u) (g.A + (size_t)((u).z & 7) * g.a_lo + (size_t)((u).z >> 3) * g.a_hi + (size_t)(u).pm * tstepA)
#define PG8_UB(u) (g.Bt + (size_t)((u).z & 7) * g.b_lo + (size_t)((u).z >> 3) * g.b_hi + (size_t)(u).pn * tstepB)
    Unit cur, nxt; int ui = 0;
    if (!S.next(0, cur)) return;
    f32x4 acc[2][2][4][2];
#pragma unroll
    for (int a = 0; a < 2; ++a)
#pragma unroll
        for (int b = 0; b < 2; ++b)
#pragma unroll
            for (int m = 0; m < 4; ++m)
#pragma unroll
                for (int n = 0; n < 2; ++n) acc[a][b][m][n] = (f32x4){0.f, 0.f, 0.f, 0.f};
    bf16x8 At[4][2], B0[2][2], B1[2][2];
    const char* cA = PG8_UA(cur); const char* cB = PG8_UB(cur);
    PG8_STAGE(PG8_SB(0, 0), cB, voffB); PG8_STAGE(PG8_SB(0, 1), cB + hstepB, voffB); PG8_STAGE(PG8_SA(0, 0), cA, voffA); PG8_STAGE(PG8_SA(0, 1), cA + hstepA, voffA);
    if (wr == 1) PG8_BAR;
    PG8_WAIT_V(2); PG8_BAR;
    PG8_STAGE(PG8_SB(1, 0), cB + kstep, voffB); PG8_STAGE(PG8_SA(1, 0), cA + kstep, voffA); PG8_STAGE(PG8_SB(1, 1), cB + hstepB + kstep, voffB);
    PG8_WAIT_V(6); PG8_BAR;
    for (;;) {
        const bool has_next = S.next(ui + 1, nxt);
        const char* nA = has_next ? PG8_UA(nxt) : cA; const char* nB = has_next ? PG8_UB(nxt) : cB;
        for (int t = 0; t < nt; t += 2) {
            const bool last = (t == nt - 2);
            const char* a1 = cA + (size_t)(t + 1) * kstep;
            const char* a2 = last ? nA : cA + (size_t)(t + 2) * kstep; const char* b2 = last ? nB : cB + (size_t)(t + 2) * kstep;
            const char* a3 = a2 + kstep; const char* b3 = b2 + kstep;
            PG8_LDB(B0, 0, 0); PG8_LDB(B1, 0, 1); PG8_SCHED; PG8_LDA(At, 0, 0); PG8_STAGE(PG8_SA(1, 1), a1 + hstepA, voffA);
            PG8_WAIT_V(8); PG8_WAIT_L(0); PG8_BAR; PG8_MMA(0, 0, At, B0); PG8_MMA(0, 1, At, B1); PG8_BAR; PG8_SCHED;
            PG8_LDA(At, 0, 1); PG8_STAGE(PG8_SB(0, 0), b2, voffB); PG8_STAGE(PG8_SB(0, 1), b2 + hstepB, voffB); PG8_STAGE(PG8_SA(0, 0), a2, voffA);
            PG8_WAIT_V(8); PG8_WAIT_L(0); PG8_BAR; PG8_MMA(1, 0, At, B0); PG8_MMA(1, 1, At, B1); PG8_BAR; PG8_SCHED;
            PG8_LDB(B0, 1, 0); PG8_LDB(B1, 1, 1); PG8_SCHED; PG8_LDA(At, 1, 0); PG8_STAGE(PG8_SA(0, 1), a2 + hstepA, voffA);
            PG8_WAIT_V(8); PG8_WAIT_L(0); PG8_BAR; PG8_MMA(0, 0, At, B0); PG8_MMA(0, 1, At, B1); PG8_BAR; PG8_SCHED;
            PG8_LDA(At, 1, 1); PG8_STAGE(PG8_SB(1, 0), b3, voffB); PG8_STAGE(PG8_SB(1, 1), b3 + hstepB, voffB); PG8_STAGE(PG8_SA(1, 0), a3, voffA);
            PG8_WAIT_V(8); PG8_WAIT_L(0); PG8_BAR; PG8_MMA(1, 0, At, B0); PG8_MMA(1, 1, At, B1); PG8_BAR; PG8_SCHED;
        }
        if (wr == 0) PG8_BAR;
        epilogue(g, acc, cur, wr, wc, fr, fq);
        if (!has_next) break;
#pragma unroll
        for (int a = 0; a < 2; ++a)
#pragma unroll
            for (int b = 0; b < 2; ++b)
#pragma unroll
                for (int m = 0; m < 4; ++m)
#pragma unroll
                    for (int n = 0; n < 2; ++n) acc[a][b][m][n] = (f32x4){0.f, 0.f, 0.f, 0.f};
        cur = nxt; cA = nA; cB = nB; ++ui;
        if (wr == 1) PG8_BAR;
    }
    PG8_WAIT_V(0);
    PG8_BAR;
#undef PG8_SA
#undef PG8_SB
#undef PG8_STAGE
#undef PG8_LDA
#undef PG8_LDB
#undef PG8_MMA
#undef PG8_WAIT_V
#undef PG8_WAIT_L
#undef PG8_BAR
#undef PG8_SCHED
#undef PG8_UA
#undef PG8_UB
}
}

namespace attn {
constexpr int KSLOT = 12288, VSLOT = 8192, BUFB = 2 * KSLOT + 2 * VSLOT;
constexpr int LDS_WS = 2 * BUFB;
constexpr int LDS_CM = LDS_WS + 2048;
constexpr int LDS_CL = LDS_CM + 1024;
constexpr int LDS_OST = LDS_CL + 512;
constexpr int LDS_END = LDS_OST + 8 * 4096;
static_assert(LDS_END <= RING_BYTES, "attention LDS");
__device__ __forceinline__ int crow(int r, int hi) { return (r & 3) + 8 * (r >> 2) + 4 * hi; }
__device__ __forceinline__ void glds16(const void* gsrc, unsigned lds_dst) { unsigned keep;
    asm volatile("s_mov_b32 %0, m0\n\ts_mov_b32 m0, %2\n\ts_nop 0\n\tglobal_load_lds_dwordx4 %1, off\n\ts_mov_b32 m0, %0" : "=&s"(keep) : "v"(gsrc), "s"(lds_dst) : "memory"); }
typedef __bf16 bf16x2_t __attribute__((ext_vector_type(2)));
__device__ __forceinline__ unsigned cvtpk_s(float lo, float hi) { f32x2 v = {lo, hi}; bf16x2_t b = __builtin_convertvector(v, bf16x2_t); return __builtin_bit_cast(unsigned, b); }
typedef LAS const char* lds_cptr;
typedef short v4i16_t __attribute__((ext_vector_type(4)));
__device__ __forceinline__ s16x4 vtr(lds_cptr p) { return __builtin_bit_cast(s16x4, __builtin_amdgcn_ds_read_tr16_b64_v4i16((LAS v4i16_t*)p)); }
__device__ __forceinline__ float swapmax(float m) { auto rr = __builtin_amdgcn_permlane32_swap(__float_as_uint(m), __float_as_uint(m), false, false); return fmaxf(__uint_as_float(rr[0]), __uint_as_float(rr[1])); }
__device__ __forceinline__ float swapsum(float m) { auto rr = __builtin_amdgcn_permlane32_swap(__float_as_uint(m), __float_as_uint(m), false, false); return __uint_as_float(rr[0]) + __uint_as_float(rr[1]); }

struct Tensors { const bf16_t* Q; const bf16_t* KV; const bf16_t* KR; bf16_t* O; };

__device__ __forceinline__ void dma_step(const Tensors& T, int krow0, int h, unsigned ldsbuf, int wid, int lane) {
#pragma unroll
    for (int i = 0; i < 5; ++i) {
        const int p = wid + 8 * i;
        const void* src; unsigned dst;
        if (p < 24) { const int j = p / 12, c = p % 12; const int row = krow0 + j * 64 + lane;
            src = (c < 8) ? (const void*)(T.KV + (size_t)row * 1024 + h * 128 + c * 8) : (const void*)(T.KR + (size_t)row * 32 + (c - 8) * 8);
            dst = ldsbuf + j * KSLOT + c * 1024; }
        else { const int pv = p - 24, j = pv >> 3, q = pv & 7; const int row = krow0 + j * 64 + 16 * (q & 3) + (lane >> 2);
            src = (const void*)(T.KV + (size_t)row * 1024 + h * 128 + 64 + (q >> 2) * 32 + (lane & 3) * 8);
            dst = ldsbuf + 2 * KSLOT + j * VSLOT + q * 1024; }
        glds16(src, (unsigned)__builtin_amdgcn_readfirstlane(dst));
    }
}

__device__ __forceinline__ void unit(const Tensors& T, int qrow0, int krow0, int nsteps, int h, char* shm, const int tid) {
    const int lane = tid & 63, r32 = lane & 31, hi = lane >> 5; const int wid = __builtin_amdgcn_readfirstlane(tid >> 6);
    const int qb = wid & 3, kh = wid >> 2;
    const unsigned lds0 = (unsigned)(uintptr_t)shm;
    float* wsf = (float*)(shm + LDS_WS) + wid * 64;
    dma_step(T, krow0, h, lds0, wid, lane);
    const bf16_t* Qw = T.Q + (size_t)(qrow0 + qb * 32 + r32) * 768 + h * 96 + hi * 8;
    bf16x8 qr[6];
#pragma unroll
    for (int d0 = 0; d0 < 6; ++d0) qr[d0] = *(const bf16x8*)(Qw + d0 * 16);
    float mhat = 0.f, l_reg = 0.f; f32x16 o[2]; o[0] = f32x16{}; o[1] = f32x16{}; f32x16 negm = f32x16{};
    const lds_cptr shm3 = (lds_cptr)shm;
    for (int s = 0; s < nsteps; ++s) {
        asm volatile("s_waitcnt vmcnt(0)" ::: "memory"); __builtin_amdgcn_s_barrier(); asm volatile("" ::: "memory");
        if (s + 1 < nsteps) dma_step(T, krow0 + (s + 1) * 128, h, lds0 + ((s + 1) & 1) * BUFB, wid, lane);
        const int bufo = (s & 1) * BUFB;
        const lds_cptr kp = shm3 + bufo + kh * KSLOT + hi * 1024 + r32 * 16;
        const lds_cptr vp = shm3 + bufo + 2 * KSLOT + kh * VSLOT + ((lane >> 4) & 1) * 32 + (lane & 3) * 8 + (4 * hi + ((lane & 15) >> 2)) * 64;
        f32x16 p0, p1;
#pragma unroll
        for (int d0 = 0; d0 < 6; ++d0) {
            const bf16x8 b0 = *(const LAS bf16x8*)(kp + d0 * 2048), b1 = *(const LAS bf16x8*)(kp + d0 * 2048 + 512);
            if (d0 == 0) { p0 = __builtin_amdgcn_mfma_f32_32x32x16_bf16(b0, qr[0], negm, 0, 0, 0); p1 = __builtin_amdgcn_mfma_f32_32x32x16_bf16(b1, qr[0], negm, 0, 0, 0); }
            else { p0 = __builtin_amdgcn_mfma_f32_32x32x16_bf16(b0, qr[d0], p0, 0, 0, 0); p1 = __builtin_amdgcn_mfma_f32_32x32x16_bf16(b1, qr[d0], p1, 0, 0, 0); } }
        float rm = fmaxf(p0[0], p1[0]);
#pragma unroll
        for (int r = 1; r < 16; ++r) rm = fmaxf(rm, fmaxf(p0[r], p1[r]));
        rm = swapmax(rm);
        bool resc = false;
        if (s == 0 || __any(rm > 8.0f)) {
            const float dl = (s == 0) ? rm : fmaxf(rm, 0.f); mhat += dl;
#pragma unroll
            for (int r = 0; r < 16; ++r) { p0[r] -= dl; p1[r] -= dl; negm[r] = -mhat; }
            if (s != 0) { const float f = __builtin_amdgcn_exp2f(-dl); l_reg *= f; if (hi == 0) wsf[r32] = f; resc = true; }
        }
        float sacc = 0.f;
#pragma unroll
        for (int r = 0; r < 16; ++r) { p0[r] = __builtin_amdgcn_exp2f(p0[r]); p1[r] = __builtin_amdgcn_exp2f(p1[r]); sacc += p0[r] + p1[r]; }
        l_reg += sacc;
        if (resc) { asm volatile("s_waitcnt lgkmcnt(0)" ::: "memory");
#pragma unroll
            for (int d_ = 0; d_ < 2; ++d_)
#pragma unroll
                for (int r = 0; r < 16; ++r) o[d_][r] *= wsf[crow(r, hi)]; }
        u32x4 pw[4];
        pw[0] = (u32x4){cvtpk_s(p0[0], p0[1]), cvtpk_s(p0[2], p0[3]), cvtpk_s(p0[4], p0[5]), cvtpk_s(p0[6], p0[7])};
        pw[1] = (u32x4){cvtpk_s(p0[8], p0[9]), cvtpk_s(p0[10], p0[11]), cvtpk_s(p0[12], p0[13]), cvtpk_s(p0[14], p0[15])};
        pw[2] = (u32x4){cvtpk_s(p1[0], p1[1]), cvtpk_s(p1[2], p1[3]), cvtpk_s(p1[4], p1[5]), cvtpk_s(p1[6], p1[7])};
        pw[3] = (u32x4){cvtpk_s(p1[8], p1[9]), cvtpk_s(p1[10], p1[11]), cvtpk_s(p1[12], p1[13]), cvtpk_s(p1[14], p1[15])};
#pragma unroll
        for (int d0 = 0; d0 < 2; ++d0)
#pragma unroll
            for (int ks = 0; ks < 4; ++ks) {
                const s16x4 lo = vtr(vp + d0 * 4096 + ks * 1024), hh = vtr(vp + d0 * 4096 + ks * 1024 + 512);
                const bf16x8 vf = (bf16x8){lo[0], lo[1], lo[2], lo[3], hh[0], hh[1], hh[2], hh[3]};
                o[d0] = __builtin_amdgcn_mfma_f32_32x32x16_bf16(__builtin_bit_cast(bf16x8, pw[ks]), vf, o[d0], 0, 0, 0); }
    }
    l_reg = swapsum(l_reg);
    float* cm = (float*)(shm + LDS_CM); float* cl = (float*)(shm + LDS_CL);
    if (hi == 0) cm[(kh * 4 + qb) * 32 + r32] = mhat;
    asm volatile("s_waitcnt lgkmcnt(0)" ::: "memory"); __builtin_amdgcn_s_barrier(); asm volatile("" ::: "memory");
    { const float mo = cm[((kh ^ 1) * 4 + qb) * 32 + r32]; const float ms = fmaxf(mhat, mo); const float f = __builtin_amdgcn_exp2f(mhat - ms); l_reg *= f;
      if (hi == 0) wsf[r32] = f; asm volatile("s_waitcnt lgkmcnt(0)" ::: "memory");
#pragma unroll
      for (int d_ = 0; d_ < 2; ++d_)
#pragma unroll
          for (int r = 0; r < 16; ++r) o[d_][r] *= wsf[crow(r, hi)]; }
    float* co = (float*)shm + qb * 2048;
    if (kh == 1) {
#pragma unroll
        for (int d_ = 0; d_ < 2; ++d_)
#pragma unroll
            for (int r = 0; r < 16; ++r) co[(d_ * 16 + r) * 64 + lane] = o[d_][r];
        if (hi == 0) cl[qb * 32 + r32] = l_reg;
    }
    asm volatile("s_waitcnt lgkmcnt(0)" ::: "memory"); __builtin_amdgcn_s_barrier(); asm volatile("" ::: "memory");
    if (kh == 0) {
#pragma unroll
        for (int d_ = 0; d_ < 2; ++d_)
#pragma unroll
            for (int r = 0; r < 16; ++r) o[d_][r] += co[(d_ * 16 + r) * 64 + lane];
        l_reg += cl[qb * 32 + r32];
        if (hi == 0) wsf[32 + r32] = l_reg; asm volatile("s_waitcnt lgkmcnt(0)" ::: "memory");
        float rli[16];
#pragma unroll
        for (int r = 0; r < 16; ++r) rli[r] = __builtin_amdgcn_rcpf(wsf[32 + crow(r, hi)]);
        bf16_t* stg = (bf16_t*)(shm + LDS_OST) + wid * 2048;
#pragma unroll
        for (int r = 0; r < 16; ++r) { const int orow = crow(r, hi);
#pragma unroll
            for (int d0 = 0; d0 < 2; ++d0) stg[orow * 64 + d0 * 32 + r32] = f2bf(o[d0][r] * rli[r]); }
        asm volatile("s_waitcnt lgkmcnt(0)" ::: "memory");
        bf16_t* Ow = T.O + (size_t)(qrow0 + qb * 32) * 512 + h * 64;
#pragma unroll
        for (int i = 0; i < 4; ++i) { const int row = i * 8 + (lane >> 3), ch = lane & 7; const u32x4 v = *(const u32x4*)(stg + row * 64 + ch * 8); *(u32x4*)(Ow + (size_t)row * 512 + ch * 8) = v; }
    }
    asm volatile("s_waitcnt lgkmcnt(0)" ::: "memory"); __builtin_amdgcn_s_barrier(); asm volatile("" ::: "memory");
}
}

#define XB_TMO      128
#define XB_XCNT(j)  (256  + 64 * (j))
#define XB_XSUB(j)  (1280 + 64 * (j))
#define XB_XGEN(j)  (2304 + 64 * (j))
#define XB_TOP      3328
#define XB_TOPGEN   3392
#define XCD_BAR_WORDS 3456
#define XB_SPIN_CAP (1u << 18)
__device__ __forceinline__ unsigned xb_ld(unsigned* p)              { return __hip_atomic_load(p, __ATOMIC_RELAXED, __HIP_MEMORY_SCOPE_AGENT); }
__device__ __forceinline__ unsigned xb_add(unsigned* p, unsigned v) { return __hip_atomic_fetch_add(p, v, __ATOMIC_RELAXED, __HIP_MEMORY_SCOPE_AGENT); }
__device__ __forceinline__ unsigned xb_xcc_id() { return (unsigned)__builtin_amdgcn_s_getreg((3 << 11) | 20) & 0xFu; }
#define XB_SPIN(cond, bar) do { unsigned _sp = 0; while (cond) { __builtin_amdgcn_s_sleep(1); \
    if ((++_sp & 255u) == 0u) { if (xb_ld(&(bar)[XB_TMO])) break; if (_sp > XB_SPIN_CAP) { atomicAdd(&(bar)[XB_TMO], 1u); break; } } } } while (0)
struct XcdBarrier { unsigned* bar; unsigned x; volatile LAS unsigned* st; };
__device__ __forceinline__ XcdBarrier xcd_barrier_post(unsigned* bar, volatile LAS unsigned* st) {
    XcdBarrier b; b.bar = bar; b.x = xb_xcc_id(); b.st = st;
    if (threadIdx.x == 0) (void)xb_add(&bar[XB_XCNT(b.x)], 1u);
    return b;
}
__device__ __forceinline__ void xcd_barrier_complete(unsigned* bar, unsigned x, unsigned& nloc, unsigned& nx) {
    const unsigned G = gridDim.x * gridDim.y * gridDim.z;
    unsigned sum, cnt, mine, sp = 0u;
    for (;;) {
        sum = 0u; cnt = 0u; mine = 0u;
#pragma unroll
        for (unsigned j = 0; j < 16; ++j) { const unsigned c = xb_ld(&bar[XB_XCNT(j)]); sum += c; cnt += (c > 0u) ? 1u : 0u; mine = (j == x) ? c : mine; }
        if (sum == G) break;
        __builtin_amdgcn_s_sleep(1);
        if ((++sp & 255u) == 0u) { if (xb_ld(&bar[XB_TMO])) break; if (sp > XB_SPIN_CAP) { atomicAdd(&bar[XB_TMO], 1u); break; } }
    }
    nloc = mine > 0u ? mine : 1u; nx = cnt > 0u ? cnt : 1u;
}
__device__ __forceinline__ void xcd_barrier(const XcdBarrier& b) {
    asm volatile("s_waitcnt vmcnt(0)" ::: "memory");
    __syncthreads();
    if (threadIdx.x == 0) {
        unsigned* bar = b.bar;
        __builtin_amdgcn_s_waitcnt(0);
        unsigned nloc = b.st[0], nx = b.st[1];
        if (nloc == 0u) { xcd_barrier_complete(bar, b.x, nloc, nx); b.st[0] = nloc; b.st[1] = nx; }
        const unsigned old = xb_add(&bar[XB_XSUB(b.x)], 1u);
        const unsigned gen = old / nloc;
        if (old + 1u == (gen + 1u) * nloc) {
            __builtin_amdgcn_fence(__ATOMIC_RELEASE, "agent");
            asm volatile("s_waitcnt vmcnt(0)" ::: "memory");
            const unsigned og = xb_add(&bar[XB_TOP], 1u);
            const unsigned tg = og / nx;
            if (og + 1u == (tg + 1u) * nx) xb_add(&bar[XB_TOPGEN], 1u);
            else XB_SPIN(xb_ld(&bar[XB_TOPGEN]) == tg, bar);
            __builtin_amdgcn_fence(__ATOMIC_ACQUIRE, "agent");
            xb_add(&bar[XB_XGEN(b.x)], 1u);
            asm volatile("s_waitcnt vmcnt(0)" ::: "memory");
        } else {
            XB_SPIN(xb_ld(&bar[XB_XGEN(b.x)]) == gen, bar);
            __builtin_amdgcn_fence(__ATOMIC_ACQUIRE, "agent");
            asm volatile("s_waitcnt vmcnt(0)" ::: "memory");
        }
    }
    __syncthreads();
}

struct Args { const float* in[29]; float* out; unsigned char* ws; int step_lo, step_hi; };
static_assert(sizeof(Args) == 31 * 8 + 8, "Args has no padding");

struct Ctx {
    LAS unsigned char* lds; int tid, lane, wave, G, gw, NGW, bid;
    float* out; unsigned char* ws;
};
__device__ __forceinline__ const float* ldarg(int i) { const char* kp = (const char*)__builtin_amdgcn_kernarg_segment_ptr(); asm volatile("" : "+s"(kp)); return *(const float* const*)(kp + 8 * i); }
#define INP(i) ldarg(i)

__device__ __forceinline__ void transpose_item(const float* W, int N, bf16_t* WT, int ldt, int k0, int n0, int drow0, LAS float* scr, int lane) {
    float v[32];
    const float* wp = W + (size_t)(k0 + (lane >> 5)) * N + n0 + (lane & 31);
#pragma unroll
    for (int i = 0; i < 32; ++i) v[i] = wp[(size_t)(2 * i) * N];
#pragma unroll
    for (int i = 0; i < 32; ++i) scr[(2 * i + (lane >> 5)) * 33 + (lane & 31)] = v[i];
    LDS_WAIT(); asm volatile("" ::: "memory");
    const int c = lane & 7;
#pragma unroll
    for (int j = 0; j < 4; ++j) { const int n = (lane >> 3) + 8 * j; const LAS float* s = scr + (8 * c) * 33 + n;
        u32x4 o; o.x = cvt_pk_bf16(s[0 * 33], s[1 * 33]); o.y = cvt_pk_bf16(s[2 * 33], s[3 * 33]); o.z = cvt_pk_bf16(s[4 * 33], s[5 * 33]); o.w = cvt_pk_bf16(s[6 * 33], s[7 * 33]);
        *(u32x4*)(WT + (size_t)(drow0 + n) * ldt + k0 + 8 * c) = o; }
    LDS_WAIT(); asm volatile("" ::: "memory");
}

__device__ __forceinline__ void prologue(Ctx& F) {
    unsigned char* ws = F.ws;
    LAS float* misc = (LAS float*)(F.lds + MISC_OFF + 1024);
    __syncthreads();
    if (F.tid < 64) { misc[F.tid] = __builtin_amdgcn_cosf((float)F.tid * (1.f / 64.f)); misc[64 + F.tid] = __builtin_amdgcn_sinf((float)F.tid * (1.f / 64.f)); }
    if (F.bid < 192) {
        LAS float* scv = (LAS float*)F.lds;
        LAS float* red = (LAS float*)(F.lds + 16384);
        for (int i = F.tid; i < 3072; i += 512) { const int m = i >> 10, k = i & 1023; const float v = (m == 0) ? INP(5)[k] : INP(4)[(m - 1) * 1024 + k]; scv[i] = v * sigmoidf_(v); }
        __syncthreads();
        const int l = F.bid / 96, c0 = (F.bid % 96) * 64;
        const float* w = INP(6) + (size_t)l * 1024 * 6144 + c0 + F.lane;
        float a0 = 0.f, a1 = 0.f, a2 = 0.f;
        const int kb = F.wave * 128;
#pragma unroll 16
        for (int k = 0; k < 128; ++k) { const float wv = w[(size_t)(kb + k) * 6144]; a0 += scv[kb + k] * wv; a1 += scv[1024 + kb + k] * wv; a2 += scv[2048 + kb + k] * wv; }
        red[(F.wave * 3 + 0) * 64 + F.lane] = a0; red[(F.wave * 3 + 1) * 64 + F.lane] = a1; red[(F.wave * 3 + 2) * 64 + F.lane] = a2;
        __syncthreads();
        if (F.wave < 3) { float s = INP(7)[l * 6144 + c0 + F.lane];
#pragma unroll
            for (int w8 = 0; w8 < 8; ++w8) s += red[(w8 * 3 + F.wave) * 64 + F.lane];
            ((float*)(ws + WS_MOD))[(l * 3 + F.wave) * 6144 + c0 + F.lane] = s; }
        __syncthreads();
    } else __syncthreads();
    LAS float* scr = (LAS float*)(F.lds + F.wave * 16384);
    for (int l = 0; l < DEPTH; ++l) {
        unsigned char* wl = ws + WS_W + (size_t)l * W_LAYER;
        {
            const float* W = INP(10) + (size_t)l * 1024 * IN_COLS; bf16_t* WT = (bf16_t*)(wl + W_IN); constexpr int nblk = IN_COLS / 32;
            for (int it = F.gw; it < 16 * nblk; it += F.NGW) { const int kb = it / nblk, nb = it % nblk, n0 = nb * 32;
                if (n0 >= OFF_FN && n0 < OFF_GATE) continue;
                const int dr = (n0 < OFF_FN) ? n0 : 2560 + (n0 - OFF_GATE);
                transpose_item(W, IN_COLS, WT, 1024, kb * 64, n0, dr, scr, F.lane); }
            for (int it = F.gw; it < 96 * 2; it += F.NGW) { const int r = 2464 + it / 2, h = it & 1; *(u32x4*)(WT + (size_t)r * 1024 + h * 512 + F.lane * 8) = (u32x4){0u, 0u, 0u, 0u}; }
        }
#define TR_SIMPLE(idx, KK, NN, OFF) { const float* W = INP(idx) + (size_t)l * (KK) * (NN); bf16_t* WT = (bf16_t*)(wl + (OFF)); constexpr int nblk = (NN) / 32; \
            for (int it = F.gw; it < ((KK) / 64) * nblk; it += F.NGW) { const int kb = it / nblk, nb = it % nblk; transpose_item(W, (NN), WT, (KK), kb * 64, nb * 32, nb * 32, scr, F.lane); } }
        TR_SIMPLE(12, 384, 768, W_QB)
        TR_SIMPLE(14, 256, 1024, W_KVB)
        TR_SIMPLE(15, 512, 1024, W_O)
        TR_SIMPLE(20, 256, 1024, W_CPW)
        TR_SIMPLE(22, 256, 1024, W_SCO)
        TR_SIMPLE(23, 256, 1024, W_FN)
        TR_SIMPLE(24, 1024, 1024, W_OUT)
        TR_SIMPLE(27, 2816, 1024, W_DN)
#undef TR_SIMPLE
        for (int gu = 0; gu < 2; ++gu) {
            const float* W = (gu ? INP(26) : INP(25)) + (size_t)l * 1024 * FF; bf16_t* WT = (bf16_t*)(wl + W_GU); constexpr int nblk = FF / 32;
            for (int it = F.gw; it < 16 * nblk; it += F.NGW) { const int kb = it / nblk, nb = it % nblk, n0 = nb * 32;
                transpose_item(W, FF, WT, 1024, kb * 64, n0, (n0 / 128) * 256 + gu * 128 + (n0 % 128), scr, F.lane); }
        }
        {
            const float* W = INP(10) + (size_t)l * 1024 * IN_COLS; bf16_t* WT = (bf16_t*)(wl + W_IN);
            for (int it = F.gw; it < 128; it += F.NGW) { const int kc = it >> 2, g = it & 3, k0 = kc * 32;
#pragma unroll 8
                for (int i = 0; i < 32; ++i) scr[i * 64 + F.lane] = W[(size_t)(k0 + i) * IN_COLS + OFF_FN + g * 64 + F.lane];
                LDS_WAIT(); asm volatile("" ::: "memory");
                float aP[32], aQ[32];
#pragma unroll
                for (int k = 0; k < 32; ++k) { aP[k] = 0.f; aQ[k] = 0.f; }
                for (int n4 = 0; n4 < 16; ++n4) { float c[4], sn[4];
#pragma unroll
                    for (int e = 0; e < 4; ++e) { const int ix = (F.lane * (4 * n4 + e)) & 63; c[e] = misc[ix]; sn[e] = misc[64 + ix]; }
#pragma unroll
                    for (int k = 0; k < 32; ++k) { const f32x4 w = *(const LAS f32x4*)(scr + k * 64 + 4 * n4);
                        aP[k] += w.x * c[0] + w.y * c[1] + w.z * c[2] + w.w * c[3]; aQ[k] += w.x * sn[0] + w.y * sn[1] + w.z * sn[2] + w.w * sn[3]; } }
                bf16_t* rp = WT + (size_t)(OFF_FN + g * 64 + F.lane) * 1024 + k0; bf16_t* rq = WT + (size_t)(OFF_GATE + g * 64 + F.lane) * 1024 + k0;
#pragma unroll
                for (int j = 0; j < 4; ++j) {
                    *(u32x4*)(rp + 8 * j) = (u32x4){cvt_pk_bf16(aP[8 * j] * 0.125f, aP[8 * j + 1] * 0.125f), cvt_pk_bf16(aP[8 * j + 2] * 0.125f, aP[8 * j + 3] * 0.125f), cvt_pk_bf16(aP[8 * j + 4] * 0.125f, aP[8 * j + 5] * 0.125f), cvt_pk_bf16(aP[8 * j + 6] * 0.125f, aP[8 * j + 7] * 0.125f)};
                    *(u32x4*)(rq + 8 * j) = (u32x4){cvt_pk_bf16(aQ[8 * j] * 0.125f, aQ[8 * j + 1] * 0.125f), cvt_pk_bf16(aQ[8 * j + 2] * 0.125f, aQ[8 * j + 3] * 0.125f), cvt_pk_bf16(aQ[8 * j + 4] * 0.125f, aQ[8 * j + 5] * 0.125f), cvt_pk_bf16(aQ[8 * j + 6] * 0.125f, aQ[8 * j + 7] * 0.125f)}; }
                LDS_WAIT(); asm volatile("" ::: "memory");
            }
        }
    }
    {
        bf16_t* TL = (bf16_t*)(ws + WS_DFTL); const int gt = F.gw * 64 + F.lane, NT = F.NGW * 64;
        for (int it = gt; it < 2048 * 512; it += NT) { const int k = it >> 9, c8 = (it & 511) * 8; float v[8];
#pragma unroll
            for (int e = 0; e < 8; ++e) { const int c = c8 + e, t = c & 2047; const float fr = (float)((k * t) & 2047) * (1.f / 2048.f);
                v[e] = ((c < 2048) ? __builtin_amdgcn_cosf(fr) : -__builtin_amdgcn_sinf(fr)) * 0.022097086912079608f; }
            *(u32x4*)(TL + (size_t)k * 4096 + c8) = (u32x4){cvt_pk_bf16(v[0], v[1]), cvt_pk_bf16(v[2], v[3]), cvt_pk_bf16(v[4], v[5]), cvt_pk_bf16(v[6], v[7])}; }
        bf16_t* TC = (bf16_t*)(ws + WS_DFTC);
        for (int it = gt; it < 256 * 64; it += NT) { const int k = it >> 6, c8 = (it & 63) * 8; float v[8];
#pragma unroll
            for (int e = 0; e < 8; ++e) { const int c = c8 + e, t = c & 255; const float fr = (float)((k * t) & 255) * (1.f / 256.f);
                v[e] = ((c < 256) ? __builtin_amdgcn_cosf(fr) : -__builtin_amdgcn_sinf(fr)) * 0.0625f; }
            *(u32x4*)(TC + (size_t)k * 512 + c8) = (u32x4){cvt_pk_bf16(v[0], v[1]), cvt_pk_bf16(v[2], v[3]), cvt_pk_bf16(v[4], v[5]), cvt_pk_bf16(v[6], v[7])}; }
        if (F.gw == F.NGW - 1) { float* R = (float*)(ws + WS_ROPE);
            for (int i = F.lane; i < 512; i += 64) { const int pos = i >> 3, f = i & 7; const float inv = __builtin_amdgcn_exp2f(-(float)f * 1.6609640474436813f);
                const float rev = ((float)pos * inv) * 0.15915494309189535f; R[2 * i] = __builtin_amdgcn_cosf(rev); R[2 * i + 1] = __builtin_amdgcn_sinf(rev); } }
    }
}

__device__ __forceinline__ void norm_row(const float* xrow, float* xcopy, const float* g, const float* sc, const float* sh, bf16_t* orow, int lane) {
    const f32x4* xr = (const f32x4*)xrow + lane; f32x4 v[4]; float s = 0.f;
#pragma unroll
    for (int j = 0; j < 4; ++j) { v[j] = xr[64 * j]; s += (v[j].x * v[j].x + v[j].y * v[j].y) + (v[j].z * v[j].z + v[j].w * v[j].w); }
    if (xcopy) {
#pragma unroll
        for (int j = 0; j < 4; ++j) ((f32x4*)xcopy + lane)[64 * j] = v[j]; }
    const float rstd = 1.f / sqrtf(wave_sum(s) * (1.f / D) + EPS);
#pragma unroll
    for (int j = 0; j < 4; ++j) { const int c = 4 * (64 * j + lane); const f32x4 gg = *(const f32x4*)(g + c), ss = *(const f32x4*)(sc + c), hh = *(const f32x4*)(sh + c);
        const f32x4 y = v[j] * rstd * gg * (ss + 1.f) + hh;
        *(u32x2*)(orow + c) = (u32x2){cvt_pk_bf16(y.x, y.y), cvt_pk_bf16(y.z, y.w)}; }
}
__device__ __forceinline__ int mod_of_row(int r) { return r < NCTX ? 0 : 1 + ((r - NCTX) >> 11); }
__device__ __forceinline__ int kvrow_of_row(int r) { return r < NCTX ? r : NCTX + ((r - NCTX) >> 11) * 2304 + 256 + ((r - NCTX) & 2047); }

__device__ __forceinline__ void phase_norm(Ctx& F, int l, int which  ) {
    const float* mod = (const float*)(F.ws + WS_MOD) + l * 3 * 6144; const float* g = (which ? INP(9) : INP(8)) + l * D;
    bf16_t* XN = (bf16_t*)(F.ws + WS_XN); const float* x0 = INP(0); const float* x1 = INP(1);
    for (int r = F.gw; r < MROWS; r += F.NGW) { const float* m = mod + mod_of_row(r) * 6144 + (which ? 3072 : 0);
        const bool first = (l == 0 && which == 0);
        const float* xrow = first ? (r < NCTX ? x0 + (size_t)r * D : x1 + (size_t)(r - NCTX) * D) : F.out + (size_t)r * D;
        norm_row(xrow, first ? F.out + (size_t)r * D : nullptr, g, m + 1024, m, XN + (size_t)r * D, F.lane); }
}

__device__ __forceinline__ void phase_prep(Ctx& F, int l) {
    unsigned char* ws = F.ws; const int lane = F.lane;
    const bf16_t* PROJ = (const bf16_t*)(ws + WS_PROJ);
    bf16_t* QN = (bf16_t*)(ws + WS_XN + XN_QN); bf16_t* CKV = (bf16_t*)(ws + WS_XN + XN_CKV); bf16_t* KR = (bf16_t*)(ws + WS_XN + XN_KR); bf16_t* UC = (bf16_t*)(ws + WS_XN + XN_UC);
    bf16_t* SC = (bf16_t*)(ws + WS_SC);
    float* out_ckv = F.out + (size_t)MROWS * D; float* out_kr = out_ckv + (size_t)NBC * DEPTH * SEQ * KVL;
    const float* rope = (const float*)(ws + WS_ROPE);
    {
        LAS float* ut = (LAS float*)F.lds;
        LAS float* wl = (LAS float*)(F.lds + 65536);
        const float* wdw = INP(16) + l * 31 * 256; const float* bdw = INP(17) + l * 256; const float* gln = INP(18) + l * 256; const float* bln = INP(19) + l * 256;
        __syncthreads();
        for (int i = F.tid; i < 31 * 256; i += 512) wl[i] = wdw[i];
        for (int item = F.bid; item < 256; item += F.G) {
            const int r0 = item * 32; const int s0 = r0 < NCTX ? (r0 & ~255) : NCTX + ((r0 - NCTX) & ~2047); const int s1 = s0 + (r0 < NCTX ? 256 : 2048);
            __syncthreads();
            for (int idx = F.tid; idx < 62 * 128; idx += 512) { const int rr = idx >> 7, cp = idx & 127; const int row = r0 - 15 + rr; float u0 = 0.f, u1 = 0.f;
                if (row >= s0 && row < s1) { const unsigned a = *(const unsigned*)(PROJ + (size_t)row * PROJ_LD + OFF_CONF + 2 * cp), b = *(const unsigned*)(PROJ + (size_t)row * PROJ_LD + OFF_CONF + 256 + 2 * cp);
                    u0 = bf_lo(a) * sigmoidf_(bf_lo(b)); u1 = bf_hi(a) * sigmoidf_(bf_hi(b)); }
                ut[rr * 256 + 2 * cp] = u0; ut[rr * 256 + 2 * cp + 1] = u1; }
            __syncthreads();
            float acc[4][4];
#pragma unroll
            for (int q = 0; q < 4; ++q) { const float b = bdw[lane + 64 * q];
#pragma unroll
                for (int ri = 0; ri < 4; ++ri) acc[ri][q] = b; }
            for (int j = 0; j < 31; ++j) {
#pragma unroll
                for (int q = 0; q < 4; ++q) { const float w = wl[j * 256 + lane + 64 * q];
#pragma unroll
                    for (int ri = 0; ri < 4; ++ri) acc[ri][q] += ut[(4 * F.wave + ri + j) * 256 + lane + 64 * q] * w; } }
#pragma unroll
            for (int ri = 0; ri < 4; ++ri) { const float mean = wave_sum(acc[ri][0] + acc[ri][1] + acc[ri][2] + acc[ri][3]) * (1.f / 256.f); float q2 = 0.f;
#pragma unroll
                for (int q = 0; q < 4; ++q) { const float d = acc[ri][q] - mean; q2 += d * d; }
                const float rstd = 1.f / sqrtf(wave_sum(q2) * (1.f / 256.f) + EPS);
#pragma unroll
                for (int q = 0; q < 4; ++q) { const int c = lane + 64 * q; const float y = (acc[ri][q] - mean) * rstd * gln[c] + bln[c]; UC[(size_t)(r0 + 4 * F.wave + ri) * 256 + c] = f2bf(y * sigmoidf_(y)); } }
        }
        __syncthreads();
    }
    const float* gqa = INP(11) + l * QL; const float* gkva = INP(13) + l * KVL; const float* wc3 = INP(21) + l * 3 * 256;
    for (int r = F.gw; r < MROWS; r += F.NGW) {
        const bf16_t* pr = PROJ + (size_t)r * PROJ_LD; const int mr = kvrow_of_row(r);
        {
            float v[6]; float s = 0.f;
#pragma unroll
            for (int j = 0; j < 3; ++j) { const unsigned u = *(const unsigned*)(pr + 2 * lane + 128 * j); v[2 * j] = bf_lo(u); v[2 * j + 1] = bf_hi(u); s += v[2 * j] * v[2 * j] + v[2 * j + 1] * v[2 * j + 1]; }
            const float rstd = 1.f / sqrtf(wave_sum(s) * (1.f / QL) + EPS);
#pragma unroll
            for (int j = 0; j < 3; ++j) { const int c = 2 * lane + 128 * j; *(unsigned*)(QN + (size_t)r * QL + c) = cvt_pk_bf16(v[2 * j] * rstd * gqa[c], v[2 * j + 1] * rstd * gqa[c + 1]); }
        }
        {
            const u32x2 u = *(const u32x2*)(pr + OFF_KVA + 4 * lane); f32x4 v = {bf_lo(u.x), bf_hi(u.x), bf_lo(u.y), bf_hi(u.y)};
            const float rstd = 1.f / sqrtf(wave_sum((v.x * v.x + v.y * v.y) + (v.z * v.z + v.w * v.w)) * (1.f / KVL) + EPS);
            v = v * rstd * *(const f32x4*)(gkva + 4 * lane);
            *(u32x2*)(CKV + (size_t)mr * KVL + 4 * lane) = (u32x2){cvt_pk_bf16(v.x, v.y), cvt_pk_bf16(v.z, v.w)};
            if (r < NCTX) { const int b = r >> 8, t = r & 255; *(f32x4*)(out_ckv + ((size_t)(b * DEPTH + l) * SEQ + t) * KVL + 4 * lane) = v; }
        }
        {
            const float v = bf1(pr[OFF_KR + (lane & 31)]);
            if (r < NCTX) { if (lane < 32) { const int b = r >> 8, t = r & 255; out_kr[((size_t)(b * DEPTH + l) * SEQ + t) * QKR + lane] = v; KR[(size_t)mr * QKR + lane] = f2bf(v); } }
            else { const int t = (r - NCTX) & 2047, j = lane & 31; const int pos = (j & 16) ? (t & 63) : (t >> 6); const float c = rope[(pos * 8 + (j & 7)) * 2], s = rope[(pos * 8 + (j & 7)) * 2 + 1];
                const float p = __shfl_xor(v, 8); const float o = (j & 8) ? (v * c + p * s) : (v * c - p * s);
                if (lane < 32) KR[(size_t)mr * QKR + lane] = f2bf(o); }
        }
        {
            const int s0 = r < NCTX ? (r & ~255) : NCTX + ((r - NCTX) & ~2047); const int s1 = s0 + (r < NCTX ? 256 : 2048);
            f32x4 a = {0.f, 0.f, 0.f, 0.f};
#pragma unroll
            for (int d = 0; d < 3; ++d) { const int row = r + d - 1;
                if (row >= s0 && row < s1) { const bf16_t* q = PROJ + (size_t)row * PROJ_LD + OFF_SC; const u32x2 gc = *(const u32x2*)(q + 256 + 4 * lane), xs = *(const u32x2*)(q + 512 + 4 * lane);
                    const f32x4 w = *(const f32x4*)(wc3 + d * 256 + 4 * lane);
                    a.x += w.x * bf_lo(gc.x) * bf_lo(xs.x); a.y += w.y * bf_hi(gc.x) * bf_hi(xs.x); a.z += w.z * bf_lo(gc.y) * bf_lo(xs.y); a.w += w.w * bf_hi(gc.y) * bf_hi(xs.y); } }
            const u32x2 gb = *(const u32x2*)(pr + OFF_SC + 4 * lane);
            *(u32x2*)(SC + (size_t)r * 256 + 4 * lane) = (u32x2){cvt_pk_bf16(a.x * bf_lo(gb.x), a.y * bf_hi(gb.x)), cvt_pk_bf16(a.z * bf_lo(gb.y), a.w * bf_hi(gb.y))};
        }
    }
    const float* cckv = INP(2); const float* ckr = INP(3);
    for (int i = F.gw; i < NBL * PAST; i += F.NGW) { const int b = i >> 8, p = i & 255; const int mr = NCTX + b * 2304 + p;
        const f32x4 v = *(const f32x4*)(cckv + ((size_t)(b * DEPTH + l) * PAST + p) * KVL + 4 * lane);
        *(u32x2*)(CKV + (size_t)mr * KVL + 4 * lane) = (u32x2){cvt_pk_bf16(v.x, v.y), cvt_pk_bf16(v.z, v.w)};
        if (lane < 32) KR[(size_t)mr * QKR + lane] = f2bf(ckr[((size_t)(b * DEPTH + l) * PAST + p) * QKR + lane]); }
    {
        LAS bf16_t* tl = (LAS bf16_t*)(F.lds + F.wave * 16384);
        bf16_t* PQL = (bf16_t*)(ws + WS_PQL); bf16_t* PQC = (bf16_t*)(ws + WS_PQC);
        for (int it = F.gw; it < 128 * 8; it += F.NGW) { const int rc = it >> 3, part = (it >> 2) & 1, cq = it & 3;
            const int col0 = (part ? OFF_GATE : OFF_FN) + cq * 64;
#pragma unroll 4
            for (int i = 0; i < 32; ++i) { const int t = 2 * i + (lane >> 5), c2 = lane & 31; const unsigned u = *(const unsigned*)(PROJ + (size_t)(rc * 64 + t) * PROJ_LD + col0 + 2 * c2);
                tl[(2 * c2) * 72 + t] = (bf16_t)(u & 0xffffu); tl[(2 * c2 + 1) * 72 + t] = (bf16_t)(u >> 16); }
            LDS_WAIT(); asm volatile("" ::: "memory");
            bf16_t* dst; int ldd;
            if (rc < 64) { const int b = rc >> 2, t0 = (rc & 3) * 64; dst = PQC + ((size_t)b * 256 + cq * 64) * 512 + part * 256 + t0; ldd = 512; }
            else { const int b = (rc - 64) >> 5, t0 = ((rc - 64) & 31) * 64; dst = PQL + ((size_t)b * 256 + cq * 64) * 4096 + part * 2048 + t0; ldd = 4096; }
#pragma unroll
            for (int i = 0; i < 8; ++i) { const int ch = 8 * i + (lane >> 3), t8 = (lane & 7) * 8; const u32x4 v = *(const LAS u32x4*)(tl + ch * 72 + t8); *(u32x4*)(dst + (size_t)ch * ldd + t8) = v; }
            LDS_WAIT(); asm volatile("" ::: "memory");
        }
    }
}

__device__ __forceinline__ void phase_attn(Ctx& F) {
    unsigned char* ws = F.ws;
    {
        const float* P = (const float*)(ws + WS_DFTP); bf16_t* Fo = (bf16_t*)(ws + WS_F) + (size_t)NCTX * 256;
        const int gt = F.gw * 64 + F.lane, NT = F.NGW * 64;
        for (int it = gt; it < NLAT * 64; it += NT) { const int row = it >> 6, c4 = (it & 63) * 4; const int b = row >> 11, k = row & 2047; f32x4 s = {0.f, 0.f, 0.f, 0.f};
#pragma unroll
            for (int ks = 0; ks < 8; ++ks) s += *(const f32x4*)(P + ((size_t)(b * 8 + ks) * 2048 + k) * 256 + c4);
            *(u32x2*)(Fo + (size_t)row * 256 + c4) = (u32x2){cvt_pk_bf16(s.x, s.y), cvt_pk_bf16(s.z, s.w)}; }
    }
    attn::Tensors T{(const bf16_t*)(ws + WS_PROJ + PJ_Q), (const bf16_t*)(ws + WS_PROJ + PJ_KV), (const bf16_t*)(ws + WS_XN + XN_KR), (bf16_t*)(ws + WS_PROJ + PJ_O)};
    for (int u = F.bid; u < 512; u += F.G) {
        if (u < 256) { const int b = u >> 7, h = (u >> 4) & 7, qb = u & 15;
            attn::unit(T, NCTX + b * 2048 + qb * 128, NCTX + b * 2304, 18, h, (char*)F.lds, F.tid); }
        else { const int v = u - 256; const int b = v >> 4, h = (v >> 1) & 7, qb = v & 1;
            attn::unit(T, b * 256 + qb * 128, b * 256, 2, h, (char*)F.lds, F.tid); }
    }
}

__device__ __forceinline__ void phase_final(Ctx& F) {
    const float* g = INP(28);
    for (int r = F.gw; r < MROWS; r += F.NGW) { f32x4* xr = (f32x4*)(F.out + (size_t)r * D) + F.lane; f32x4 v[4]; float s = 0.f;
#pragma unroll
        for (int j = 0; j < 4; ++j) { v[j] = xr[64 * j]; s += (v[j].x * v[j].x + v[j].y * v[j].y) + (v[j].z * v[j].z + v[j].w * v[j].w); }
        const float rstd = 1.f / sqrtf(wave_sum(s) * (1.f / D) + EPS);
#pragma unroll
        for (int j = 0; j < 4; ++j) xr[64 * j] = v[j] * rstd * *(const f32x4*)(g + 4 * (64 * j + F.lane)); }
}

constexpr int STEPS_PER_LAYER = 16, N_STEPS = 2 + DEPTH * STEPS_PER_LAYER;
__host__ __device__ constexpr bool barrier_after(int s) {
    if (s == 0) return true; if (s >= N_STEPS - 1) return false;
    const int k = (s - 1) % STEPS_PER_LAYER;
    return !(k == 3 || k == 4 || k == 5 || k == 8 || k == 9 || k == 10);
}

__global__ void __launch_bounds__(512, 2) mk_fwd(Args args) {
    extern __shared__ __attribute__((aligned(16))) unsigned char lds_raw[];
    volatile LAS unsigned* MISC = (volatile LAS unsigned*)((LAS unsigned char*)lds_raw + MISC_OFF);
    if (threadIdx.x < 64) MISC[threadIdx.x] = 0u;
    __syncthreads();
    XcdBarrier bar; bar.bar = (unsigned*)(args.ws + WS_CTL) + 1024; bar.x = 0; bar.st = nullptr;
    if (MK_N_LAUNCHES == 1) bar = xcd_barrier_post((unsigned*)(args.ws + WS_CTL) + 1024, MISC + 8);
    for (int step = args.step_lo; step < args.step_hi; ++step) {
        const int kprobe = (step == 0) ? 16 : (step == N_STEPS - 1) ? 17 : (step - 1) % STEPS_PER_LAYER;
        const int nrep = ((PROBE_MASK >> kprobe) & 1) ? 2 : 1;
      for (int rep = 0; rep < nrep; ++rep) {
        unsigned char* ws = args.ws; float* outp = args.out; int tid_ = threadIdx.x; int bid_ = blockIdx.x;
        asm volatile("" : "+s"(ws), "+s"(outp), "+v"(tid_), "+s"(bid_));
        Ctx F; F.lds = (LAS unsigned char*)lds_raw; F.tid = tid_; F.lane = F.tid & 63; F.wave = __builtin_amdgcn_readfirstlane(F.tid >> 6);
        F.G = gridDim.x; F.gw = bid_ * 8 + F.wave; F.NGW = F.G * 8; F.out = outp; F.ws = ws; F.bid = bid_;
        bool isgemm = false; pg8::Job J{};
        if (step == 0) prologue(F);
        else if (step == N_STEPS - 1) phase_final(F);
        else {
            const int l = (step - 1) / STEPS_PER_LAYER, k = (step - 1) % STEPS_PER_LAYER;
            unsigned char* wl = ws + WS_W + (size_t)l * W_LAYER;
            const float* modl = (const float*)(ws + WS_MOD) + l * 3 * 6144;
            J.nZ = 1; J.a_lo = J.a_hi = J.b_lo = J.b_hi = 0; J.zso = 0; J.aux = 0; J.ldc = 0;
            switch (k) {
            case 0: phase_norm(F, l, 0); break;
            case 1: isgemm = true; J.A = (const char*)(ws + WS_XN); J.Bt = (const char*)(wl + W_IN); J.lda = 1024; J.ldb = 1024; J.K = 1024; J.nM = 32; J.nN = 26; J.kind = pg8::EK_PROJ;
                    J.o0 = ws + WS_PROJ; J.o1 = ws + WS_GATES; break;
            case 2: phase_prep(F, l); break;
            case 3: isgemm = true; J.A = (const char*)(ws + WS_XN + XN_QN); J.Bt = (const char*)(wl + W_QB); J.lda = 384; J.ldb = 384; J.K = 384; J.nM = 32; J.nN = 3; J.kind = pg8::EK_Q;
                    J.o0 = ws + WS_PROJ + PJ_Q; J.p0 = ws + WS_ROPE; break;
            case 4: isgemm = true; J.A = (const char*)(ws + WS_XN + XN_CKV); J.Bt = (const char*)(wl + W_KVB); J.lda = 256; J.ldb = 256; J.K = 256; J.nM = 34; J.nN = 4; J.kind = pg8::EK_BF16;
                    J.o0 = ws + WS_PROJ + PJ_KV; J.ldc = 1024; break;
            case 5: isgemm = true; J.A = (const char*)(ws + WS_DFTL); J.Bt = (const char*)(ws + WS_PQL); J.lda = 4096; J.ldb = 4096; J.K = 512; J.nM = 8; J.nN = 1; J.nZ = 16; J.kind = pg8::EK_F32;
                    J.a_lo = 1024; J.a_hi = 0; J.b_lo = 1024; J.b_hi = (long)256 * 4096 * 2; J.o0 = ws + WS_DFTP; J.ldc = 256; J.zso = (long)2048 * 256; break;
            case 6: isgemm = true; J.A = (const char*)(ws + WS_DFTC); J.Bt = (const char*)(ws + WS_PQC); J.lda = 512; J.ldb = 512; J.K = 512; J.nM = 1; J.nN = 1; J.nZ = 16; J.kind = pg8::EK_BF16;
                    J.b_lo = (long)256 * 512 * 2; J.b_hi = (long)8 * 256 * 512 * 2; J.o0 = ws + WS_F; J.ldc = 256; J.zso = (long)256 * 256; break;
            case 7: phase_attn(F); break;
            case 8: isgemm = true; J.A = (const char*)(ws + WS_PROJ + PJ_O); J.Bt = (const char*)(wl + W_O); J.lda = 512; J.ldb = 512; J.K = 512; J.aux = 0; goto merge_common;
            case 9: isgemm = true; J.A = (const char*)(ws + WS_XN + XN_UC); J.Bt = (const char*)(wl + W_CPW); J.lda = 256; J.ldb = 256; J.K = 256; J.aux = 1; goto merge_common;
            case 10: isgemm = true; J.A = (const char*)(ws + WS_SC); J.Bt = (const char*)(wl + W_SCO); J.lda = 256; J.ldb = 256; J.K = 256; J.aux = 2; goto merge_common;
            case 11: isgemm = true; J.A = (const char*)(ws + WS_F); J.Bt = (const char*)(wl + W_FN); J.lda = 256; J.ldb = 256; J.K = 256; J.aux = 3;
            merge_common: J.nM = 32; J.nN = 4; J.kind = pg8::EK_MERGE; J.o0 = ws + WS_DFTP; J.o1 = ws + WS_PROJ + PJ_Q; J.p0 = ws + WS_GATES; break;
            case 12: isgemm = true; J.A = (const char*)(ws + WS_PROJ + PJ_Q); J.Bt = (const char*)(wl + W_OUT); J.lda = 1024; J.ldb = 1024; J.K = 1024; J.nM = 32; J.nN = 4; J.kind = pg8::EK_RESID;
                    J.o0 = F.out; J.p1 = F.out; J.p0 = modl; J.aux = 2048; break;
            case 13: phase_norm(F, l, 1); break;
            case 14: isgemm = true; J.A = (const char*)(ws + WS_XN); J.Bt = (const char*)(wl + W_GU); J.lda = 1024; J.ldb = 1024; J.K = 1024; J.nM = 32; J.nN = 22; J.kind = pg8::EK_SWIGLU;
                    J.o0 = ws + WS_GATES; break;
            default: isgemm = true; J.A = (const char*)(ws + WS_GATES); J.Bt = (const char*)(wl + W_DN); J.lda = FF; J.ldb = FF; J.K = FF; J.nM = 32; J.nN = 4; J.kind = pg8::EK_RESID;
                    J.o0 = F.out; J.p1 = F.out; J.p0 = modl; J.aux = 5120; break;
            }
        }
        if (PROBE_MASK != 0 && rep + 1 < nrep && J.kind == pg8::EK_RESID) J.o0 = ws + WS_DFTP;
        if (isgemm) { pg8::Order S; S.init(J, F.G, F.bid); pg8::gemm_phase(F.lds, J, S, F.tid); }
      }
        if (step + 1 < args.step_hi && barrier_after(step)) { xcd_barrier(bar); if ((PROBE_MASK >> 18) & 1) xcd_barrier(bar); }
    }
}

extern "C" void kernel_launch(void* const* d_in, const int* in_sizes, int n_in, void* d_out, int out_size, void* d_ws, size_t ws_size, hipStream_t stream) {
    static int grid = 0;
    if (grid == 0) {
        if (n_in != 29 || ws_size < WS_END) { fprintf(stderr, "kernel_launch: expected 29 inputs and >= %zu bytes of workspace; got %d, %zu\n", (size_t)WS_END, n_in, ws_size); grid = -1; return; }
        int dev = 0, cus = 0, per_cu = 0;
        if (hipGetDevice(&dev) != hipSuccess || hipDeviceGetAttribute(&cus, hipDeviceAttributeMultiprocessorCount, dev) != hipSuccess) { grid = -1; return; }
        if (hipFuncSetAttribute((const void*)mk_fwd, hipFuncAttributeMaxDynamicSharedMemorySize, LDS_BYTES) != hipSuccess) { fprintf(stderr, "kernel_launch: hipFuncSetAttribute failed\n"); grid = -1; return; }
        if (hipOccupancyMaxActiveBlocksPerMultiprocessor(&per_cu, (const void*)mk_fwd, 512, LDS_BYTES) != hipSuccess || per_cu < 1) fprintf(stderr, "kernel_launch: occupancy query reports %d\n", per_cu);
        (void)hipGetLastError();
        grid = cus;
    }
    if (grid < 0) return;
    (void)hipMemsetAsync((char*)d_ws + WS_CTL, 0, CTL_ZERO_BYTES, stream);
    Args a{};
    for (int i = 0; i < 29; ++i) a.in[i] = (const float*)d_in[i];
    a.out = (float*)d_out; a.ws = (unsigned char*)d_ws;
    if (MK_N_LAUNCHES == 1) { a.step_lo = 0; a.step_hi = N_STEPS; hipLaunchKernelGGL(mk_fwd, dim3(grid), dim3(512), LDS_BYTES, stream, a); }
    else {
        int lo = 0;
        for (int s = 0; s < N_STEPS; ++s) if (barrier_after(s) || s == N_STEPS - 1) { a.step_lo = lo; a.step_hi = s + 1; hipLaunchKernelGGL(mk_fwd, dim3(grid), dim3(512), LDS_BYTES, stream, a); lo = s + 1; }
    }
}
```

```cpp
#include <hip/hip_runtime.h>
#include <hip/hip_bf16.h>
#include <cstdio>
#include <cstdint>

#ifndef MK_N_LAUNCHES
#define MK_N_LAUNCHES 1
#endif
#ifndef PROBE_MASK
#define PROBE_MASK 0x0
#endif

#define LAS __attribute__((address_space(3)))
#define GAS __attribute__((address_space(1)))
typedef unsigned short bf16_t;
typedef short bf16x8 __attribute__((ext_vector_type(8)));
typedef short s16x4 __attribute__((ext_vector_type(4)));
typedef float f32x4 __attribute__((ext_vector_type(4)));
typedef float f32x2 __attribute__((ext_vector_type(2)));
typedef float f32x16 __attribute__((ext_vector_type(16)));
typedef unsigned u32x4 __attribute__((ext_vector_type(4)));
typedef unsigned u32x2 __attribute__((ext_vector_type(2)));

constexpr int D = 1024, NCTX = 4096, NLAT = 4096, MROWS = 8192, DEPTH = 2;
constexpr int SEQ = 256, DEC_SEQ = 2048, PAST = 256, NBC = 16, NBL = 2;
constexpr int NH = 8, QKN = 64, QKR = 32, VH = 64, QL = 384, KVL = 256;
constexpr int IN_COLS = 6304, FF = 2816;
constexpr int OFF_KVA = 384, OFF_KR = 640, OFF_CONF = 672, OFF_SC = 1184, OFF_FN = 1952, OFF_GATE = 2208;
constexpr int PROJ_LD = 2464;
constexpr int WIN_N = 6656;
constexpr int KVROWS = 8704;
constexpr float EPS = 1e-6f;
constexpr float QSCALE = 0.10206207261596577f * 1.4426950408889634f;

constexpr size_t al256(size_t x) { return (x + 255) & ~(size_t)255; }
constexpr size_t WS_CTL = 0, CTL_ZERO_BYTES = 65536;
constexpr size_t WS_MOD = 65536;
constexpr size_t WS_ROPE = WS_MOD + al256(2 * 3 * 6144 * 4);
constexpr size_t WS_DFTL = WS_ROPE + 4096;
constexpr size_t WS_DFTC = WS_DFTL + (size_t)2048 * 4096 * 2;
constexpr size_t WS_W = WS_DFTC + (size_t)256 * 512 * 2;
constexpr size_t W_IN = 0;
constexpr size_t W_QB = W_IN + (size_t)WIN_N * 1024 * 2;
constexpr size_t W_KVB = W_QB + (size_t)768 * 384 * 2;
constexpr size_t W_CAT = W_KVB + (size_t)1024 * 256 * 2;
constexpr size_t W_OUT = W_CAT + (size_t)1024 * 1280 * 2;
constexpr size_t W_GU = W_OUT + (size_t)1024 * 1024 * 2;
constexpr size_t W_DN = W_GU + (size_t)5632 * 1024 * 2;
constexpr size_t W_LAYER = W_DN + (size_t)1024 * 2816 * 2;
constexpr size_t WS_XN = WS_W + 2 * W_LAYER;
constexpr size_t XN_QN = 0, XN_CKV = XN_QN + (size_t)MROWS * 384 * 2, XN_KR = XN_CKV + (size_t)KVROWS * 256 * 2;
static_assert(XN_KR + (size_t)KVROWS * 32 * 2 <= (size_t)MROWS * 1024 * 2, "XN overlay");
constexpr size_t WS_PROJ = WS_XN + (size_t)MROWS * 1024 * 2;
constexpr size_t PJ_Q = 0, PJ_KV = PJ_Q + (size_t)MROWS * 768 * 2;
static_assert(PJ_KV + (size_t)KVROWS * 1024 * 2 <= (size_t)MROWS * PROJ_LD * 2, "PROJ overlay");
constexpr size_t WS_GATES = WS_PROJ + (size_t)MROWS * PROJ_LD * 2;
constexpr size_t WS_ACAT = WS_GATES + (size_t)MROWS * 4096 * 2;
constexpr int ACAT_LD = 1280, AC_UC = 512, AC_SC = 768, AC_F = 1024;
constexpr size_t WS_PQL = WS_ACAT + (size_t)MROWS * ACAT_LD * 2;
constexpr size_t WS_PQC = WS_PQL + (size_t)2 * 256 * 4096 * 2;
constexpr size_t WS_DFTP = WS_PQC + (size_t)16 * 256 * 512 * 2;
constexpr size_t WS_END = WS_DFTP + (size_t)2 * 8 * 2048 * 256 * 2;
static_assert(WS_END <= 268435456, "workspace map exceeds 256 MiB");

constexpr int RING_BYTES = 131072, MISC_OFF = RING_BYTES, LDS_BYTES = 147456;

__device__ __forceinline__ unsigned cvt_pk_bf16(float lo, float hi) { unsigned r; asm volatile("v_cvt_pk_bf16_f32 %0, %1, %2" : "=v"(r) : "v"(lo), "v"(hi)); return r; }
__device__ __forceinline__ float bf_lo(unsigned u) { return __uint_as_float(u << 16); }
__device__ __forceinline__ float bf_hi(unsigned u) { return __uint_as_float(u & 0xffff0000u); }
__device__ __forceinline__ float bf1(bf16_t u) { return __uint_as_float((unsigned)u << 16); }
__device__ __forceinline__ bf16_t f2bf(float f) { return (bf16_t)(cvt_pk_bf16(f, 0.f) & 0xffffu); }
__device__ __forceinline__ float sigmoidf_(float x) { return __builtin_amdgcn_rcpf(1.f + __expf(-x)); }
__device__ __forceinline__ float wave_sum(float v) {
#pragma unroll
    for (int o = 1; o < 64; o <<= 1) v += __shfl_xor(v, o);
    return v;
}
#define LDS_WAIT() asm volatile("s_waitcnt lgkmcnt(0)" ::: "memory")
#define VM_WAIT() asm volatile("s_waitcnt vmcnt(0)" ::: "memory")

namespace pg8 {
constexpr int BM = 256, BK = 64, HALF = 128, HTB = HALF * BK * 2, STAGE_BYTES = 8 * HTB;
__device__ __forceinline__ int lds_byte(int r, int c) { const int st = (r >> 4) * 2 + (c >> 5), rr = r & 15, cc = c & 31, ob = rr * 64 + cc * 2; return st * 1024 + (ob ^ (((ob >> 9) & 1) << 5)); }
__device__ __forceinline__ void stage_rc(int b, int& R, int& C) { const int st = b / 1024, sb = b % 1024, swz = sb ^ (((sb >> 9) & 1) << 5); R = (st >> 1) * 16 + swz / 64; C = (st & 1) * 32 + (swz % 64) / 2; }
__device__ __forceinline__ int perm32(int rho) { const int n = rho >> 4, i = rho & 15; return 8 * (i >> 2) + 4 * n + (i & 3); }

struct Unit { int pm, pn, z, koff, nt, seg; };
struct Job {
    const char* A; const char* Bt; int lda, ldb, K; long a_lo, a_hi, b_lo, b_hi;
    int nM, nN, nZ;
    int kind;
    void* o0; void* o1; const void* p0; const void* p1; int ldc; long zso; int aux;
};
enum { EK_PROJ = 0, EK_Q, EK_BF16, EK_MERGE, EK_RESID, EK_SWIGLU };

struct Order {
    int nM, nN, nZ, nwg, G, c, single, nt, chain;
    __device__ __forceinline__ void init(const Job& j, int G_, int c_) { nM = j.nM; nN = j.nN; nZ = j.nZ; nwg = nM * nN * nZ; G = G_; c = c_; single = -1; nt = j.K / BK; chain = (j.kind == EK_MERGE); }
    __device__ __forceinline__ void init_single(const Job& j, int unit) { nM = j.nM; nN = j.nN; nZ = j.nZ; nwg = nM * nN * nZ; G = 1; c = 0; single = unit; nt = j.K / BK; chain = 0; }
    __device__ __forceinline__ bool next(int i, Unit& u) const {
        u.koff = 0; u.nt = nt; u.seg = -1;
        if (single >= 0) { if (i > 0) return false; const int per = nM * nN; u.z = single / per; const int r = single % per; u.pn = r / nM; u.pm = r % nM; return true; }
        if (chain) { u.seg = i & 3; i >>= 2; u.koff = (u.seg == 0) ? 0 : (256 + 256 * u.seg) * 2; u.nt = (u.seg == 0) ? 8 : 4; }
        const long L = (long)i * G + c; if (L >= nwg) return false;
        if (nZ > 1) { const int per = nM * nN; u.z = (int)L / per; const int r = (int)L % per; u.pn = r / nM; u.pm = r % nM; return true; }
        constexpr int NXCD = 8, WGM = 8;
        int wgid = (int)L; { const int q = nwg / NXCD, r = nwg % NXCD, xcd = wgid % NXCD, off = wgid / NXCD; wgid = (xcd < r ? xcd * (q + 1) : r * (q + 1) + (xcd - r) * q) + off; }
        const int nig = WGM * nN, gid = wgid / nig, fm = gid * WGM, gsz = (nM - fm) < WGM ? (nM - fm) : WGM;
        u.pm = fm + ((wgid % nig) % gsz); u.pn = (wgid % nig) / gsz; u.z = 0; return true;
    }
};

__device__ __forceinline__ void epilogue(const Job& J, const f32x4 (&acc)[2][2][4][2], const Unit& u, int wr, int wc, int fr, int fq) {
    const int row0 = u.pm * BM + wr * 64 + fr;
    const int cl = wc * 32 + 8 * fq;
    if (J.kind == EK_PROJ) {
        const bool isg = u.pn >= 10;
        bf16_t* base = isg ? (bf16_t*)J.o1 : (bf16_t*)J.o0; const int ldc = isg ? 4096 : PROJ_LD;
        const int col0 = (isg ? (u.pn - 10) * BM : u.pn * BM) + cl;
#pragma unroll
        for (int ai = 0; ai < 2; ++ai)
#pragma unroll
            for (int m = 0; m < 4; ++m) { bf16_t* rowp = base + (size_t)(row0 + ai * HALF + m * 16) * ldc + col0;
#pragma unroll
                for (int bj = 0; bj < 2; ++bj) { f32x4 v0 = acc[ai][bj][m][0], v1 = acc[ai][bj][m][1];
                    if (isg) {
#pragma unroll
                        for (int e = 0; e < 4; ++e) { v0[e] = sigmoidf_(v0[e]); v1[e] = sigmoidf_(v1[e]); } }
                    u32x4 w; w.x = cvt_pk_bf16(v0[0], v0[1]); w.y = cvt_pk_bf16(v0[2], v0[3]); w.z = cvt_pk_bf16(v1[0], v1[1]); w.w = cvt_pk_bf16(v1[2], v1[3]);
                    if (isg || col0 + bj * HALF + 8 <= PROJ_LD) *(u32x4*)(rowp + bj * HALF) = w; } }
    } else if (J.kind == EK_Q) {
        bf16_t* Q = (bf16_t*)J.o0; const float* rope = (const float*)J.p0; const bool lat = u.pm >= 16;
#pragma unroll
        for (int bj = 0; bj < 2; ++bj) {
            const int G = 8 * u.pn + 4 * bj + wc; const bool isrope = lat && (G % 3 == 2);
#pragma unroll
            for (int ai = 0; ai < 2; ++ai)
#pragma unroll
                for (int m = 0; m < 4; ++m) { const int row = row0 + ai * HALF + m * 16;
                    float v[8];
#pragma unroll
                    for (int e = 0; e < 4; ++e) { v[e] = acc[ai][bj][m][0][e] * QSCALE; v[4 + e] = acc[ai][bj][m][1][e] * QSCALE; }
                    if (isrope) { const int t = (row - NCTX) & (DEC_SEQ - 1); const int pos = (fq < 2) ? (t >> 6) : (t & 63);
                        const f32x4* cs = (const f32x4*)(rope + pos * 16);
                        const f32x4 c0 = cs[0], c1 = cs[1], c2 = cs[2], c3 = cs[3];
                        const float cc[8] = {c0[0], c0[2], c1[0], c1[2], c2[0], c2[2], c3[0], c3[2]}, ss[8] = {c0[1], c0[3], c1[1], c1[3], c2[1], c2[3], c3[1], c3[3]};
#pragma unroll
                        for (int e = 0; e < 8; ++e) { const float p = __shfl_xor(v[e], 16); v[e] = (fq & 1) ? (v[e] * cc[e] + p * ss[e]) : (v[e] * cc[e] - p * ss[e]); } }
                    u32x4 w; w.x = cvt_pk_bf16(v[0], v[1]); w.y = cvt_pk_bf16(v[2], v[3]); w.z = cvt_pk_bf16(v[4], v[5]); w.w = cvt_pk_bf16(v[6], v[7]);
                    *(u32x4*)(Q + (size_t)row * 768 + u.pn * BM + bj * HALF + cl) = w; } }
    } else if (J.kind == EK_BF16) {
        bf16_t* O = (bf16_t*)J.o0 + (size_t)u.z * J.zso;
#pragma unroll
        for (int ai = 0; ai < 2; ++ai)
#pragma unroll
            for (int m = 0; m < 4; ++m) { bf16_t* rowp = O + (size_t)(row0 + ai * HALF + m * 16) * J.ldc + u.pn * BM + cl;
#pragma unroll
                for (int bj = 0; bj < 2; ++bj) { const f32x4 v0 = acc[ai][bj][m][0], v1 = acc[ai][bj][m][1];
                    u32x4 w; w.x = cvt_pk_bf16(v0[0], v0[1]); w.y = cvt_pk_bf16(v0[2], v0[3]); w.z = cvt_pk_bf16(v1[0], v1[1]); w.w = cvt_pk_bf16(v1[2], v1[3]);
                    *(u32x4*)(rowp + bj * HALF) = w; } }
    } else if (J.kind == EK_MERGE) {
        const bf16_t* gates = (const bf16_t*)J.p0 + 3 * 1024; bf16_t* MB = (bf16_t*)J.o0;
#pragma unroll
        for (int ai = 0; ai < 2; ++ai)
#pragma unroll
            for (int m = 0; m < 4; ++m) { const size_t row = (size_t)(row0 + ai * HALF + m * 16);
#pragma unroll
                for (int bj = 0; bj < 2; ++bj) { const int col = u.pn * BM + bj * HALF + cl;
                    const u32x4 g = *(const u32x4*)(gates + row * 4096 + col);
                    f32x4 v0 = acc[ai][bj][m][0], v1 = acc[ai][bj][m][1];
                    v0[0] *= bf_lo(g.x); v0[1] *= bf_hi(g.x); v0[2] *= bf_lo(g.y); v0[3] *= bf_hi(g.y); v1[0] *= bf_lo(g.z); v1[1] *= bf_hi(g.z); v1[2] *= bf_lo(g.w); v1[3] *= bf_hi(g.w);
                    u32x4 w; w.x = cvt_pk_bf16(v0[0], v0[1]); w.y = cvt_pk_bf16(v0[2], v0[3]); w.z = cvt_pk_bf16(v1[0], v1[1]); w.w = cvt_pk_bf16(v1[2], v1[3]); *(u32x4*)(MB + row * 1024 + col) = w; } }
    } else if (J.kind == EK_RESID) {
        float* X = (float*)J.o0; const float* XI = (const float*)J.p1; const int mi = u.pm < 16 ? 0 : (u.pm < 24 ? 1 : 2); const float* gv = (const float*)J.p0 + mi * 6144 + J.aux;
#pragma unroll
        for (int bj = 0; bj < 2; ++bj) { const int col = u.pn * BM + bj * HALF + cl; const f32x4 g0 = *(const f32x4*)(gv + col), g1 = *(const f32x4*)(gv + col + 4);
#pragma unroll
            for (int ai = 0; ai < 2; ++ai)
#pragma unroll
                for (int m = 0; m < 4; ++m) { float* xp = X + (size_t)(row0 + ai * HALF + m * 16) * 1024 + col; const float* xi = XI + (size_t)(row0 + ai * HALF + m * 16) * 1024 + col;
                    const f32x4 a = *(const f32x4*)xi, b = *(const f32x4*)(xi + 4);
                    *(f32x4*)xp = a + g0 * acc[ai][bj][m][0]; *(f32x4*)(xp + 4) = b + g1 * acc[ai][bj][m][1]; } }
    } else {
        bf16_t* ACT = (bf16_t*)J.o0;
#pragma unroll
        for (int ai = 0; ai < 2; ++ai)
#pragma unroll
            for (int m = 0; m < 4; ++m) { f32x4 v0, v1;
#pragma unroll
                for (int e = 0; e < 4; ++e) { const float g0 = acc[ai][0][m][0][e], g1 = acc[ai][0][m][1][e]; v0[e] = g0 * sigmoidf_(g0) * acc[ai][1][m][0][e]; v1[e] = g1 * sigmoidf_(g1) * acc[ai][1][m][1][e]; }
                u32x4 w; w.x = cvt_pk_bf16(v0[0], v0[1]); w.y = cvt_pk_bf16(v0[2], v0[3]); w.z = cvt_pk_bf16(v1[0], v1[1]); w.w = cvt_pk_bf16(v1[2], v1[3]);
                *(u32x4*)(ACT + (size_t)(row0 + ai * HALF + m * 16) * FF + u.pn * HALF + cl) = w; }
    }
}

__device__ __forceinline__ float rdiv(float a, float b) { return a * __builtin_amdgcn_rcpf(fmaxf(b, 1e-30f)); }
__device__ __forceinline__ void merge_hook(const Job& J, f32x4 (&acc)[2][2][4][2], const Unit& u, int br, int wr, int wc, int fr, int fq) {
    const int row0 = u.pm * BM + wr * 64 + fr; const int cl = wc * 32 + 8 * fq;
    const bf16_t* gates = (const bf16_t*)J.p0 + br * 1024;
#pragma unroll
    for (int ai = 0; ai < 2; ++ai)
#pragma unroll
        for (int m = 0; m < 4; ++m) { const size_t row = (size_t)(row0 + ai * HALF + m * 16);
#pragma unroll
            for (int bj = 0; bj < 2; ++bj) { const int col = u.pn * BM + bj * HALF + cl;
                const u32x4 a = *(const u32x4*)(gates + row * 4096 + col), b = *(const u32x4*)(gates + row * 4096 + 1024 + col);
                f32x4& v0 = acc[ai][bj][m][0]; f32x4& v1 = acc[ai][bj][m][1];
                v0[0] *= rdiv(bf_lo(a.x), bf_lo(b.x)); v0[1] *= rdiv(bf_hi(a.x), bf_hi(b.x)); v0[2] *= rdiv(bf_lo(a.y), bf_lo(b.y)); v0[3] *= rdiv(bf_hi(a.y), bf_hi(b.y));
                v1[0] *= rdiv(bf_lo(a.z), bf_lo(b.z)); v1[1] *= rdiv(bf_hi(a.z), bf_hi(b.z)); v1[2] *= rdiv(bf_lo(a.w), bf_lo(b.w)); v1[3] *= rdiv(bf_hi(a.w), bf_hi(b.w)); }
            if (m & 1) asm volatile("" ::: "memory"); }
}

__device__ __forceinline__ void gemm_phase(LAS unsigned char* lds, const Job& g, const Order& S, const int tid) {
    const int wid = __builtin_amdgcn_readfirstlane(tid >> 6), lane = tid & 63, wr = wid >> 2, wc = wid & 3, fr = lane & 15, fq = lane >> 4;
    unsigned voffA[2], voffB[2];
#pragma unroll
    for (int i = 0; i < 2; ++i) { int R, C; stage_rc(tid * 16 + i * 8192, R, C); const int Rb = (R & ~31) + perm32(R & 31);
        voffA[i] = (unsigned)(R * g.lda + C) * 2u; voffB[i] = (unsigned)(Rb * g.ldb + C) * 2u; }
    const size_t kstep = (size_t)(BK * 2);
    const size_t hstepA = (size_t)HALF * g.lda * 2, hstepB = (size_t)HALF * g.ldb * 2;
    const size_t tstepA = 2 * hstepA, tstepB = 2 * hstepB;
    const unsigned ldsw = (unsigned)wid * 1024u;
    const int aoff = lds_byte(wr * 64 + fr, fq * 8), boff = lds_byte(wc * 32 + fr, fq * 8);
#define PG8_SA(b, h) (((b) * 2 + (h)) * HTB)
#define PG8_SB(b, h) ((4 + (b) * 2 + (h)) * HTB)
#define PG8_STAGE(bufoff, gbase, voff) do { _Pragma("unroll") for (int _i = 0; _i < 2; ++_i) \
        __builtin_amdgcn_global_load_lds((const unsigned*)((const char*)(gbase) + (voff)[_i]), (LAS unsigned*)(lds + (bufoff) + ldsw + _i * 8192), 16, 0, 0); } while (0)
#define PG8_LDA(dst, b, h) do { _Pragma("unroll") for (int m = 0; m < 4; ++m) _Pragma("unroll") for (int k = 0; k < 2; ++k) dst[m][k] = *(const LAS bf16x8*)(lds + PG8_SA(b, h) + aoff + m * 2048 + k * 1024); } while (0)
#define PG8_LDB(dst, b, h) do { _Pragma("unroll") for (int n = 0; n < 2; ++n) _Pragma("unroll") for (int k = 0; k < 2; ++k) dst[n][k] = *(const LAS bf16x8*)(lds + PG8_SB(b, h) + boff + n * 2048 + k * 1024); } while (0)
#define PG8_MMA(ai, bj, At, Bt) do { __builtin_amdgcn_s_setprio(1); _Pragma("unroll") for (int m = 0; m < 4; ++m) _Pragma("unroll") for (int n = 0; n < 2; ++n) _Pragma("unroll") for (int k = 0; k < 2; ++k) \
        acc[ai][bj][m][n] = __builtin_amdgcn_mfma_f32_16x16x32_bf16(Bt[n][k], At[m][k], acc[ai][bj][m][n], 0, 0, 0); __builtin_amdgcn_s_setprio(0); } while (0)
#define PG8_WAIT_V(n) asm volatile("s_waitcnt vmcnt(" #n ")" ::: "memory")
#define PG8_WAIT_L(n) asm volatile("s_waitcnt lgkmcnt(" #n ")" ::: "memory")
#define PG8_BAR __builtin_amdgcn_s_barrier()
#define PG8_SCHED __builtin_amdgcn_sched_barrier(0)
#define PG8_UA(u) (g.A + (size_t)((u).z & 7) * g.a_lo + (size_t)((u).z >> 3) * g.a_hi + (size_t)(u).pm * tstepA + (u).koff)
#define PG8_UB(u) (g.Bt + (size_t)((u).z & 7) * g.b_lo + (size_t)((u).z >> 3) * g.b_hi + (size_t)(u).pn * tstepB + (u).koff)
    Unit cur, nxt; int ui = 0;
    if (!S.next(0, cur)) return;
    f32x4 acc[2][2][4][2];
#pragma unroll
    for (int a = 0; a < 2; ++a)
#pragma unroll
        for (int b = 0; b < 2; ++b)
#pragma unroll
            for (int m = 0; m < 4; ++m)
#pragma unroll
                for (int n = 0; n < 2; ++n) acc[a][b][m][n] = (f32x4){0.f, 0.f, 0.f, 0.f};
    bf16x8 At[4][2], B0[2][2], B1[2][2];
    const char* cA = PG8_UA(cur); const char* cB = PG8_UB(cur);
    PG8_STAGE(PG8_SB(0, 0), cB, voffB); PG8_STAGE(PG8_SB(0, 1), cB + hstepB, voffB); PG8_STAGE(PG8_SA(0, 0), cA, voffA); PG8_STAGE(PG8_SA(0, 1), cA + hstepA, voffA);
    if (wr == 1) PG8_BAR;
    PG8_WAIT_V(2); PG8_BAR;
    PG8_STAGE(PG8_SB(1, 0), cB + kstep, voffB); PG8_STAGE(PG8_SA(1, 0), cA + kstep, voffA); PG8_STAGE(PG8_SB(1, 1), cB + hstepB + kstep, voffB);
    PG8_WAIT_V(6); PG8_BAR;
    for (;;) {
        const bool has_next = S.next(ui + 1, nxt);
        const char* nA = has_next ? PG8_UA(nxt) : cA; const char* nB = has_next ? PG8_UB(nxt) : cB;
        const int nt = cur.nt;
        for (int t = 0; t < nt; t += 2) {
            const bool last = (t == nt - 2);
            const char* a1 = cA + (size_t)(t + 1) * kstep;
            const char* a2 = last ? nA : cA + (size_t)(t + 2) * kstep; const char* b2 = last ? nB : cB + (size_t)(t + 2) * kstep;
            const char* a3 = a2 + kstep; const char* b3 = b2 + kstep;
            PG8_LDB(B0, 0, 0); PG8_LDB(B1, 0, 1); PG8_SCHED; PG8_LDA(At, 0, 0); PG8_STAGE(PG8_SA(1, 1), a1 + hstepA, voffA);
            PG8_WAIT_V(8); PG8_WAIT_L(0); PG8_BAR; PG8_MMA(0, 0, At, B0); PG8_MMA(0, 1, At, B1); PG8_BAR; PG8_SCHED;
            PG8_LDA(At, 0, 1); PG8_STAGE(PG8_SB(0, 0), b2, voffB); PG8_STAGE(PG8_SB(0, 1), b2 + hstepB, voffB); PG8_STAGE(PG8_SA(0, 0), a2, voffA);
            PG8_WAIT_V(8); PG8_WAIT_L(0); PG8_BAR; PG8_MMA(1, 0, At, B0); PG8_MMA(1, 1, At, B1); PG8_BAR; PG8_SCHED;
            PG8_LDB(B0, 1, 0); PG8_LDB(B1, 1, 1); PG8_SCHED; PG8_LDA(At, 1, 0); PG8_STAGE(PG8_SA(0, 1), a2 + hstepA, voffA);
            PG8_WAIT_V(8); PG8_WAIT_L(0); PG8_BAR; PG8_MMA(0, 0, At, B0); PG8_MMA(0, 1, At, B1); PG8_BAR; PG8_SCHED;
            PG8_LDA(At, 1, 1); PG8_STAGE(PG8_SB(1, 0), b3, voffB); PG8_STAGE(PG8_SB(1, 1), b3 + hstepB, voffB); PG8_STAGE(PG8_SA(1, 0), a3, voffA);
            PG8_WAIT_V(8); PG8_WAIT_L(0); PG8_BAR; PG8_MMA(1, 0, At, B0); PG8_MMA(1, 1, At, B1); PG8_BAR; PG8_SCHED;
        }
        if (wr == 0) PG8_BAR;
        const bool mid = (cur.seg >= 0 && cur.seg < 3);
        if (mid) merge_hook(g, acc, cur, cur.seg, wr, wc, fr, fq);
        else epilogue(g, acc, cur, wr, wc, fr, fq);
        if (!has_next) break;
        if (!mid) {
#pragma unroll
        for (int a = 0; a < 2; ++a)
#pragma unroll
            for (int b = 0; b < 2; ++b)
#pragma unroll
                for (int m = 0; m < 4; ++m)
#pragma unroll
                    for (int n = 0; n < 2; ++n) acc[a][b][m][n] = (f32x4){0.f, 0.f, 0.f, 0.f};
        }
        cur = nxt; cA = nA; cB = nB; ++ui;
        if (wr == 1) PG8_BAR;
    }
    PG8_WAIT_V(0);
    PG8_BAR;
#undef PG8_SA
#undef PG8_SB
#undef PG8_STAGE
#undef PG8_LDA
#undef PG8_LDB
#undef PG8_MMA
#undef PG8_WAIT_V
#undef PG8_WAIT_L
#undef PG8_BAR
#undef PG8_SCHED
#undef PG8_UA
#undef PG8_UB
}
}

namespace attn {
constexpr int KSLOT = 12288, VSLOT = 8192, BUFB = 2 * KSLOT + 2 * VSLOT;
constexpr int LDS_WS = 2 * BUFB;
constexpr int LDS_CM = LDS_WS + 2048;
constexpr int LDS_CL = LDS_CM + 1024;
constexpr int LDS_OST = LDS_CL + 512;
constexpr int LDS_END = LDS_OST + 8 * 4096;
static_assert(LDS_END <= RING_BYTES, "attention LDS");
__device__ __forceinline__ int crow(int r, int hi) { return (r & 3) + 8 * (r >> 2) + 4 * hi; }
__device__ __forceinline__ void glds16(const void* gsrc, unsigned lds_dst) { unsigned keep;
    asm volatile("s_mov_b32 %0, m0\n\ts_mov_b32 m0, %2\n\ts_nop 0\n\tglobal_load_lds_dwordx4 %1, off\n\ts_mov_b32 m0, %0" : "=&s"(keep) : "v"(gsrc), "s"(lds_dst) : "memory"); }
typedef __bf16 bf16x2_t __attribute__((ext_vector_type(2)));
__device__ __forceinline__ unsigned cvtpk_s(float lo, float hi) { f32x2 v = {lo, hi}; bf16x2_t b = __builtin_convertvector(v, bf16x2_t); return __builtin_bit_cast(unsigned, b); }
typedef LAS const char* lds_cptr;
typedef short v4i16_t __attribute__((ext_vector_type(4)));
__device__ __forceinline__ s16x4 vtr(lds_cptr p) { return __builtin_bit_cast(s16x4, __builtin_amdgcn_ds_read_tr16_b64_v4i16((LAS v4i16_t*)p)); }
__device__ __forceinline__ float swapmax(float m) { auto rr = __builtin_amdgcn_permlane32_swap(__float_as_uint(m), __float_as_uint(m), false, false); return fmaxf(__uint_as_float(rr[0]), __uint_as_float(rr[1])); }
__device__ __forceinline__ float swapsum(float m) { auto rr = __builtin_amdgcn_permlane32_swap(__float_as_uint(m), __float_as_uint(m), false, false); return __uint_as_float(rr[0]) + __uint_as_float(rr[1]); }

struct Tensors { const bf16_t* Q; const bf16_t* KV; const bf16_t* KR; bf16_t* O; };

__device__ __forceinline__ void dma_step(const Tensors& T, int krow0, int h, unsigned ldsbuf, int wid, int lane) {
#pragma unroll
    for (int i = 0; i < 5; ++i) {
        const int p = wid + 8 * i;
        const void* src; unsigned dst;
        if (p < 24) { const int j = p / 12, c = p % 12; const int row = krow0 + j * 64 + lane;
            src = (c < 8) ? (const void*)(T.KV + (size_t)row * 1024 + h * 128 + c * 8) : (const void*)(T.KR + (size_t)row * 32 + (c - 8) * 8);
            dst = ldsbuf + j * KSLOT + c * 1024; }
        else { const int pv = p - 24, j = pv >> 3, q = pv & 7; const int row = krow0 + j * 64 + 16 * (q & 3) + (lane >> 2);
            src = (const void*)(T.KV + (size_t)row * 1024 + h * 128 + 64 + (q >> 2) * 32 + (lane & 3) * 8);
            dst = ldsbuf + 2 * KSLOT + j * VSLOT + q * 1024; }
        glds16(src, (unsigned)__builtin_amdgcn_readfirstlane(dst));
    }
}

__device__ __forceinline__ void unit(const Tensors& T, int qrow0, int krow0, int nsteps, int h, char* shm, const int tid) {
    const int lane = tid & 63, r32 = lane & 31, hi = lane >> 5; const int wid = __builtin_amdgcn_readfirstlane(tid >> 6);
    const int qb = wid & 3, kh = wid >> 2;
    const unsigned lds0 = (unsigned)(uintptr_t)shm;
    float* wsf = (float*)(shm + LDS_WS) + wid * 64;
    dma_step(T, krow0, h, lds0, wid, lane);
    const bf16_t* Qw = T.Q + (size_t)(qrow0 + qb * 32 + r32) * 768 + h * 96 + hi * 8;
    bf16x8 qr[6];
#pragma unroll
    for (int d0 = 0; d0 < 6; ++d0) qr[d0] = *(const bf16x8*)(Qw + d0 * 16);
    float mhat = 0.f, l_reg = 0.f; f32x16 o[2]; o[0] = f32x16{}; o[1] = f32x16{}; f32x16 negm = f32x16{};
    const lds_cptr shm3 = (lds_cptr)shm;
    for (int s = 0; s < nsteps; ++s) {
        asm volatile("s_waitcnt vmcnt(0)" ::: "memory"); __builtin_amdgcn_s_barrier(); asm volatile("" ::: "memory");
        if (s + 1 < nsteps) dma_step(T, krow0 + (s + 1) * 128, h, lds0 + ((s + 1) & 1) * BUFB, wid, lane);
        const int bufo = (s & 1) * BUFB;
        const lds_cptr kp = shm3 + bufo + kh * KSLOT + hi * 1024 + r32 * 16;
        const lds_cptr vp = shm3 + bufo + 2 * KSLOT + kh * VSLOT + ((lane >> 4) & 1) * 32 + (lane & 3) * 8 + (4 * hi + ((lane & 15) >> 2)) * 64;
        f32x16 p0, p1;
#pragma unroll
        for (int d0 = 0; d0 < 6; ++d0) {
            const bf16x8 b0 = *(const LAS bf16x8*)(kp + d0 * 2048), b1 = *(const LAS bf16x8*)(kp + d0 * 2048 + 512);
            if (d0 == 0) { p0 = __builtin_amdgcn_mfma_f32_32x32x16_bf16(b0, qr[0], negm, 0, 0, 0); p1 = __builtin_amdgcn_mfma_f32_32x32x16_bf16(b1, qr[0], negm, 0, 0, 0); }
            else { p0 = __builtin_amdgcn_mfma_f32_32x32x16_bf16(b0, qr[d0], p0, 0, 0, 0); p1 = __builtin_amdgcn_mfma_f32_32x32x16_bf16(b1, qr[d0], p1, 0, 0, 0); } }
        float rm = fmaxf(p0[0], p1[0]);
#pragma unroll
        for (int r = 1; r < 16; ++r) rm = fmaxf(rm, fmaxf(p0[r], p1[r]));
        rm = swapmax(rm);
        bool resc = false;
        if (s == 0 || __any(rm > 8.0f)) {
            const float dl = (s == 0) ? rm : fmaxf(rm, 0.f); mhat += dl;
#pragma unroll
            for (int r = 0; r < 16; ++r) { p0[r] -= dl; p1[r] -= dl; negm[r] = -mhat; }
            if (s != 0) { const float f = __builtin_amdgcn_exp2f(-dl); l_reg *= f; if (hi == 0) wsf[r32] = f; resc = true; }
        }
        float sacc = 0.f;
#pragma unroll
        for (int r = 0; r < 16; ++r) { p0[r] = __builtin_amdgcn_exp2f(p0[r]); p1[r] = __builtin_amdgcn_exp2f(p1[r]); sacc += p0[r] + p1[r]; }
        l_reg += sacc;
        if (resc) { asm volatile("s_waitcnt lgkmcnt(0)" ::: "memory");
#pragma unroll
            for (int d_ = 0; d_ < 2; ++d_)
#pragma unroll
                for (int r = 0; r < 16; ++r) o[d_][r] *= wsf[crow(r, hi)]; }
        u32x4 pw[4];
        pw[0] = (u32x4){cvtpk_s(p0[0], p0[1]), cvtpk_s(p0[2], p0[3]), cvtpk_s(p0[4], p0[5]), cvtpk_s(p0[6], p0[7])};
        pw[1] = (u32x4){cvtpk_s(p0[8], p0[9]), cvtpk_s(p0[10], p0[11]), cvtpk_s(p0[12], p0[13]), cvtpk_s(p0[14], p0[15])};
        pw[2] = (u32x4){cvtpk_s(p1[0], p1[1]), cvtpk_s(p1[2], p1[3]), cvtpk_s(p1[4], p1[5]), cvtpk_s(p1[6], p1[7])};
        pw[3] = (u32x4){cvtpk_s(p1[8], p1[9]), cvtpk_s(p1[10], p1[11]), cvtpk_s(p1[12], p1[13]), cvtpk_s(p1[14], p1[15])};
#pragma unroll
        for (int d0 = 0; d0 < 2; ++d0)
#pragma unroll
            for (int ks = 0; ks < 4; ++ks) {
                const s16x4 lo = vtr(vp + d0 * 4096 + ks * 1024), hh = vtr(vp + d0 * 4096 + ks * 1024 + 512);
                const bf16x8 vf = (bf16x8){lo[0], lo[1], lo[2], lo[3], hh[0], hh[1], hh[2], hh[3]};
                o[d0] = __builtin_amdgcn_mfma_f32_32x32x16_bf16(__builtin_bit_cast(bf16x8, pw[ks]), vf, o[d0], 0, 0, 0); }
    }
    l_reg = swapsum(l_reg);
    float* cm = (float*)(shm + LDS_CM); float* cl = (float*)(shm + LDS_CL);
    if (hi == 0) cm[(kh * 4 + qb) * 32 + r32] = mhat;
    asm volatile("s_waitcnt lgkmcnt(0)" ::: "memory"); __builtin_amdgcn_s_barrier(); asm volatile("" ::: "memory");
    { const float mo = cm[((kh ^ 1) * 4 + qb) * 32 + r32]; const float ms = fmaxf(mhat, mo); const float f = __builtin_amdgcn_exp2f(mhat - ms); l_reg *= f;
      if (hi == 0) wsf[r32] = f; asm volatile("s_waitcnt lgkmcnt(0)" ::: "memory");
#pragma unroll
      for (int d_ = 0; d_ < 2; ++d_)
#pragma unroll
          for (int r = 0; r < 16; ++r) o[d_][r] *= wsf[crow(r, hi)]; }
    float* co = (float*)shm + qb * 2048;
    if (kh == 1) {
#pragma unroll
        for (int d_ = 0; d_ < 2; ++d_)
#pragma unroll
            for (int r = 0; r < 16; ++r) co[(d_ * 16 + r) * 64 + lane] = o[d_][r];
        if (hi == 0) cl[qb * 32 + r32] = l_reg;
    }
    asm volatile("s_waitcnt lgkmcnt(0)" ::: "memory"); __builtin_amdgcn_s_barrier(); asm volatile("" ::: "memory");
    if (kh == 0) {
#pragma unroll
        for (int d_ = 0; d_ < 2; ++d_)
#pragma unroll
            for (int r = 0; r < 16; ++r) o[d_][r] += co[(d_ * 16 + r) * 64 + lane];
        l_reg += cl[qb * 32 + r32];
        if (hi == 0) wsf[32 + r32] = l_reg; asm volatile("s_waitcnt lgkmcnt(0)" ::: "memory");
        float rli[16];
#pragma unroll
        for (int r = 0; r < 16; ++r) rli[r] = __builtin_amdgcn_rcpf(wsf[32 + crow(r, hi)]);
        bf16_t* stg = (bf16_t*)(shm + LDS_OST) + wid * 2048;
#pragma unroll
        for (int r = 0; r < 16; ++r) { const int orow = crow(r, hi);
#pragma unroll
            for (int d0 = 0; d0 < 2; ++d0) stg[orow * 64 + d0 * 32 + r32] = f2bf(o[d0][r] * rli[r]); }
        asm volatile("s_waitcnt lgkmcnt(0)" ::: "memory");
        bf16_t* Ow = T.O + (size_t)(qrow0 + qb * 32) * ACAT_LD + h * 64;
#pragma unroll
        for (int i = 0; i < 4; ++i) { const int row = i * 8 + (lane >> 3), ch = lane & 7; const u32x4 v = *(const u32x4*)(stg + row * 64 + ch * 8); *(u32x4*)(Ow + (size_t)row * ACAT_LD + ch * 8) = v; }
    }
    asm volatile("s_waitcnt lgkmcnt(0)" ::: "memory"); __builtin_amdgcn_s_barrier(); asm volatile("" ::: "memory");
}
}

#define XB_TMO      128
#define XB_XCNT(j)  (256  + 64 * (j))
#define XB_XSUB(j)  (1280 + 64 * (j))
#define XB_XGEN(j)  (2304 + 64 * (j))
#define XB_TOP      3328
#define XB_TOPGEN   3392
#define XCD_BAR_WORDS 3456
#define XB_SPIN_CAP (1u << 18)
__device__ __forceinline__ unsigned xb_ld(unsigned* p)              { return __hip_atomic_load(p, __ATOMIC_RELAXED, __HIP_MEMORY_SCOPE_AGENT); }
__device__ __forceinline__ unsigned xb_add(unsigned* p, unsigned v) { return __hip_atomic_fetch_add(p, v, __ATOMIC_RELAXED, __HIP_MEMORY_SCOPE_AGENT); }
__device__ __forceinline__ unsigned xb_xcc_id() { return (unsigned)__builtin_amdgcn_s_getreg((3 << 11) | 20) & 0xFu; }
#define XB_SPIN(cond, bar) do { unsigned _sp = 0; while (cond) { __builtin_amdgcn_s_sleep(1); \
    if ((++_sp & 255u) == 0u) { if (xb_ld(&(bar)[XB_TMO])) break; if (_sp > XB_SPIN_CAP) { atomicAdd(&(bar)[XB_TMO], 1u); break; } } } } while (0)
struct XcdBarrier { unsigned* bar; unsigned x; volatile LAS unsigned* st; };
__device__ __forceinline__ XcdBarrier xcd_barrier_post(unsigned* bar, volatile LAS unsigned* st) {
    XcdBarrier b; b.bar = bar; b.x = xb_xcc_id(); b.st = st;
    if (threadIdx.x == 0) (void)xb_add(&bar[XB_XCNT(b.x)], 1u);
    return b;
}
__device__ __forceinline__ void xcd_barrier_complete(unsigned* bar, unsigned x, unsigned& nloc, unsigned& nx) {
    const unsigned G = gridDim.x * gridDim.y * gridDim.z;
    unsigned sum, cnt, mine, sp = 0u;
    for (;;) {
        sum = 0u; cnt = 0u; mine = 0u;
#pragma unroll
        for (unsigned j = 0; j < 16; ++j) { const unsigned c = xb_ld(&bar[XB_XCNT(j)]); sum += c; cnt += (c > 0u) ? 1u : 0u; mine = (j == x) ? c : mine; }
        if (sum == G) break;
        __builtin_amdgcn_s_sleep(1);
        if ((++sp & 255u) == 0u) { if (xb_ld(&bar[XB_TMO])) break; if (sp > XB_SPIN_CAP) { atomicAdd(&bar[XB_TMO], 1u); break; } }
    }
    nloc = mine > 0u ? mine : 1u; nx = cnt > 0u ? cnt : 1u;
}
__device__ __forceinline__ void xcd_barrier(const XcdBarrier& b) {
    asm volatile("s_waitcnt vmcnt(0)" ::: "memory");
    __syncthreads();
    if (threadIdx.x == 0) {
        unsigned* bar = b.bar;
        __builtin_amdgcn_s_waitcnt(0);
        unsigned nloc = b.st[0], nx = b.st[1];
        if (nloc == 0u) { xcd_barrier_complete(bar, b.x, nloc, nx); b.st[0] = nloc; b.st[1] = nx; }
        const unsigned old = xb_add(&bar[XB_XSUB(b.x)], 1u);
        const unsigned gen = old / nloc;
        if (old + 1u == (gen + 1u) * nloc) {
            __builtin_amdgcn_fence(__ATOMIC_RELEASE, "agent");
            asm volatile("s_waitcnt vmcnt(0)" ::: "memory");
            const unsigned og = xb_add(&bar[XB_TOP], 1u);
            const unsigned tg = og / nx;
            if (og + 1u == (tg + 1u) * nx) xb_add(&bar[XB_TOPGEN], 1u);
            else XB_SPIN(xb_ld(&bar[XB_TOPGEN]) == tg, bar);
            __builtin_amdgcn_fence(__ATOMIC_ACQUIRE, "agent");
            xb_add(&bar[XB_XGEN(b.x)], 1u);
            asm volatile("s_waitcnt vmcnt(0)" ::: "memory");
        } else {
            XB_SPIN(xb_ld(&bar[XB_XGEN(b.x)]) == gen, bar);
            __builtin_amdgcn_fence(__ATOMIC_ACQUIRE, "agent");
            asm volatile("s_waitcnt vmcnt(0)" ::: "memory");
        }
    }
    __syncthreads();
}

struct Args { const float* in[29]; float* out; unsigned char* ws; int step_lo, step_hi; };
static_assert(sizeof(Args) == 31 * 8 + 8, "Args has no padding");

struct Ctx {
    LAS unsigned char* lds; int tid, lane, wave, G, gw, NGW, bid;
    float* out; unsigned char* ws;
};
__device__ __forceinline__ const float* ldarg(int i) { const char* kp = (const char*)__builtin_amdgcn_kernarg_segment_ptr(); asm volatile("" : "+s"(kp)); return *(const float* const*)(kp + 8 * i); }
#define INP(i) ldarg(i)

__device__ __forceinline__ void transpose_item(const float* W, int N, bf16_t* WT, int ldt, int k0, int n0, int drow0, LAS float* scr, int lane) {
    float v[32];
    const float* wp = W + (size_t)(k0 + (lane >> 5)) * N + n0 + (lane & 31);
#pragma unroll
    for (int i = 0; i < 32; ++i) v[i] = wp[(size_t)(2 * i) * N];
#pragma unroll
    for (int i = 0; i < 32; ++i) scr[(2 * i + (lane >> 5)) * 33 + (lane & 31)] = v[i];
    LDS_WAIT(); asm volatile("" ::: "memory");
    const int c = lane & 7;
#pragma unroll
    for (int j = 0; j < 4; ++j) { const int n = (lane >> 3) + 8 * j; const LAS float* s = scr + (8 * c) * 33 + n;
        u32x4 o; o.x = cvt_pk_bf16(s[0 * 33], s[1 * 33]); o.y = cvt_pk_bf16(s[2 * 33], s[3 * 33]); o.z = cvt_pk_bf16(s[4 * 33], s[5 * 33]); o.w = cvt_pk_bf16(s[6 * 33], s[7 * 33]);
        *(u32x4*)(WT + (size_t)(drow0 + n) * ldt + k0 + 8 * c) = o; }
    LDS_WAIT(); asm volatile("" ::: "memory");
}

__device__ __forceinline__ void prologue(Ctx& F) {
    unsigned char* ws = F.ws;
    LAS float* misc = (LAS float*)(F.lds + MISC_OFF + 1024);
    __syncthreads();
    if (F.tid < 64) { misc[F.tid] = __builtin_amdgcn_cosf((float)F.tid * (1.f / 64.f)); misc[64 + F.tid] = __builtin_amdgcn_sinf((float)F.tid * (1.f / 64.f)); }
    if (F.bid < 192) {
        LAS float* scv = (LAS float*)F.lds;
        LAS float* red = (LAS float*)(F.lds + 16384);
        for (int i = F.tid; i < 3072; i += 512) { const int m = i >> 10, k = i & 1023; const float v = (m == 0) ? INP(5)[k] : INP(4)[(m - 1) * 1024 + k]; scv[i] = v * sigmoidf_(v); }
        __syncthreads();
        const int l = F.bid / 96, c0 = (F.bid % 96) * 64;
        const float* w = INP(6) + (size_t)l * 1024 * 6144 + c0 + F.lane;
        float a0 = 0.f, a1 = 0.f, a2 = 0.f;
        const int kb = F.wave * 128;
#pragma unroll 16
        for (int k = 0; k < 128; ++k) { const float wv = w[(size_t)(kb + k) * 6144]; a0 += scv[kb + k] * wv; a1 += scv[1024 + kb + k] * wv; a2 += scv[2048 + kb + k] * wv; }
        red[(F.wave * 3 + 0) * 64 + F.lane] = a0; red[(F.wave * 3 + 1) * 64 + F.lane] = a1; red[(F.wave * 3 + 2) * 64 + F.lane] = a2;
        __syncthreads();
        if (F.wave < 3) { float s = INP(7)[l * 6144 + c0 + F.lane];
#pragma unroll
            for (int w8 = 0; w8 < 8; ++w8) s += red[(w8 * 3 + F.wave) * 64 + F.lane];
            ((float*)(ws + WS_MOD))[(l * 3 + F.wave) * 6144 + c0 + F.lane] = s; }
        __syncthreads();
    } else __syncthreads();
    LAS float* scr = (LAS float*)(F.lds + F.wave * 16384);
    for (int l = 0; l < DEPTH; ++l) {
        unsigned char* wl = ws + WS_W + (size_t)l * W_LAYER;
        {
            const float* W = INP(10) + (size_t)l * 1024 * IN_COLS; bf16_t* WT = (bf16_t*)(wl + W_IN); constexpr int nblk = IN_COLS / 32;
            for (int it = F.gw; it < 16 * nblk; it += F.NGW) { const int kb = it / nblk, nb = it % nblk, n0 = nb * 32;
                if (n0 >= OFF_FN && n0 < OFF_GATE) continue;
                const int dr = (n0 < OFF_FN) ? n0 : 2560 + (n0 - OFF_GATE);
                transpose_item(W, IN_COLS, WT, 1024, kb * 64, n0, dr, scr, F.lane); }
            for (int it = F.gw; it < 96 * 2; it += F.NGW) { const int r = 2464 + it / 2, h = it & 1; *(u32x4*)(WT + (size_t)r * 1024 + h * 512 + F.lane * 8) = (u32x4){0u, 0u, 0u, 0u}; }
        }
#define TR_SIMPLE(idx, KK, NN, OFF) { const float* W = INP(idx) + (size_t)l * (KK) * (NN); bf16_t* WT = (bf16_t*)(wl + (OFF)); constexpr int nblk = (NN) / 32; \
            for (int it = F.gw; it < ((KK) / 64) * nblk; it += F.NGW) { const int kb = it / nblk, nb = it % nblk; transpose_item(W, (NN), WT, (KK), kb * 64, nb * 32, nb * 32, scr, F.lane); } }
        TR_SIMPLE(12, 384, 768, W_QB)
        TR_SIMPLE(14, 256, 1024, W_KVB)
#define TR_CAT(idx, KK, KOFF) { const float* W = INP(idx) + (size_t)l * (KK) * 1024; bf16_t* WT = (bf16_t*)(wl + W_CAT) + (KOFF); \
            for (int it = F.gw; it < ((KK) / 64) * 32; it += F.NGW) { const int kb = it / 32, nb = it % 32; transpose_item(W, 1024, WT, 1280, kb * 64, nb * 32, nb * 32, scr, F.lane); } }
        TR_CAT(15, 512, 0)
        TR_CAT(20, 256, 512)
        TR_CAT(22, 256, 768)
        TR_CAT(23, 256, 1024)
#undef TR_CAT
        TR_SIMPLE(24, 1024, 1024, W_OUT)
        TR_SIMPLE(27, 2816, 1024, W_DN)
#undef TR_SIMPLE
        for (int gu = 0; gu < 2; ++gu) {
            const float* W = (gu ? INP(26) : INP(25)) + (size_t)l * 1024 * FF; bf16_t* WT = (bf16_t*)(wl + W_GU); constexpr int nblk = FF / 32;
            for (int it = F.gw; it < 16 * nblk; it += F.NGW) { const int kb = it / nblk, nb = it % nblk, n0 = nb * 32;
                transpose_item(W, FF, WT, 1024, kb * 64, n0, (n0 / 128) * 256 + gu * 128 + (n0 % 128), scr, F.lane); }
        }
        {
            const float* W = INP(10) + (size_t)l * 1024 * IN_COLS; bf16_t* WT = (bf16_t*)(wl + W_IN);
            for (int it = F.gw; it < 128; it += F.NGW) { const int kc = it >> 2, g = it & 3, k0 = kc * 32;
#pragma unroll 8
                for (int i = 0; i < 32; ++i) scr[i * 64 + F.lane] = W[(size_t)(k0 + i) * IN_COLS + OFF_FN + g * 64 + F.lane];
                LDS_WAIT(); asm volatile("" ::: "memory");
                float aP[32], aQ[32];
#pragma unroll
                for (int k = 0; k < 32; ++k) { aP[k] = 0.f; aQ[k] = 0.f; }
                for (int n4 = 0; n4 < 16; ++n4) { float c[4], sn[4];
#pragma unroll
                    for (int e = 0; e < 4; ++e) { const int ix = (F.lane * (4 * n4 + e)) & 63; c[e] = misc[ix]; sn[e] = misc[64 + ix]; }
#pragma unroll
                    for (int k = 0; k < 32; ++k) { const f32x4 w = *(const LAS f32x4*)(scr + k * 64 + 4 * n4);
                        aP[k] += w.x * c[0] + w.y * c[1] + w.z * c[2] + w.w * c[3]; aQ[k] += w.x * sn[0] + w.y * sn[1] + w.z * sn[2] + w.w * sn[3]; } }
                bf16_t* rp = WT + (size_t)(OFF_FN + g * 64 + F.lane) * 1024 + k0; bf16_t* rq = WT + (size_t)(OFF_GATE + g * 64 + F.lane) * 1024 + k0;
#pragma unroll
                for (int j = 0; j < 4; ++j) {
                    *(u32x4*)(rp + 8 * j) = (u32x4){cvt_pk_bf16(aP[8 * j] * 0.125f, aP[8 * j + 1] * 0.125f), cvt_pk_bf16(aP[8 * j + 2] * 0.125f, aP[8 * j + 3] * 0.125f), cvt_pk_bf16(aP[8 * j + 4] * 0.125f, aP[8 * j + 5] * 0.125f), cvt_pk_bf16(aP[8 * j + 6] * 0.125f, aP[8 * j + 7] * 0.125f)};
                    *(u32x4*)(rq + 8 * j) = (u32x4){cvt_pk_bf16(aQ[8 * j] * 0.125f, aQ[8 * j + 1] * 0.125f), cvt_pk_bf16(aQ[8 * j + 2] * 0.125f, aQ[8 * j + 3] * 0.125f), cvt_pk_bf16(aQ[8 * j + 4] * 0.125f, aQ[8 * j + 5] * 0.125f), cvt_pk_bf16(aQ[8 * j + 6] * 0.125f, aQ[8 * j + 7] * 0.125f)}; }
                LDS_WAIT(); asm volatile("" ::: "memory");
            }
        }
    }
    {
        bf16_t* TL = (bf16_t*)(ws + WS_DFTL); const int gt = F.gw * 64 + F.lane, NT = F.NGW * 64;
        for (int it = gt; it < 2048 * 512; it += NT) { const int k = it >> 9, c8 = (it & 511) * 8; float v[8];
#pragma unroll
            for (int e = 0; e < 8; ++e) { const int c = c8 + e, t = c & 2047; const float fr = (float)((k * t) & 2047) * (1.f / 2048.f);
                v[e] = ((c < 2048) ? __builtin_amdgcn_cosf(fr) : -__builtin_amdgcn_sinf(fr)) * 0.022097086912079608f; }
            *(u32x4*)(TL + (size_t)k * 4096 + c8) = (u32x4){cvt_pk_bf16(v[0], v[1]), cvt_pk_bf16(v[2], v[3]), cvt_pk_bf16(v[4], v[5]), cvt_pk_bf16(v[6], v[7])}; }
        bf16_t* TC = (bf16_t*)(ws + WS_DFTC);
        for (int it = gt; it < 256 * 64; it += NT) { const int k = it >> 6, c8 = (it & 63) * 8; float v[8];
#pragma unroll
            for (int e = 0; e < 8; ++e) { const int c = c8 + e, t = c & 255; const float fr = (float)((k * t) & 255) * (1.f / 256.f);
                v[e] = ((c < 256) ? __builtin_amdgcn_cosf(fr) : -__builtin_amdgcn_sinf(fr)) * 0.0625f; }
            *(u32x4*)(TC + (size_t)k * 512 + c8) = (u32x4){cvt_pk_bf16(v[0], v[1]), cvt_pk_bf16(v[2], v[3]), cvt_pk_bf16(v[4], v[5]), cvt_pk_bf16(v[6], v[7])}; }
        if (F.gw == F.NGW - 1) { float* R = (float*)(ws + WS_ROPE);
            for (int i = F.lane; i < 512; i += 64) { const int pos = i >> 3, f = i & 7; const float inv = __builtin_amdgcn_exp2f(-(float)f * 1.6609640474436813f);
                const float rev = ((float)pos * inv) * 0.15915494309189535f; R[2 * i] = __builtin_amdgcn_cosf(rev); R[2 * i + 1] = __builtin_amdgcn_sinf(rev); } }
    }
}

__device__ __forceinline__ void norm_row(const float* xrow, float* xcopy, const float* g, const float* sc, const float* sh, bf16_t* orow, int lane) {
    const f32x4* xr = (const f32x4*)xrow + lane; f32x4 v[4]; float s = 0.f;
#pragma unroll
    for (int j = 0; j < 4; ++j) { v[j] = xr[64 * j]; s += (v[j].x * v[j].x + v[j].y * v[j].y) + (v[j].z * v[j].z + v[j].w * v[j].w); }
    if (xcopy) {
#pragma unroll
        for (int j = 0; j < 4; ++j) ((f32x4*)xcopy + lane)[64 * j] = v[j]; }
    const float rstd = 1.f / sqrtf(wave_sum(s) * (1.f / D) + EPS);
#pragma unroll
    for (int j = 0; j < 4; ++j) { const int c = 4 * (64 * j + lane); const f32x4 gg = *(const f32x4*)(g + c), ss = *(const f32x4*)(sc + c), hh = *(const f32x4*)(sh + c);
        const f32x4 y = v[j] * rstd * gg * (ss + 1.f) + hh;
        *(u32x2*)(orow + c) = (u32x2){cvt_pk_bf16(y.x, y.y), cvt_pk_bf16(y.z, y.w)}; }
}
__device__ __forceinline__ int mod_of_row(int r) { return r < NCTX ? 0 : 1 + ((r - NCTX) >> 11); }
__device__ __forceinline__ int kvrow_of_row(int r) { return r < NCTX ? r : NCTX + ((r - NCTX) >> 11) * 2304 + 256 + ((r - NCTX) & 2047); }

__device__ __forceinline__ void phase_norm(Ctx& F, int l, int which  ) {
    const float* mod = (const float*)(F.ws + WS_MOD) + l * 3 * 6144; const float* g = (which ? INP(9) : INP(8)) + l * D;
    bf16_t* XN = (bf16_t*)(F.ws + WS_XN); const float* x0 = INP(0); const float* x1 = INP(1);
    for (int r = F.gw; r < MROWS; r += F.NGW) { const float* m = mod + mod_of_row(r) * 6144 + (which ? 3072 : 0);
        const bool first = (l == 0 && which == 0);
        const float* xrow = first ? (r < NCTX ? x0 + (size_t)r * D : x1 + (size_t)(r - NCTX) * D) : F.out + (size_t)r * D;
        norm_row(xrow, first ? F.out + (size_t)r * D : nullptr, g, m + 1024, m, XN + (size_t)r * D, F.lane); }
}

__device__ __forceinline__ void phase_prep(Ctx& F, int l) {
    unsigned char* ws = F.ws; const int lane = F.lane;
    const bf16_t* PROJ = (const bf16_t*)(ws + WS_PROJ);
    bf16_t* QN = (bf16_t*)(ws + WS_XN + XN_QN); bf16_t* CKV = (bf16_t*)(ws + WS_XN + XN_CKV); bf16_t* KR = (bf16_t*)(ws + WS_XN + XN_KR);
    bf16_t* ACAT = (bf16_t*)(ws + WS_ACAT);
    float* out_ckv = F.out + (size_t)MROWS * D; float* out_kr = out_ckv + (size_t)NBC * DEPTH * SEQ * KVL;
    const float* rope = (const float*)(ws + WS_ROPE);
    {
        LAS float* ut = (LAS float*)F.lds;
        LAS float* wl = (LAS float*)(F.lds + 65536);
        const float* wdw = INP(16) + l * 31 * 256; const float* bdw = INP(17) + l * 256; const float* gln = INP(18) + l * 256; const float* bln = INP(19) + l * 256;
        __syncthreads();
        for (int i = F.tid; i < 31 * 256; i += 512) wl[i] = wdw[i];
        for (int item = F.bid; item < 256; item += F.G) {
            const int r0 = item * 32; const int s0 = r0 < NCTX ? (r0 & ~255) : NCTX + ((r0 - NCTX) & ~2047); const int s1 = s0 + (r0 < NCTX ? 256 : 2048);
            __syncthreads();
            for (int idx = F.tid; idx < 62 * 128; idx += 512) { const int rr = idx >> 7, cp = idx & 127; const int row = r0 - 15 + rr; float u0 = 0.f, u1 = 0.f;
                if (row >= s0 && row < s1) { const unsigned a = *(const unsigned*)(PROJ + (size_t)row * PROJ_LD + OFF_CONF + 2 * cp), b = *(const unsigned*)(PROJ + (size_t)row * PROJ_LD + OFF_CONF + 256 + 2 * cp);
                    u0 = bf_lo(a) * sigmoidf_(bf_lo(b)); u1 = bf_hi(a) * sigmoidf_(bf_hi(b)); }
                ut[rr * 256 + 2 * cp] = u0; ut[rr * 256 + 2 * cp + 1] = u1; }
            __syncthreads();
            float acc[4][4];
#pragma unroll
            for (int q = 0; q < 4; ++q) { const float b = bdw[lane + 64 * q];
#pragma unroll
                for (int ri = 0; ri < 4; ++ri) acc[ri][q] = b; }
            for (int j = 0; j < 31; ++j) {
#pragma unroll
                for (int q = 0; q < 4; ++q) { const float w = wl[j * 256 + lane + 64 * q];
#pragma unroll
                    for (int ri = 0; ri < 4; ++ri) acc[ri][q] += ut[(4 * F.wave + ri + j) * 256 + lane + 64 * q] * w; } }
#pragma unroll
            for (int ri = 0; ri < 4; ++ri) { const float mean = wave_sum(acc[ri][0] + acc[ri][1] + acc[ri][2] + acc[ri][3]) * (1.f / 256.f); float q2 = 0.f;
#pragma unroll
                for (int q = 0; q < 4; ++q) { const float d = acc[ri][q] - mean; q2 += d * d; }
                const float rstd = 1.f / sqrtf(wave_sum(q2) * (1.f / 256.f) + EPS);
#pragma unroll
                for (int q = 0; q < 4; ++q) { const int c = lane + 64 * q; const float y = (acc[ri][q] - mean) * rstd * gln[c] + bln[c]; ACAT[(size_t)(r0 + 4 * F.wave + ri) * ACAT_LD + AC_UC + c] = f2bf(y * sigmoidf_(y)); } }
        }
        __syncthreads();
    }
    const float* gqa = INP(11) + l * QL; const float* gkva = INP(13) + l * KVL; const float* wc3 = INP(21) + l * 3 * 256;
    for (int r = F.gw; r < MROWS; r += F.NGW) {
        const bf16_t* pr = PROJ + (size_t)r * PROJ_LD; const int mr = kvrow_of_row(r);
        {
            float v[6]; float s = 0.f;
#pragma unroll
            for (int j = 0; j < 3; ++j) { const unsigned u = *(const unsigned*)(pr + 2 * lane + 128 * j); v[2 * j] = bf_lo(u); v[2 * j + 1] = bf_hi(u); s += v[2 * j] * v[2 * j] + v[2 * j + 1] * v[2 * j + 1]; }
            const float rstd = 1.f / sqrtf(wave_sum(s) * (1.f / QL) + EPS);
#pragma unroll
            for (int j = 0; j < 3; ++j) { const int c = 2 * lane + 128 * j; *(unsigned*)(QN + (size_t)r * QL + c) = cvt_pk_bf16(v[2 * j] * rstd * gqa[c], v[2 * j + 1] * rstd * gqa[c + 1]); }
        }
        {
            const u32x2 u = *(const u32x2*)(pr + OFF_KVA + 4 * lane); f32x4 v = {bf_lo(u.x), bf_hi(u.x), bf_lo(u.y), bf_hi(u.y)};
            const float rstd = 1.f / sqrtf(wave_sum((v.x * v.x + v.y * v.y) + (v.z * v.z + v.w * v.w)) * (1.f / KVL) + EPS);
            v = v * rstd * *(const f32x4*)(gkva + 4 * lane);
            *(u32x2*)(CKV + (size_t)mr * KVL + 4 * lane) = (u32x2){cvt_pk_bf16(v.x, v.y), cvt_pk_bf16(v.z, v.w)};
            if (r < NCTX) { const int b = r >> 8, t = r & 255; *(f32x4*)(out_ckv + ((size_t)(b * DEPTH + l) * SEQ + t) * KVL + 4 * lane) = v; }
        }
        {
            const float v = bf1(pr[OFF_KR + (lane & 31)]);
            if (r < NCTX) { if (lane < 32) { const int b = r >> 8, t = r & 255; out_kr[((size_t)(b * DEPTH + l) * SEQ + t) * QKR + lane] = v; KR[(size_t)mr * QKR + lane] = f2bf(v); } }
            else { const int t = (r - NCTX) & 2047, j = lane & 31; const int pos = (j & 16) ? (t & 63) : (t >> 6); const float c = rope[(pos * 8 + (j & 7)) * 2], s = rope[(pos * 8 + (j & 7)) * 2 + 1];
                const float p = __shfl_xor(v, 8); const float o = (j & 8) ? (v * c + p * s) : (v * c - p * s);
                if (lane < 32) KR[(size_t)mr * QKR + lane] = f2bf(o); }
        }
        {
            const int s0 = r < NCTX ? (r & ~255) : NCTX + ((r - NCTX) & ~2047); const int s1 = s0 + (r < NCTX ? 256 : 2048);
            f32x4 a = {0.f, 0.f, 0.f, 0.f};
#pragma unroll
            for (int d = 0; d < 3; ++d) { const int row = r + d - 1;
                if (row >= s0 && row < s1) { const bf16_t* q = PROJ + (size_t)row * PROJ_LD + OFF_SC; const u32x2 gc = *(const u32x2*)(q + 256 + 4 * lane), xs = *(const u32x2*)(q + 512 + 4 * lane);
                    const f32x4 w = *(const f32x4*)(wc3 + d * 256 + 4 * lane);
                    a.x += w.x * bf_lo(gc.x) * bf_lo(xs.x); a.y += w.y * bf_hi(gc.x) * bf_hi(xs.x); a.z += w.z * bf_lo(gc.y) * bf_lo(xs.y); a.w += w.w * bf_hi(gc.y) * bf_hi(xs.y); } }
            const u32x2 gb = *(const u32x2*)(pr + OFF_SC + 4 * lane);
            *(u32x2*)(ACAT + (size_t)r * ACAT_LD + AC_SC + 4 * lane) = (u32x2){cvt_pk_bf16(a.x * bf_lo(gb.x), a.y * bf_hi(gb.x)), cvt_pk_bf16(a.z * bf_lo(gb.y), a.w * bf_hi(gb.y))};
        }
    }
    const float* cckv = INP(2); const float* ckr = INP(3);
    for (int i = F.gw; i < NBL * PAST; i += F.NGW) { const int b = i >> 8, p = i & 255; const int mr = NCTX + b * 2304 + p;
        const f32x4 v = *(const f32x4*)(cckv + ((size_t)(b * DEPTH + l) * PAST + p) * KVL + 4 * lane);
        *(u32x2*)(CKV + (size_t)mr * KVL + 4 * lane) = (u32x2){cvt_pk_bf16(v.x, v.y), cvt_pk_bf16(v.z, v.w)};
        if (lane < 32) KR[(size_t)mr * QKR + lane] = f2bf(ckr[((size_t)(b * DEPTH + l) * PAST + p) * QKR + lane]); }
    {
        LAS bf16_t* tl = (LAS bf16_t*)(F.lds + F.wave * 16384);
        bf16_t* PQL = (bf16_t*)(ws + WS_PQL); bf16_t* PQC = (bf16_t*)(ws + WS_PQC);
        for (int it = F.gw; it < 128 * 8; it += F.NGW) { const int rc = it >> 3, part = (it >> 2) & 1, cq = it & 3;
            const int col0 = (part ? OFF_GATE : OFF_FN) + cq * 64;
#pragma unroll 4
            for (int i = 0; i < 32; ++i) { const int t = 2 * i + (lane >> 5), c2 = lane & 31; const unsigned u = *(const unsigned*)(PROJ + (size_t)(rc * 64 + t) * PROJ_LD + col0 + 2 * c2);
                tl[(2 * c2) * 72 + t] = (bf16_t)(u & 0xffffu); tl[(2 * c2 + 1) * 72 + t] = (bf16_t)(u >> 16); }
            LDS_WAIT(); asm volatile("" ::: "memory");
            bf16_t* dst; int ldd;
            if (rc < 64) { const int b = rc >> 2, t0 = (rc & 3) * 64; dst = PQC + ((size_t)b * 256 + cq * 64) * 512 + part * 256 + t0; ldd = 512; }
            else { const int b = (rc - 64) >> 5, t0 = ((rc - 64) & 31) * 64; dst = PQL + ((size_t)b * 256 + cq * 64) * 4096 + part * 2048 + t0; ldd = 4096; }
#pragma unroll
            for (int i = 0; i < 8; ++i) { const int ch = 8 * i + (lane >> 3), t8 = (lane & 7) * 8; const u32x4 v = *(const LAS u32x4*)(tl + ch * 72 + t8); *(u32x4*)(dst + (size_t)ch * ldd + t8) = v; }
            LDS_WAIT(); asm volatile("" ::: "memory");
        }
    }
}

__device__ __forceinline__ void phase_attn(Ctx& F) {
    unsigned char* ws = F.ws;
    {
        const bf16_t* P = (const bf16_t*)(ws + WS_DFTP); bf16_t* Fo = (bf16_t*)(ws + WS_ACAT) + (size_t)NCTX * ACAT_LD + AC_F;
        const int gt = F.gw * 64 + F.lane, NT = F.NGW * 64;
        for (int it = gt; it < NLAT * 32; it += NT) { const int row = it >> 5, c8 = (it & 31) * 8; const int b = row >> 11, k = row & 2047; float sv[8] = {0.f, 0.f, 0.f, 0.f, 0.f, 0.f, 0.f, 0.f};
#pragma unroll
            for (int ks = 0; ks < 8; ++ks) { const u32x4 p = *(const u32x4*)(P + ((size_t)(b * 8 + ks) * 2048 + k) * 256 + c8);
                sv[0] += bf_lo(p.x); sv[1] += bf_hi(p.x); sv[2] += bf_lo(p.y); sv[3] += bf_hi(p.y); sv[4] += bf_lo(p.z); sv[5] += bf_hi(p.z); sv[6] += bf_lo(p.w); sv[7] += bf_hi(p.w); }
            *(u32x4*)(Fo + (size_t)row * ACAT_LD + c8) = (u32x4){cvt_pk_bf16(sv[0], sv[1]), cvt_pk_bf16(sv[2], sv[3]), cvt_pk_bf16(sv[4], sv[5]), cvt_pk_bf16(sv[6], sv[7])}; }
    }
    attn::Tensors T{(const bf16_t*)(ws + WS_PROJ + PJ_Q), (const bf16_t*)(ws + WS_PROJ + PJ_KV), (const bf16_t*)(ws + WS_XN + XN_KR), (bf16_t*)(ws + WS_ACAT)};
    for (int u = F.bid; u < 512; u += F.G) {
        if (u < 256) { const int b = u >> 7, h = (u >> 4) & 7, qb = u & 15;
            attn::unit(T, NCTX + b * 2048 + qb * 128, NCTX + b * 2304, 18, h, (char*)F.lds, F.tid); }
        else { const int v = u - 256; const int b = v >> 4, h = (v >> 1) & 7, qb = v & 1;
            attn::unit(T, b * 256 + qb * 128, b * 256, 2, h, (char*)F.lds, F.tid); }
    }
}

__device__ __forceinline__ void phase_final(Ctx& F) {
    const float* g = INP(28);
    for (int r = F.gw; r < MROWS; r += F.NGW) { f32x4* xr = (f32x4*)(F.out + (size_t)r * D) + F.lane; f32x4 v[4]; float s = 0.f;
#pragma unroll
        for (int j = 0; j < 4; ++j) { v[j] = xr[64 * j]; s += (v[j].x * v[j].x + v[j].y * v[j].y) + (v[j].z * v[j].z + v[j].w * v[j].w); }
        const float rstd = 1.f / sqrtf(wave_sum(s) * (1.f / D) + EPS);
#pragma unroll
        for (int j = 0; j < 4; ++j) xr[64 * j] = v[j] * rstd * *(const f32x4*)(g + 4 * (64 * j + F.lane)); }
}

constexpr int STEPS_PER_LAYER = 10, N_STEPS = 2 + DEPTH * STEPS_PER_LAYER;
__host__ __device__ constexpr bool barrier_after(int s) { return s < N_STEPS - 1; }

__global__ void __launch_bounds__(512, 2) mk_fwd(Args args) {
    extern __shared__ __attribute__((aligned(16))) unsigned char lds_raw[];
    volatile LAS unsigned* MISC = (volatile LAS unsigned*)((LAS unsigned char*)lds_raw + MISC_OFF);
    if (threadIdx.x < 64) MISC[threadIdx.x] = 0u;
    __syncthreads();
    XcdBarrier bar; bar.bar = (unsigned*)(args.ws + WS_CTL) + 1024; bar.x = 0; bar.st = nullptr;
    if (MK_N_LAUNCHES == 1) bar = xcd_barrier_post((unsigned*)(args.ws + WS_CTL) + 1024, MISC + 8);
    for (int step = args.step_lo; step < args.step_hi; ++step) {
        const int kprobe = (step == 0) ? 16 : (step == N_STEPS - 1) ? 17 : (step - 1) % STEPS_PER_LAYER;
        const int nrep = ((PROBE_MASK >> kprobe) & 1) ? 2 : 1;
      for (int rep = 0; rep < nrep; ++rep) {
        unsigned char* ws = args.ws; float* outp = args.out; int tid_ = threadIdx.x; int bid_ = blockIdx.x;
        asm volatile("" : "+s"(ws), "+s"(outp), "+v"(tid_), "+s"(bid_));
        Ctx F; F.lds = (LAS unsigned char*)lds_raw; F.tid = tid_; F.lane = F.tid & 63; F.wave = __builtin_amdgcn_readfirstlane(F.tid >> 6);
        F.G = gridDim.x; F.gw = bid_ * 8 + F.wave; F.NGW = F.G * 8; F.out = outp; F.ws = ws; F.bid = bid_;
        int ngemm = 0;
        if (step == 0) prologue(F);
        else if (step == N_STEPS - 1) phase_final(F);
        else {
            const int l = (step - 1) / STEPS_PER_LAYER, k = (step - 1) % STEPS_PER_LAYER;
            unsigned char* wl = ws + WS_W + (size_t)l * W_LAYER;
            const float* modl = (const float*)(ws + WS_MOD) + l * 3 * 6144; (void)modl;
            switch (k) {
            case 0: phase_norm(F, l, 0); break;
            case 1: ngemm = 1; break;
            case 2: phase_prep(F, l); break;
            case 3: ngemm = 2; break;
            case 4: phase_attn(F); break;
            case 5: case 6: case 8: case 9: ngemm = 1; break;
            default: phase_norm(F, l, 1); break;
            }
            for (int r = 0; r < ngemm; ++r) {
                { unsigned char* w2 = F.ws; float* o2 = F.out; asm volatile("" : "+s"(w2), "+s"(o2)); ws = w2; F.out = o2; wl = ws + WS_W + (size_t)l * W_LAYER; modl = (const float*)(ws + WS_MOD) + l * 3 * 6144; }
                pg8::Job J{}; J.nZ = 1; J.a_lo = J.a_hi = J.b_lo = J.b_hi = 0; J.zso = 0; J.aux = 0; J.ldc = 0; int single = -1;
                if (k == 1) { J.A = (const char*)(ws + WS_XN); J.Bt = (const char*)(wl + W_IN); J.lda = 1024; J.ldb = 1024; J.K = 1024; J.nM = 32; J.nN = 26; J.kind = pg8::EK_PROJ; J.o0 = ws + WS_PROJ; J.o1 = ws + WS_GATES; }
                else if (k == 3) {
                    const int L = F.bid + r * F.G; if (L >= 376) continue;
                    if (L < 128) { single = L; J.A = (const char*)(ws + WS_DFTL); J.Bt = (const char*)(ws + WS_PQL); J.lda = 4096; J.ldb = 4096; J.K = 512; J.nM = 8; J.nN = 1; J.nZ = 16; J.kind = pg8::EK_BF16;
                        J.a_lo = 1024; J.b_lo = 1024; J.b_hi = (long)256 * 4096 * 2; J.o0 = ws + WS_DFTP; J.ldc = 256; J.zso = (long)2048 * 256; }
                    else if (L < 144) { single = L - 128; J.A = (const char*)(ws + WS_DFTC); J.Bt = (const char*)(ws + WS_PQC); J.lda = 512; J.ldb = 512; J.K = 512; J.nM = 1; J.nN = 1; J.nZ = 16; J.kind = pg8::EK_BF16;
                        J.b_lo = (long)256 * 512 * 2; J.b_hi = (long)8 * 256 * 512 * 2; J.o0 = ws + WS_ACAT + AC_F * 2; J.ldc = ACAT_LD; J.zso = (long)256 * ACAT_LD; }
                    else if (L < 240) { single = L - 144; J.A = (const char*)(ws + WS_XN + XN_QN); J.Bt = (const char*)(wl + W_QB); J.lda = 384; J.ldb = 384; J.K = 384; J.nM = 32; J.nN = 3; J.kind = pg8::EK_Q;
                        J.o0 = ws + WS_PROJ + PJ_Q; J.p0 = ws + WS_ROPE; }
                    else { single = L - 240; J.A = (const char*)(ws + WS_XN + XN_CKV); J.Bt = (const char*)(wl + W_KVB); J.lda = 256; J.ldb = 256; J.K = 256; J.nM = 34; J.nN = 4; J.kind = pg8::EK_BF16;
                        J.o0 = ws + WS_PROJ + PJ_KV; J.ldc = 1024; }
                }
                else if (k == 5) { J.A = (const char*)(ws + WS_ACAT); J.Bt = (const char*)(wl + W_CAT); J.lda = 1280; J.ldb = 1280; J.K = 1280; J.nM = 32; J.nN = 4; J.kind = pg8::EK_MERGE; J.o0 = ws + WS_PROJ + PJ_Q; J.p0 = ws + WS_GATES; }
                else if (k == 6) { J.A = (const char*)(ws + WS_PROJ + PJ_Q); J.Bt = (const char*)(wl + W_OUT); J.lda = 1024; J.ldb = 1024; J.K = 1024; J.nM = 32; J.nN = 4; J.kind = pg8::EK_RESID; J.o0 = F.out; J.p1 = F.out; J.p0 = modl; J.aux = 2048; }
                else if (k == 8) { J.A = (const char*)(ws + WS_XN); J.Bt = (const char*)(wl + W_GU); J.lda = 1024; J.ldb = 1024; J.K = 1024; J.nM = 32; J.nN = 22; J.kind = pg8::EK_SWIGLU; J.o0 = ws + WS_GATES; }
                else { J.A = (const char*)(ws + WS_GATES); J.Bt = (const char*)(wl + W_DN); J.lda = FF; J.ldb = FF; J.K = FF; J.nM = 32; J.nN = 4; J.kind = pg8::EK_RESID; J.o0 = F.out; J.p1 = F.out; J.p0 = modl; J.aux = 5120; }
                if (PROBE_MASK != 0 && rep + 1 < nrep && J.kind == pg8::EK_RESID) J.o0 = ws + WS_ACAT;
                pg8::Order S; if (single >= 0) S.init_single(J, single); else S.init(J, F.G, F.bid);
                pg8::gemm_phase(F.lds, J, S, F.tid);
            }
        }
      }
        if (step + 1 < args.step_hi && barrier_after(step)) { xcd_barrier(bar); if ((PROBE_MASK >> 18) & 1) xcd_barrier(bar); }
    }
}

extern "C" void kernel_launch(void* const* d_in, const int* in_sizes, int n_in, void* d_out, int out_size, void* d_ws, size_t ws_size, hipStream_t stream) {
    static int grid = 0;
    if (grid == 0) {
        if (n_in != 29 || ws_size < WS_END) { fprintf(stderr, "kernel_launch: expected 29 inputs and >= %zu bytes of workspace; got %d, %zu\n", (size_t)WS_END, n_in, ws_size); grid = -1; return; }
        int dev = 0, cus = 0, per_cu = 0;
        if (hipGetDevice(&dev) != hipSuccess || hipDeviceGetAttribute(&cus, hipDeviceAttributeMultiprocessorCount, dev) != hipSuccess) { grid = -1; return; }
        if (hipFuncSetAttribute((const void*)mk_fwd, hipFuncAttributeMaxDynamicSharedMemorySize, LDS_BYTES) != hipSuccess) { fprintf(stderr, "kernel_launch: hipFuncSetAttribute failed\n"); grid = -1; return; }
        if (hipOccupancyMaxActiveBlocksPerMultiprocessor(&per_cu, (const void*)mk_fwd, 512, LDS_BYTES) != hipSuccess || per_cu < 1) fprintf(stderr, "kernel_launch: occupancy query reports %d\n", per_cu);
        (void)hipGetLastError();
        grid = cus;
    }
    if (grid < 0) return;
    (void)hipMemsetAsync((char*)d_ws + WS_CTL, 0, CTL_ZERO_BYTES, stream);
    Args a{};
    for (int i = 0; i < 29; ++i) a.in[i] = (const float*)d_in[i];
    a.out = (float*)d_out; a.ws = (unsigned char*)d_ws;
    if (MK_N_LAUNCHES == 1) { a.step_lo = 0; a.step_hi = N_STEPS; hipLaunchKernelGGL(mk_fwd, dim3(grid), dim3(512), LDS_BYTES, stream, a); }
    else {
        int lo = 0;
        for (int s = 0; s < N_STEPS; ++s) if (barrier_after(s) || s == N_STEPS - 1) { a.step_lo = lo; a.step_hi = s + 1; hipLaunchKernelGGL(mk_fwd, dim3(grid), dim3(512), LDS_BYTES, stream, a); lo = s + 1; }
    }
}
```

```cpp
#include <hip/hip_runtime.h>
#include <hip/hip_bf16.h>
#include <cstdio>
#include <cstdint>

#ifndef MK_N_LAUNCHES
#define MK_N_LAUNCHES 1
#endif
#ifndef PROBE_TSTEP
#define PROBE_TSTEP -1
#endif
#ifndef PROBE_MASK
#define PROBE_MASK 0
#endif

#define LAS __attribute__((address_space(3)))
#define GAS __attribute__((address_space(1)))
typedef unsigned short bf16_t;
typedef short bf16x8 __attribute__((ext_vector_type(8)));
typedef short s16x4 __attribute__((ext_vector_type(4)));
typedef float f32x4 __attribute__((ext_vector_type(4)));
typedef float f32x2 __attribute__((ext_vector_type(2)));
typedef float f32x16 __attribute__((ext_vector_type(16)));
typedef unsigned u32x4 __attribute__((ext_vector_type(4)));
typedef unsigned u32x2 __attribute__((ext_vector_type(2)));

constexpr int D = 1024, NCTX = 4096, NLAT = 4096, MROWS = 8192, DEPTH = 2;
constexpr int SEQ = 256, DEC_SEQ = 2048, PAST = 256, NBC = 16, NBL = 2;
constexpr int NH = 8, QKN = 64, QKR = 32, VH = 64, QL = 384, KVL = 256;
constexpr int IN_COLS = 6304, FF = 2816;
constexpr int OFF_KVA = 384, OFF_KR = 640, OFF_CONF = 672, OFF_SC = 1184, OFF_FN = 1952, OFF_GATE = 2208;
constexpr int PROJ_LD = 2464;
constexpr int WIN_N = 6656;
constexpr int KVROWS = 8704;
constexpr float EPS = 1e-6f;
constexpr float QSCALE = 0.10206207261596577f * 1.4426950408889634f;

constexpr size_t al256(size_t x) { return (x + 255) & ~(size_t)255; }
constexpr size_t WS_CTL = 0, CTL_ZERO_BYTES = 163840;
constexpr size_t WS_SUMSQ = 32768;
constexpr size_t WS_MOD = CTL_ZERO_BYTES;
constexpr size_t WS_ROPE = WS_MOD + al256(2 * 3 * 6144 * 4);
constexpr size_t WS_BIAS = WS_ROPE + 4096;
constexpr int BIAS_LD = 6656;
constexpr size_t WS_DFTL = WS_BIAS + (size_t)2 * 2 * 3 * BIAS_LD * 4;
constexpr size_t WS_DFTC = WS_DFTL + (size_t)2048 * 4096 * 2;
constexpr size_t WS_W = WS_DFTC + (size_t)256 * 512 * 2;
constexpr size_t W_IN = 0;
constexpr size_t W_QB = W_IN + (size_t)WIN_N * 1024 * 2;
constexpr size_t W_KVB = W_QB + (size_t)768 * 384 * 2;
constexpr size_t W_CAT = W_KVB + (size_t)1024 * 256 * 2;
constexpr size_t W_OUT = W_CAT + (size_t)1024 * 1280 * 2;
constexpr size_t W_GU = W_OUT + (size_t)1024 * 1024 * 2;
constexpr size_t W_DN = W_GU + (size_t)5632 * 1024 * 2;
constexpr size_t W_LAYER = W_DN + (size_t)1024 * 2816 * 2;
constexpr size_t WS_XN = WS_W + 2 * W_LAYER;
constexpr size_t XN_QN = 0, XN_CKV = XN_QN + (size_t)MROWS * 384 * 2, XN_KR = XN_CKV + (size_t)KVROWS * 256 * 2;
static_assert(XN_KR + (size_t)KVROWS * 32 * 2 <= (size_t)MROWS * 1024 * 2, "XN overlay");
constexpr size_t WS_PROJ = WS_XN + (size_t)MROWS * 1024 * 2;
constexpr size_t PJ_Q = 0, PJ_KV = PJ_Q + (size_t)MROWS * 768 * 2;
static_assert(PJ_KV + (size_t)KVROWS * 1024 * 2 <= (size_t)MROWS * PROJ_LD * 2, "PROJ overlay");
constexpr size_t WS_GATES = WS_PROJ + (size_t)MROWS * PROJ_LD * 2;
constexpr size_t WS_ACAT = WS_GATES + (size_t)MROWS * 4096 * 2;
constexpr int ACAT_LD = 1280, AC_UC = 512, AC_SC = 768, AC_F = 1024;
constexpr size_t WS_PQL = WS_ACAT + (size_t)MROWS * ACAT_LD * 2;
constexpr size_t WS_PQC = WS_PQL + (size_t)2 * 256 * 4096 * 2;
constexpr size_t WS_DFTP = WS_PQC + (size_t)16 * 256 * 512 * 2;
constexpr size_t WS_END = WS_DFTP + (size_t)2 * 8 * 2048 * 256 * 2;
static_assert(WS_END <= 268435456, "workspace map exceeds 256 MiB");

constexpr int RING_BYTES = 147456, MISC_OFF = RING_BYTES, LDS_BYTES = 163840;

__device__ __forceinline__ unsigned cvt_pk_bf16(float lo, float hi) { unsigned r; asm volatile("v_cvt_pk_bf16_f32 %0, %1, %2" : "=v"(r) : "v"(lo), "v"(hi)); return r; }
__device__ __forceinline__ float bf_lo(unsigned u) { return __uint_as_float(u << 16); }
__device__ __forceinline__ float bf_hi(unsigned u) { return __uint_as_float(u & 0xffff0000u); }
__device__ __forceinline__ float bf1(bf16_t u) { return __uint_as_float((unsigned)u << 16); }
__device__ __forceinline__ bf16_t f2bf(float f) { return (bf16_t)(cvt_pk_bf16(f, 0.f) & 0xffffu); }
__device__ __forceinline__ float sigmoidf_(float x) { return __builtin_amdgcn_rcpf(1.f + __expf(-x)); }
__device__ __forceinline__ float wave_sum(float v) {
#pragma unroll
    for (int o = 1; o < 64; o <<= 1) v += __shfl_xor(v, o);
    return v;
}
#define LDS_WAIT() asm volatile("s_waitcnt lgkmcnt(0)" ::: "memory")
#define VM_WAIT() asm volatile("s_waitcnt vmcnt(0)" ::: "memory")

namespace pg8 {
constexpr int BM = 256, BK = 64, HALF = 128, HTB = HALF * BK * 2, STAGE_BYTES = 8 * HTB;
__device__ __forceinline__ int lds_byte(int r, int c) { const int st = (r >> 4) * 2 + (c >> 5), rr = r & 15, cc = c & 31, ob = rr * 64 + cc * 2; return st * 1024 + (ob ^ (((ob >> 9) & 1) << 5)); }
__device__ __forceinline__ void stage_rc(int b, int& R, int& C) { const int st = b / 1024, sb = b % 1024, swz = sb ^ (((sb >> 9) & 1) << 5); R = (st >> 1) * 16 + swz / 64; C = (st & 1) * 32 + (swz % 64) / 2; }
__device__ __forceinline__ int perm32(int rho) { const int n = rho >> 4, i = rho & 15; return 8 * (i >> 2) + 4 * n + (i & 3); }

struct Unit { int pm, pn, z, koff, nt, seg; };
struct Job {
    const char* A; const char* Bt; int lda, ldb, K; long a_lo, a_hi, b_lo, b_hi;
    int nM, nN, nZ;
    int kind, hm;
    void* o0; void* o1; void* o2; const void* p0; const void* p1; const void* p2; const void* p3; int ldc; long zso; int aux;
};
enum { EK_PROJ = 0, EK_Q, EK_BF16, EK_MERGE, EK_RESID, EK_SWIGLU };

struct Order {
    int nM, nN, nZ, nwg, G, c, single, nt, chain;
    __device__ __forceinline__ void init(const Job& j, int G_, int c_) { nM = j.nM; nN = j.nN; nZ = j.nZ; nwg = nM * nN * nZ; G = G_; c = c_; single = -1; nt = j.K / BK; chain = (j.kind == EK_MERGE); }
    __device__ __forceinline__ void init_single(const Job& j, int unit) { nM = j.nM; nN = j.nN; nZ = j.nZ; nwg = nM * nN * nZ; G = 1; c = 0; single = unit; nt = j.K / BK; chain = 0; }
    __device__ __forceinline__ bool next(int i, Unit& u) const {
        u.koff = 0; u.nt = nt; u.seg = -1;
        if (single >= 0) { if (i > 0) return false; const int per = nM * nN; u.z = single / per; const int r = single % per; u.pn = r / nM; u.pm = r % nM; return true; }
        if (chain) { u.seg = i & 3; i >>= 2; u.koff = (u.seg == 0) ? 0 : (256 + 256 * u.seg) * 2; u.nt = (u.seg == 0) ? 8 : 4; }
        const long L = (long)i * G + c; if (L >= nwg) return false;
        if (nZ > 1) { const int per = nM * nN; u.z = (int)L / per; const int r = (int)L % per; u.pn = r / nM; u.pm = r % nM; return true; }
        constexpr int NXCD = 8, WGM = 8;
        int wgid = (int)L; { const int q = nwg / NXCD, r = nwg % NXCD, xcd = wgid % NXCD, off = wgid / NXCD; wgid = (xcd < r ? xcd * (q + 1) : r * (q + 1) + (xcd - r) * q) + off; }
        const int nig = WGM * nN, gid = wgid / nig, fm = gid * WGM, gsz = (nM - fm) < WGM ? (nM - fm) : WGM;
        u.pm = fm + ((wgid % nig) % gsz); u.pn = (wgid % nig) / gsz; u.z = 0; return true;
    }
};

__device__ __forceinline__ void epilogue(const Job& J, const f32x4 (&acc)[2][2][4][2], const Unit& u, int wr, int wc, int fr, int fq) {
    const int row0 = u.pm * BM + wr * 64 + fr;
    const int cl = wc * 32 + 8 * fq;
    if (J.kind == EK_PROJ) {
        const bool isg = u.pn >= 10;
        bf16_t* base = isg ? (bf16_t*)J.o1 : (bf16_t*)J.o0; const int ldc = isg ? 4096 : PROJ_LD;
        const int col0 = (isg ? (u.pn - 10) * BM : u.pn * BM) + cl;
        const float* ssq = (const float*)J.p2; const int mi = u.pm < 16 ? 0 : (u.pm < 24 ? 1 : 2); const float* bias = (const float*)J.p3 + mi * BIAS_LD + u.pn * BM + cl;
        f32x4 bb[2][2];
#pragma unroll
        for (int bj = 0; bj < 2; ++bj) { bb[bj][0] = *(const f32x4*)(bias + bj * HALF); bb[bj][1] = *(const f32x4*)(bias + bj * HALF + 4); }
#pragma unroll
        for (int ai = 0; ai < 2; ++ai)
#pragma unroll
            for (int m = 0; m < 4; ++m) { bf16_t* rowp = base + (size_t)(row0 + ai * HALF + m * 16) * ldc + col0;
                const float rs = 1.f / sqrtf(ssq[row0 + ai * HALF + m * 16] * (1.f / D) + EPS);
#pragma unroll
                for (int bj = 0; bj < 2; ++bj) { f32x4 v0 = acc[ai][bj][m][0] * rs + bb[bj][0], v1 = acc[ai][bj][m][1] * rs + bb[bj][1];
                    if (isg) {
#pragma unroll
                        for (int e = 0; e < 4; ++e) { v0[e] = sigmoidf_(v0[e]); v1[e] = sigmoidf_(v1[e]); } }
                    u32x4 w; w.x = cvt_pk_bf16(v0[0], v0[1]); w.y = cvt_pk_bf16(v0[2], v0[3]); w.z = cvt_pk_bf16(v1[0], v1[1]); w.w = cvt_pk_bf16(v1[2], v1[3]);
                    if (isg || col0 + bj * HALF + 8 <= PROJ_LD) *(u32x4*)(rowp + bj * HALF) = w; } }
    } else if (J.kind == EK_Q) {
        bf16_t* Q = (bf16_t*)J.o0; const float* rope = (const float*)J.p0; const bool lat = u.pm >= 16;
#pragma unroll
        for (int bj = 0; bj < 2; ++bj) {
            const int G = 8 * u.pn + 4 * bj + wc; const bool isrope = lat && (G % 3 == 2);
#pragma unroll
            for (int ai = 0; ai < 2; ++ai)
#pragma unroll
                for (int m = 0; m < 4; ++m) { const int row = row0 + ai * HALF + m * 16;
                    float v[8];
#pragma unroll
                    for (int e = 0; e < 4; ++e) { v[e] = acc[ai][bj][m][0][e] * QSCALE; v[4 + e] = acc[ai][bj][m][1][e] * QSCALE; }
                    if (isrope) { const int t = (row - NCTX) & (DEC_SEQ - 1); const int pos = (fq < 2) ? (t >> 6) : (t & 63);
                        const f32x4* cs = (const f32x4*)(rope + pos * 16);
                        const f32x4 c0 = cs[0], c1 = cs[1], c2 = cs[2], c3 = cs[3];
                        const float cc[8] = {c0[0], c0[2], c1[0], c1[2], c2[0], c2[2], c3[0], c3[2]}, ss[8] = {c0[1], c0[3], c1[1], c1[3], c2[1], c2[3], c3[1], c3[3]};
#pragma unroll
                        for (int e = 0; e < 8; ++e) { const float p = __shfl_xor(v[e], 16); v[e] = (fq & 1) ? (v[e] * cc[e] + p * ss[e]) : (v[e] * cc[e] - p * ss[e]); } }
                    u32x4 w; w.x = cvt_pk_bf16(v[0], v[1]); w.y = cvt_pk_bf16(v[2], v[3]); w.z = cvt_pk_bf16(v[4], v[5]); w.w = cvt_pk_bf16(v[6], v[7]);
                    *(u32x4*)(Q + (size_t)row * 768 + u.pn * BM + bj * HALF + cl) = w; } }
    } else if (J.kind == EK_BF16) {
        bf16_t* O = (bf16_t*)J.o0 + (size_t)u.z * J.zso;
#pragma unroll
        for (int ai = 0; ai < 2; ++ai)
#pragma unroll
            for (int m = 0; m < 4; ++m) { bf16_t* rowp = O + (size_t)(row0 + ai * HALF + m * 16) * J.ldc + u.pn * BM + cl;
#pragma unroll
                for (int bj = 0; bj < 2; ++bj) { const f32x4 v0 = acc[ai][bj][m][0], v1 = acc[ai][bj][m][1];
                    u32x4 w; w.x = cvt_pk_bf16(v0[0], v0[1]); w.y = cvt_pk_bf16(v0[2], v0[3]); w.z = cvt_pk_bf16(v1[0], v1[1]); w.w = cvt_pk_bf16(v1[2], v1[3]);
                    *(u32x4*)(rowp + bj * HALF) = w; } }
    } else {
        bf16_t* ACT = (bf16_t*)J.o0;
        const float* ssq = (const float*)J.p2; const int mi = u.pm < 16 ? 0 : (u.pm < 24 ? 1 : 2); const float* bias = (const float*)J.p3 + mi * BIAS_LD + u.pn * BM + cl;
        const f32x4 bg0 = *(const f32x4*)bias, bg1 = *(const f32x4*)(bias + 4), bu0 = *(const f32x4*)(bias + HALF), bu1 = *(const f32x4*)(bias + HALF + 4);
#pragma unroll
        for (int ai = 0; ai < 2; ++ai)
#pragma unroll
            for (int m = 0; m < 4; ++m) { f32x4 v0, v1; const float rs = 1.f / sqrtf(ssq[row0 + ai * HALF + m * 16] * (1.f / D) + EPS);
#pragma unroll
                for (int e = 0; e < 4; ++e) { const float g0 = acc[ai][0][m][0][e] * rs + bg0[e], g1 = acc[ai][0][m][1][e] * rs + bg1[e];
                    v0[e] = g0 * sigmoidf_(g0) * (acc[ai][1][m][0][e] * rs + bu0[e]); v1[e] = g1 * sigmoidf_(g1) * (acc[ai][1][m][1][e] * rs + bu1[e]); }
                u32x4 w; w.x = cvt_pk_bf16(v0[0], v0[1]); w.y = cvt_pk_bf16(v0[2], v0[3]); w.z = cvt_pk_bf16(v1[0], v1[1]); w.w = cvt_pk_bf16(v1[2], v1[3]);
                *(u32x4*)(ACT + (size_t)(row0 + ai * HALF + m * 16) * FF + u.pn * HALF + cl) = w; }
    }
}

__device__ __forceinline__ void gemm_phase(LAS unsigned char* lds, const Job& g, const Order& S, const int tid) {
    const int wid = __builtin_amdgcn_readfirstlane(tid >> 6), lane = tid & 63, wr = wid >> 2, wc = wid & 3, fr = lane & 15, fq = lane >> 4;
    unsigned voffA[2], voffB[2];
#pragma unroll
    for (int i = 0; i < 2; ++i) { int R, C; stage_rc(tid * 16 + i * 8192, R, C); const int Rb = (R & ~31) + perm32(R & 31);
        voffA[i] = (unsigned)(R * g.lda + C) * 2u; voffB[i] = (unsigned)(Rb * g.ldb + C) * 2u; }
    const size_t kstep = (size_t)(BK * 2);
    const size_t hstepA = (size_t)HALF * g.lda * 2, hstepB = (size_t)HALF * g.ldb * 2;
    const size_t tstepA = 2 * hstepA, tstepB = 2 * hstepB;
    const unsigned ldsw = (unsigned)wid * 1024u;
    const int aoff = lds_byte(wr * 64 + fr, fq * 8), boff = lds_byte(wc * 32 + fr, fq * 8);
#define PG8_SA(b, h) (((b) * 2 + (h)) * HTB)
#define PG8_SB(b, h) ((4 + (b) * 2 + (h)) * HTB)
#define PG8_STAGE(bufoff, gbase, voff) do { _Pragma("unroll") for (int _i = 0; _i < 2; ++_i) \
        __builtin_amdgcn_global_load_lds((const unsigned*)((const char*)(gbase) + (voff)[_i]), (LAS unsigned*)(lds + (bufoff) + ldsw + _i * 8192), 16, 0, 0); } while (0)
#define PG8_LDA(dst, b, h) do { _Pragma("unroll") for (int m = 0; m < 4; ++m) _Pragma("unroll") for (int k = 0; k < 2; ++k) dst[m][k] = *(const LAS bf16x8*)(lds + PG8_SA(b, h) + aoff + m * 2048 + k * 1024); } while (0)
#define PG8_LDB(dst, b, h) do { _Pragma("unroll") for (int n = 0; n < 2; ++n) _Pragma("unroll") for (int k = 0; k < 2; ++k) dst[n][k] = *(const LAS bf16x8*)(lds + PG8_SB(b, h) + boff + n * 2048 + k * 1024); } while (0)
#define PG8_MMA(ai, bj, At, Bt) do { __builtin_amdgcn_s_setprio(1); _Pragma("unroll") for (int m = 0; m < 4; ++m) _Pragma("unroll") for (int n = 0; n < 2; ++n) _Pragma("unroll") for (int k = 0; k < 2; ++k) \
        acc[ai][bj][m][n] = __builtin_amdgcn_mfma_f32_16x16x32_bf16(Bt[n][k], At[m][k], acc[ai][bj][m][n], 0, 0, 0); __builtin_amdgcn_s_setprio(0); } while (0)
#define PG8_WAIT_V(n) asm volatile("s_waitcnt vmcnt(" #n ")" ::: "memory")
#define PG8_WAIT_L(n) asm volatile("s_waitcnt lgkmcnt(" #n ")" ::: "memory")
#define PG8_BAR __builtin_amdgcn_s_barrier()
#define PG8_SCHED __builtin_amdgcn_sched_barrier(0)
#define PG8_UA(u) (g.A + (size_t)((u).z & 7) * g.a_lo + (size_t)((u).z >> 3) * g.a_hi + (size_t)(u).pm * tstepA + (u).koff)
#define PG8_UB(u) (g.Bt + (size_t)((u).z & 7) * g.b_lo + (size_t)((u).z >> 3) * g.b_hi + (size_t)(u).pn * tstepB + (u).koff)
    Unit cur, nxt; int ui = 0;
    if (!S.next(0, cur)) return;
    f32x4 acc[2][2][4][2];
#pragma unroll
    for (int a = 0; a < 2; ++a)
#pragma unroll
        for (int b = 0; b < 2; ++b)
#pragma unroll
            for (int m = 0; m < 4; ++m)
#pragma unroll
                for (int n = 0; n < 2; ++n) acc[a][b][m][n] = (f32x4){0.f, 0.f, 0.f, 0.f};
    bf16x8 At[4][2], B0[2][2], B1[2][2];
    const char* cA = PG8_UA(cur); const char* cB = PG8_UB(cur);
    PG8_STAGE(PG8_SB(0, 0), cB, voffB); PG8_STAGE(PG8_SB(0, 1), cB + hstepB, voffB); PG8_STAGE(PG8_SA(0, 0), cA, voffA); PG8_STAGE(PG8_SA(0, 1), cA + hstepA, voffA);
    if (wr == 1) PG8_BAR;
    PG8_WAIT_V(2); PG8_BAR;
    PG8_STAGE(PG8_SB(1, 0), cB + kstep, voffB); PG8_STAGE(PG8_SA(1, 0), cA + kstep, voffA); PG8_STAGE(PG8_SB(1, 1), cB + hstepB + kstep, voffB);
    PG8_WAIT_V(6); PG8_BAR;
    for (;;) {
        const bool has_next = S.next(ui + 1, nxt);
        const char* nA = has_next ? PG8_UA(nxt) : cA; const char* nB = has_next ? PG8_UB(nxt) : cB;
        const int nt = cur.nt;
        for (int t = 0; t < nt; t += 2) {
            const bool last = (t == nt - 2);
            const char* a1 = cA + (size_t)(t + 1) * kstep;
            const char* a2 = last ? nA : cA + (size_t)(t + 2) * kstep; const char* b2 = last ? nB : cB + (size_t)(t + 2) * kstep;
            const char* a3 = a2 + kstep; const char* b3 = b2 + kstep;
            PG8_LDB(B0, 0, 0); PG8_LDB(B1, 0, 1); PG8_SCHED; PG8_LDA(At, 0, 0); PG8_STAGE(PG8_SA(1, 1), a1 + hstepA, voffA);
            PG8_WAIT_V(8); PG8_WAIT_L(0); PG8_BAR; PG8_MMA(0, 0, At, B0); PG8_MMA(0, 1, At, B1); PG8_BAR; PG8_SCHED;
            PG8_LDA(At, 0, 1); PG8_STAGE(PG8_SB(0, 0), b2, voffB); PG8_STAGE(PG8_SB(0, 1), b2 + hstepB, voffB); PG8_STAGE(PG8_SA(0, 0), a2, voffA);
            PG8_WAIT_V(8); PG8_WAIT_L(0); PG8_BAR; PG8_MMA(1, 0, At, B0); PG8_MMA(1, 1, At, B1); PG8_BAR; PG8_SCHED;
            PG8_LDB(B0, 1, 0); PG8_LDB(B1, 1, 1); PG8_SCHED; PG8_LDA(At, 1, 0); PG8_STAGE(PG8_SA(0, 1), a2 + hstepA, voffA);
            PG8_WAIT_V(8); PG8_WAIT_L(0); PG8_BAR; PG8_MMA(0, 0, At, B0); PG8_MMA(0, 1, At, B1); PG8_BAR; PG8_SCHED;
            PG8_LDA(At, 1, 1); PG8_STAGE(PG8_SB(1, 0), b3, voffB); PG8_STAGE(PG8_SB(1, 1), b3 + hstepB, voffB); PG8_STAGE(PG8_SA(1, 0), a3, voffA);
            PG8_WAIT_V(8); PG8_WAIT_L(0); PG8_BAR; PG8_MMA(1, 0, At, B0); PG8_MMA(1, 1, At, B1); PG8_BAR; PG8_SCHED;
        }
        if (wr == 0) PG8_BAR;
        epilogue(g, acc, cur, wr, wc, fr, fq);
        if (!has_next) break;
#pragma unroll
        for (int a = 0; a < 2; ++a)
#pragma unroll
            for (int b = 0; b < 2; ++b)
#pragma unroll
                for (int m = 0; m < 4; ++m)
#pragma unroll
                    for (int n = 0; n < 2; ++n) acc[a][b][m][n] = (f32x4){0.f, 0.f, 0.f, 0.f};
        cur = nxt; cA = nA; cB = nB; ++ui;
        if (wr == 1) PG8_BAR;
    }
    PG8_WAIT_V(0);
    PG8_BAR;
#undef PG8_SA
#undef PG8_SB
#undef PG8_STAGE
#undef PG8_LDA
#undef PG8_LDB
#undef PG8_MMA
#undef PG8_WAIT_V
#undef PG8_WAIT_L
#undef PG8_BAR
#undef PG8_SCHED
#undef PG8_UA
#undef PG8_UB
}

__device__ __forceinline__ void epilogue_hm(const Job& J, f32x4 (&acc)[2][4][2], f32x4 (&macc)[2][4][2], const Unit& u, int wr, int wc, int fr, int fq) {
    const int row0 = u.pm * HALF + wr * 64 + fr; const int cl = wc * 32 + 8 * fq;
    if (J.kind == EK_MERGE) {
        const bf16_t* gates = (const bf16_t*)J.p0 + u.seg * 1024; bf16_t* MB = (bf16_t*)J.o0;
#pragma unroll
        for (int m = 0; m < 4; ++m) { const size_t row = (size_t)(row0 + m * 16);
#pragma unroll
            for (int bj = 0; bj < 2; ++bj) { const int col = u.pn * BM + bj * HALF + cl;
                const u32x4 g = *(const u32x4*)(gates + row * 4096 + col);
                f32x4 v0 = acc[bj][m][0], v1 = acc[bj][m][1];
                v0[0] *= bf_lo(g.x); v0[1] *= bf_hi(g.x); v0[2] *= bf_lo(g.y); v0[3] *= bf_hi(g.y); v1[0] *= bf_lo(g.z); v1[1] *= bf_hi(g.z); v1[2] *= bf_lo(g.w); v1[3] *= bf_hi(g.w);
                if (u.seg > 0) { v0 += macc[bj][m][0]; v1 += macc[bj][m][1]; }
                macc[bj][m][0] = v0; macc[bj][m][1] = v1;
                if (u.seg == 3) { u32x4 w; w.x = cvt_pk_bf16(v0[0], v0[1]); w.y = cvt_pk_bf16(v0[2], v0[3]); w.z = cvt_pk_bf16(v1[0], v1[1]); w.w = cvt_pk_bf16(v1[2], v1[3]); *(u32x4*)(MB + row * 1024 + col) = w; } } }
    } else {
        float* X = (float*)J.o0; const float* XI = (const float*)J.p1; const int mi = u.pm < 32 ? 0 : (u.pm < 48 ? 1 : 2); const float* gv = (const float*)J.p0 + mi * 6144 + J.aux;
        bf16_t* XS = (bf16_t*)J.o1; float* SS = (float*)J.o2; const float* gn = (const float*)J.p2; const float* scn = (const float*)J.p3 + mi * 6144;
        float sm[4] = {0.f, 0.f, 0.f, 0.f};
#pragma unroll
        for (int bj = 0; bj < 2; ++bj) { const int col = u.pn * BM + bj * HALF + cl; const f32x4 g0 = *(const f32x4*)(gv + col), g1 = *(const f32x4*)(gv + col + 4);
            f32x4 s0 = {0.f, 0.f, 0.f, 0.f}, s1 = s0;
            if (XS) { s0 = *(const f32x4*)(gn + col) * (*(const f32x4*)(scn + col) + 1.f); s1 = *(const f32x4*)(gn + col + 4) * (*(const f32x4*)(scn + col + 4) + 1.f); }
#pragma unroll
            for (int m = 0; m < 4; ++m) { const size_t off = (size_t)(row0 + m * 16) * 1024 + col;
                const f32x4 a = *(const f32x4*)(XI + off) + g0 * acc[bj][m][0], b = *(const f32x4*)(XI + off + 4) + g1 * acc[bj][m][1];
                *(f32x4*)(X + off) = a; *(f32x4*)(X + off + 4) = b;
                if (XS) { const f32x4 ya = a * s0, yb = b * s1; *(u32x4*)(XS + off) = (u32x4){cvt_pk_bf16(ya[0], ya[1]), cvt_pk_bf16(ya[2], ya[3]), cvt_pk_bf16(yb[0], yb[1]), cvt_pk_bf16(yb[2], yb[3])};
                    sm[m] += (a[0] * a[0] + a[1] * a[1]) + (a[2] * a[2] + a[3] * a[3]) + (b[0] * b[0] + b[1] * b[1]) + (b[2] * b[2] + b[3] * b[3]); } } }
        if (XS) {
#pragma unroll
            for (int m = 0; m < 4; ++m) { float v = sm[m]; v += __shfl_xor(v, 16); v += __shfl_xor(v, 32); if (fq == 0) unsafeAtomicAdd(SS + row0 + m * 16, v); } }
    }
}

__device__ __forceinline__ void gemm_phase_hm(LAS unsigned char* lds, const Job& g, const Order& S, const int tid) {
    const int wid = __builtin_amdgcn_readfirstlane(tid >> 6), lane = tid & 63, wr = wid >> 2, wc = wid & 3, fr = lane & 15, fq = lane >> 4;
    unsigned voffA[2], voffB[2];
#pragma unroll
    for (int i = 0; i < 2; ++i) { int R, C; stage_rc(tid * 16 + i * 8192, R, C); const int Rb = (R & ~31) + perm32(R & 31);
        voffA[i] = (unsigned)(R * g.lda + C) * 2u; voffB[i] = (unsigned)(Rb * g.ldb + C) * 2u; }
    const size_t kstep = (size_t)(BK * 2);
    const size_t hstepA = (size_t)HALF * g.lda * 2, hstepB = (size_t)HALF * g.ldb * 2, tstepB = 2 * hstepB;
    const unsigned ldsw = (unsigned)wid * 1024u;
    const int aoff = lds_byte(wr * 64 + fr, fq * 8), boff = lds_byte(wc * 32 + fr, fq * 8);
    constexpr int SLOT = 3 * HTB;
#define HM_STAGE(slotoff, gbase, voff) do { _Pragma("unroll") for (int _i = 0; _i < 2; ++_i) \
        __builtin_amdgcn_global_load_lds((const unsigned*)((const char*)(gbase) + (voff)[_i]), (LAS unsigned*)(lds + (slotoff) + ldsw + _i * 8192), 16, 0, 0); } while (0)
#define HM_MMA(bj, Bt) do { __builtin_amdgcn_s_setprio(1); _Pragma("unroll") for (int m = 0; m < 4; ++m) _Pragma("unroll") for (int n = 0; n < 2; ++n) _Pragma("unroll") for (int k = 0; k < 2; ++k) \
        acc[bj][m][n] = __builtin_amdgcn_mfma_f32_16x16x32_bf16(Bt[n][k], At[m][k], acc[bj][m][n], 0, 0, 0); __builtin_amdgcn_s_setprio(0); } while (0)
#define HM_WAIT_V(n) asm volatile("s_waitcnt vmcnt(" #n ")" ::: "memory")
#define HM_WAIT_L(n) asm volatile("s_waitcnt lgkmcnt(" #n ")" ::: "memory")
#define HM_BAR __builtin_amdgcn_s_barrier()
#define HM_SCHED __builtin_amdgcn_sched_barrier(0)
#define HM_UA(u) (g.A + (size_t)(u).pm * hstepA + (u).koff)
#define HM_UB(u) (g.Bt + (size_t)(u).pn * tstepB + (u).koff)
    Unit cur, nxt; int ui = 0;
    if (!S.next(0, cur)) return;
    f32x4 acc[2][4][2], macc[2][4][2];
#pragma unroll
    for (int b = 0; b < 2; ++b)
#pragma unroll
        for (int m = 0; m < 4; ++m)
#pragma unroll
            for (int n = 0; n < 2; ++n) { acc[b][m][n] = (f32x4){0.f, 0.f, 0.f, 0.f}; macc[b][m][n] = (f32x4){0.f, 0.f, 0.f, 0.f}; }
    bf16x8 At[4][2], B0[2][2], B1[2][2];
    const char* cA = HM_UA(cur); const char* cB = HM_UB(cur);
    HM_STAGE(0 * SLOT, cA, voffA); HM_STAGE(0 * SLOT + HTB, cB, voffB); HM_STAGE(0 * SLOT + 2 * HTB, cB + hstepB, voffB);
    HM_STAGE(1 * SLOT, cA + kstep, voffA); HM_STAGE(1 * SLOT + HTB, cB + kstep, voffB); HM_STAGE(1 * SLOT + 2 * HTB, cB + hstepB + kstep, voffB);
    if (wr == 1) HM_BAR;
    HM_WAIT_V(6); HM_BAR; HM_BAR;
    int rd = 0;
    for (;;) {
        const bool has_next = S.next(ui + 1, nxt);
        const char* nA = has_next ? HM_UA(nxt) : cA; const char* nB = has_next ? HM_UB(nxt) : cB;
        const int nt = cur.nt;
        for (int t = 0; t < nt; ++t) {
            const int st = (rd >= SLOT) ? rd - SLOT : rd + 2 * SLOT;
            const int t2 = t + 2;
            const char* a2 = (t2 < nt) ? cA + (size_t)t2 * kstep : nA + (size_t)(t2 - nt) * kstep;
            const char* b2 = (t2 < nt) ? cB + (size_t)t2 * kstep : nB + (size_t)(t2 - nt) * kstep;
            LAS unsigned char* lr = lds + rd;
#pragma unroll
            for (int n = 0; n < 2; ++n)
#pragma unroll
                for (int k = 0; k < 2; ++k) { B0[n][k] = *(const LAS bf16x8*)(lr + HTB + boff + n * 2048 + k * 1024); B1[n][k] = *(const LAS bf16x8*)(lr + 2 * HTB + boff + n * 2048 + k * 1024); }
            HM_SCHED;
#pragma unroll
            for (int m = 0; m < 4; ++m)
#pragma unroll
                for (int k = 0; k < 2; ++k) At[m][k] = *(const LAS bf16x8*)(lr + aoff + m * 2048 + k * 1024);
            HM_STAGE(st, a2, voffA); HM_STAGE(st + HTB, b2, voffB); HM_STAGE(st + 2 * HTB, b2 + hstepB, voffB);
            HM_WAIT_V(6); HM_WAIT_L(0); HM_BAR; HM_MMA(0, B0); HM_MMA(1, B1); HM_BAR; HM_SCHED;
            rd = (rd >= 2 * SLOT) ? 0 : rd + SLOT;
        }
        if (wr == 0) HM_BAR;
        epilogue_hm(g, acc, macc, cur, wr, wc, fr, fq);
        if (!has_next) break;
#pragma unroll
        for (int b = 0; b < 2; ++b)
#pragma unroll
            for (int m = 0; m < 4; ++m)
#pragma unroll
                for (int n = 0; n < 2; ++n) acc[b][m][n] = (f32x4){0.f, 0.f, 0.f, 0.f};
        cur = nxt; cA = nA; cB = nB; ++ui;
        if (wr == 1) HM_BAR;
    }
    HM_WAIT_V(0);
    HM_BAR;
#undef HM_STAGE
#undef HM_MMA
#undef HM_WAIT_V
#undef HM_WAIT_L
#undef HM_BAR
#undef HM_SCHED
#undef HM_UA
#undef HM_UB
}
}

namespace attn {
constexpr int KSLOT = 12288, VSLOT = 8192, BUFB = 2 * KSLOT + 2 * VSLOT;
constexpr int LDS_WS = 2 * BUFB;
constexpr int LDS_CM = LDS_WS + 2048;
constexpr int LDS_CL = LDS_CM + 1024;
constexpr int LDS_OST = LDS_CL + 512;
constexpr int LDS_END = LDS_OST + 8 * 4096;
static_assert(LDS_END <= RING_BYTES, "attention LDS");
__device__ __forceinline__ int crow(int r, int hi) { return (r & 3) + 8 * (r >> 2) + 4 * hi; }
__device__ __forceinline__ void glds16(const void* gsrc, unsigned lds_dst) { unsigned keep;
    asm volatile("s_mov_b32 %0, m0\n\ts_mov_b32 m0, %2\n\ts_nop 0\n\tglobal_load_lds_dwordx4 %1, off\n\ts_mov_b32 m0, %0" : "=&s"(keep) : "v"(gsrc), "s"(lds_dst) : "memory"); }
typedef __bf16 bf16x2_t __attribute__((ext_vector_type(2)));
__device__ __forceinline__ unsigned cvtpk_s(float lo, float hi) { f32x2 v = {lo, hi}; bf16x2_t b = __builtin_convertvector(v, bf16x2_t); return __builtin_bit_cast(unsigned, b); }
typedef LAS const char* lds_cptr;
typedef short v4i16_t __attribute__((ext_vector_type(4)));
__device__ __forceinline__ s16x4 vtr(lds_cptr p) { return __builtin_bit_cast(s16x4, __builtin_amdgcn_ds_read_tr16_b64_v4i16((LAS v4i16_t*)p)); }
__device__ __forceinline__ float swapmax(float m) { auto rr = __builtin_amdgcn_permlane32_swap(__float_as_uint(m), __float_as_uint(m), false, false); return fmaxf(__uint_as_float(rr[0]), __uint_as_float(rr[1])); }
__device__ __forceinline__ float swapsum(float m) { auto rr = __builtin_amdgcn_permlane32_swap(__float_as_uint(m), __float_as_uint(m), false, false); return __uint_as_float(rr[0]) + __uint_as_float(rr[1]); }

struct Tensors { const bf16_t* Q; const bf16_t* KV; const bf16_t* KR; bf16_t* O; };

__device__ __forceinline__ void dma_step(const Tensors& T, int krow0, int h, unsigned ldsbuf, int wid, int lane) {
#pragma unroll
    for (int i = 0; i < 5; ++i) {
        const int p = wid + 8 * i;
        const void* src; unsigned dst;
        if (p < 24) { const int j = p / 12, c = p % 12; const int row = krow0 + j * 64 + lane;
            src = (c < 8) ? (const void*)(T.KV + (size_t)row * 1024 + h * 128 + c * 8) : (const void*)(T.KR + (size_t)row * 32 + (c - 8) * 8);
            dst = ldsbuf + j * KSLOT + c * 1024; }
        else { const int pv = p - 24, j = pv >> 3, q = pv & 7; const int row = krow0 + j * 64 + 16 * (q & 3) + (lane >> 2);
            src = (const void*)(T.KV + (size_t)row * 1024 + h * 128 + 64 + (q >> 2) * 32 + (lane & 3) * 8);
            dst = ldsbuf + 2 * KSLOT + j * VSLOT + q * 1024; }
        glds16(src, (unsigned)__builtin_amdgcn_readfirstlane(dst));
    }
}

__device__ __forceinline__ void unit(const Tensors& T, int qrow0, int krow0, int nsteps, int h, char* shm, const int tid) {
    const int lane = tid & 63, r32 = lane & 31, hi = lane >> 5; const int wid = __builtin_amdgcn_readfirstlane(tid >> 6);
    const int qb = wid & 3, kh = wid >> 2;
    const unsigned lds0 = (unsigned)(uintptr_t)shm;
    float* wsf = (float*)(shm + LDS_WS) + wid * 64;
    dma_step(T, krow0, h, lds0, wid, lane);
    const bf16_t* Qw = T.Q + (size_t)(qrow0 + qb * 32 + r32) * 768 + h * 96 + hi * 8;
    bf16x8 qr[6];
#pragma unroll
    for (int d0 = 0; d0 < 6; ++d0) qr[d0] = *(const bf16x8*)(Qw + d0 * 16);
    float mhat = 0.f, l_reg = 0.f; f32x16 o[2]; o[0] = f32x16{}; o[1] = f32x16{}; f32x16 negm = f32x16{};
    const lds_cptr shm3 = (lds_cptr)shm;
    for (int s = 0; s < nsteps; ++s) {
        asm volatile("s_waitcnt vmcnt(0)" ::: "memory"); __builtin_amdgcn_s_barrier(); asm volatile("" ::: "memory");
        if (s + 1 < nsteps) dma_step(T, krow0 + (s + 1) * 128, h, lds0 + ((s + 1) & 1) * BUFB, wid, lane);
        const int bufo = (s & 1) * BUFB;
        const lds_cptr kp = shm3 + bufo + kh * KSLOT + hi * 1024 + r32 * 16;
        const lds_cptr vp = shm3 + bufo + 2 * KSLOT + kh * VSLOT + ((lane >> 4) & 1) * 32 + (lane & 3) * 8 + (4 * hi + ((lane & 15) >> 2)) * 64;
        f32x16 p0, p1;
#pragma unroll
        for (int d0 = 0; d0 < 6; ++d0) {
            const bf16x8 b0 = *(const LAS bf16x8*)(kp + d0 * 2048), b1 = *(const LAS bf16x8*)(kp + d0 * 2048 + 512);
            if (d0 == 0) { p0 = __builtin_amdgcn_mfma_f32_32x32x16_bf16(b0, qr[0], negm, 0, 0, 0); p1 = __builtin_amdgcn_mfma_f32_32x32x16_bf16(b1, qr[0], negm, 0, 0, 0); }
            else { p0 = __builtin_amdgcn_mfma_f32_32x32x16_bf16(b0, qr[d0], p0, 0, 0, 0); p1 = __builtin_amdgcn_mfma_f32_32x32x16_bf16(b1, qr[d0], p1, 0, 0, 0); } }
        float rm = fmaxf(p0[0], p1[0]);
#pragma unroll
        for (int r = 1; r < 16; ++r) rm = fmaxf(rm, fmaxf(p0[r], p1[r]));
        rm = swapmax(rm);
        bool resc = false;
        if (s == 0 || __any(rm > 8.0f)) {
            const float dl = (s == 0) ? rm : fmaxf(rm, 0.f); mhat += dl;
#pragma unroll
            for (int r = 0; r < 16; ++r) { p0[r] -= dl; p1[r] -= dl; negm[r] = -mhat; }
            if (s != 0) { const float f = __builtin_amdgcn_exp2f(-dl); l_reg *= f; if (hi == 0) wsf[r32] = f; resc = true; }
        }
        float sacc = 0.f;
#pragma unroll
        for (int r = 0; r < 16; ++r) { p0[r] = __builtin_amdgcn_exp2f(p0[r]); p1[r] = __builtin_amdgcn_exp2f(p1[r]); sacc += p0[r] + p1[r]; }
        l_reg += sacc;
        if (resc) { asm volatile("s_waitcnt lgkmcnt(0)" ::: "memory");
#pragma unroll
            for (int d_ = 0; d_ < 2; ++d_)
#pragma unroll
                for (int r = 0; r < 16; ++r) o[d_][r] *= wsf[crow(r, hi)]; }
        u32x4 pw[4];
        pw[0] = (u32x4){cvtpk_s(p0[0], p0[1]), cvtpk_s(p0[2], p0[3]), cvtpk_s(p0[4], p0[5]), cvtpk_s(p0[6], p0[7])};
        pw[1] = (u32x4){cvtpk_s(p0[8], p0[9]), cvtpk_s(p0[10], p0[11]), cvtpk_s(p0[12], p0[13]), cvtpk_s(p0[14], p0[15])};
        pw[2] = (u32x4){cvtpk_s(p1[0], p1[1]), cvtpk_s(p1[2], p1[3]), cvtpk_s(p1[4], p1[5]), cvtpk_s(p1[6], p1[7])};
        pw[3] = (u32x4){cvtpk_s(p1[8], p1[9]), cvtpk_s(p1[10], p1[11]), cvtpk_s(p1[12], p1[13]), cvtpk_s(p1[14], p1[15])};
#pragma unroll
        for (int d0 = 0; d0 < 2; ++d0)
#pragma unroll
            for (int ks = 0; ks < 4; ++ks) {
                const s16x4 lo = vtr(vp + d0 * 4096 + ks * 1024), hh = vtr(vp + d0 * 4096 + ks * 1024 + 512);
                const bf16x8 vf = (bf16x8){lo[0], lo[1], lo[2], lo[3], hh[0], hh[1], hh[2], hh[3]};
                o[d0] = __builtin_amdgcn_mfma_f32_32x32x16_bf16(__builtin_bit_cast(bf16x8, pw[ks]), vf, o[d0], 0, 0, 0); }
    }
    l_reg = swapsum(l_reg);
    float* cm = (float*)(shm + LDS_CM); float* cl = (float*)(shm + LDS_CL);
    if (hi == 0) cm[(kh * 4 + qb) * 32 + r32] = mhat;
    asm volatile("s_waitcnt lgkmcnt(0)" ::: "memory"); __builtin_amdgcn_s_barrier(); asm volatile("" ::: "memory");
    { const float mo = cm[((kh ^ 1) * 4 + qb) * 32 + r32]; const float ms = fmaxf(mhat, mo); const float f = __builtin_amdgcn_exp2f(mhat - ms); l_reg *= f;
      if (hi == 0) wsf[r32] = f; asm volatile("s_waitcnt lgkmcnt(0)" ::: "memory");
#pragma unroll
      for (int d_ = 0; d_ < 2; ++d_)
#pragma unroll
          for (int r = 0; r < 16; ++r) o[d_][r] *= wsf[crow(r, hi)]; }
    float* co = (float*)shm + qb * 2048;
    if (kh == 1) {
#pragma unroll
        for (int d_ = 0; d_ < 2; ++d_)
#pragma unroll
            for (int r = 0; r < 16; ++r) co[(d_ * 16 + r) * 64 + lane] = o[d_][r];
        if (hi == 0) cl[qb * 32 + r32] = l_reg;
    }
    asm volatile("s_waitcnt lgkmcnt(0)" ::: "memory"); __builtin_amdgcn_s_barrier(); asm volatile("" ::: "memory");
    if (kh == 0) {
#pragma unroll
        for (int d_ = 0; d_ < 2; ++d_)
#pragma unroll
            for (int r = 0; r < 16; ++r) o[d_][r] += co[(d_ * 16 + r) * 64 + lane];
        l_reg += cl[qb * 32 + r32];
        if (hi == 0) wsf[32 + r32] = l_reg; asm volatile("s_waitcnt lgkmcnt(0)" ::: "memory");
        float rli[16];
#pragma unroll
        for (int r = 0; r < 16; ++r) rli[r] = __builtin_amdgcn_rcpf(wsf[32 + crow(r, hi)]);
        bf16_t* stg = (bf16_t*)(shm + LDS_OST) + wid * 2048;
#pragma unroll
        for (int r = 0; r < 16; ++r) { const int orow = crow(r, hi);
#pragma unroll
            for (int d0 = 0; d0 < 2; ++d0) stg[orow * 64 + d0 * 32 + r32] = f2bf(o[d0][r] * rli[r]); }
        asm volatile("s_waitcnt lgkmcnt(0)" ::: "memory");
        bf16_t* Ow = T.O + (size_t)(qrow0 + qb * 32) * ACAT_LD + h * 64;
#pragma unroll
        for (int i = 0; i < 4; ++i) { const int row = i * 8 + (lane >> 3), ch = lane & 7; const u32x4 v = *(const u32x4*)(stg + row * 64 + ch * 8); *(u32x4*)(Ow + (size_t)row * ACAT_LD + ch * 8) = v; }
    }
    asm volatile("s_waitcnt lgkmcnt(0)" ::: "memory"); __builtin_amdgcn_s_barrier(); asm volatile("" ::: "memory");
}
}

#define XB_TMO      128
#define XB_XCNT(j)  (256  + 64 * (j))
#define XB_XSUB(j)  (1280 + 64 * (j))
#define XB_XGEN(j)  (2304 + 64 * (j))
#define XB_TOP      3328
#define XB_TOPGEN   3392
#define XCD_BAR_WORDS 3456
#define XB_SPIN_CAP (1u << 18)
__device__ __forceinline__ unsigned xb_ld(unsigned* p)              { return __hip_atomic_load(p, __ATOMIC_RELAXED, __HIP_MEMORY_SCOPE_AGENT); }
__device__ __forceinline__ unsigned xb_add(unsigned* p, unsigned v) { return __hip_atomic_fetch_add(p, v, __ATOMIC_RELAXED, __HIP_MEMORY_SCOPE_AGENT); }
__device__ __forceinline__ unsigned xb_xcc_id() { return (unsigned)__builtin_amdgcn_s_getreg((3 << 11) | 20) & 0xFu; }
#define XB_SPIN(cond, bar) do { unsigned _sp = 0; while (cond) { __builtin_amdgcn_s_sleep(1); \
    if ((++_sp & 255u) == 0u) { if (xb_ld(&(bar)[XB_TMO])) break; if (_sp > XB_SPIN_CAP) { atomicAdd(&(bar)[XB_TMO], 1u); break; } } } } while (0)
struct XcdBarrier { unsigned* bar; unsigned x; volatile LAS unsigned* st; };
__device__ __forceinline__ XcdBarrier xcd_barrier_post(unsigned* bar, volatile LAS unsigned* st) {
    XcdBarrier b; b.bar = bar; b.x = xb_xcc_id(); b.st = st;
    if (threadIdx.x == 0) (void)xb_add(&bar[XB_XCNT(b.x)], 1u);
    return b;
}
__device__ __forceinline__ void xcd_barrier_complete(unsigned* bar, unsigned x, unsigned& nloc, unsigned& nx) {
    const unsigned G = gridDim.x * gridDim.y * gridDim.z;
    unsigned sum, cnt, mine, sp = 0u;
    for (;;) {
        sum = 0u; cnt = 0u; mine = 0u;
#pragma unroll
        for (unsigned j = 0; j < 16; ++j) { const unsigned c = xb_ld(&bar[XB_XCNT(j)]); sum += c; cnt += (c > 0u) ? 1u : 0u; mine = (j == x) ? c : mine; }
        if (sum == G) break;
        __builtin_amdgcn_s_sleep(1);
        if ((++sp & 255u) == 0u) { if (xb_ld(&bar[XB_TMO])) break; if (sp > XB_SPIN_CAP) { atomicAdd(&bar[XB_TMO], 1u); break; } }
    }
    nloc = mine > 0u ? mine : 1u; nx = cnt > 0u ? cnt : 1u;
}
__device__ __forceinline__ void xcd_barrier(const XcdBarrier& b, const int tid) {
    asm volatile("s_waitcnt vmcnt(0)" ::: "memory");
    __syncthreads();
    if (tid == 0) {
        unsigned* bar = b.bar;
        __builtin_amdgcn_s_waitcnt(0);
        unsigned nloc = b.st[0], nx = b.st[1];
        if (nloc == 0u) { xcd_barrier_complete(bar, b.x, nloc, nx); b.st[0] = nloc; b.st[1] = nx; }
        const unsigned old = xb_add(&bar[XB_XSUB(b.x)], 1u);
        const unsigned gen = old / nloc;
        if (old + 1u == (gen + 1u) * nloc) {
            __builtin_amdgcn_fence(__ATOMIC_RELEASE, "agent");
            asm volatile("s_waitcnt vmcnt(0)" ::: "memory");
            const unsigned og = xb_add(&bar[XB_TOP], 1u);
            const unsigned tg = og / nx;
            if (og + 1u == (tg + 1u) * nx) xb_add(&bar[XB_TOPGEN], 1u);
            else XB_SPIN(xb_ld(&bar[XB_TOPGEN]) == tg, bar);
            __builtin_amdgcn_fence(__ATOMIC_ACQUIRE, "agent");
            xb_add(&bar[XB_XGEN(b.x)], 1u);
            asm volatile("s_waitcnt vmcnt(0)" ::: "memory");
        } else {
            XB_SPIN(xb_ld(&bar[XB_XGEN(b.x)]) == gen, bar);
            __builtin_amdgcn_fence(__ATOMIC_ACQUIRE, "agent");
            asm volatile("s_waitcnt vmcnt(0)" ::: "memory");
        }
    }
    __syncthreads();
}

struct Args { const float* in[29]; float* out; unsigned char* ws; int step_lo, step_hi; };
static_assert(sizeof(Args) == 31 * 8 + 8, "Args has no padding");

struct Ctx {
    LAS unsigned char* lds; int tid, lane, wave, G, gw, NGW, bid;
    float* out; unsigned char* ws;
};
__device__ __forceinline__ const float* ldarg(int i) { const char* kp = (const char*)__builtin_amdgcn_kernarg_segment_ptr(); asm volatile("" : "+s"(kp)); return *(const float* const*)(kp + 8 * i); }
#define INP(i) ldarg(i)

__device__ __forceinline__ void transpose_item(const float* W, int N, bf16_t* WT, int ldt, int k0, int n0, int drow0, LAS float* scr, int lane) {
    float v[32];
    const float* wp = W + (size_t)(k0 + (lane >> 5)) * N + n0 + (lane & 31);
#pragma unroll
    for (int i = 0; i < 32; ++i) v[i] = wp[(size_t)(2 * i) * N];
#pragma unroll
    for (int i = 0; i < 32; ++i) scr[(2 * i + (lane >> 5)) * 33 + (lane & 31)] = v[i];
    LDS_WAIT(); asm volatile("" ::: "memory");
    const int c = lane & 7;
#pragma unroll
    for (int j = 0; j < 4; ++j) { const int n = (lane >> 3) + 8 * j; const LAS float* s = scr + (8 * c) * 33 + n;
        u32x4 o; o.x = cvt_pk_bf16(s[0 * 33], s[1 * 33]); o.y = cvt_pk_bf16(s[2 * 33], s[3 * 33]); o.z = cvt_pk_bf16(s[4 * 33], s[5 * 33]); o.w = cvt_pk_bf16(s[6 * 33], s[7 * 33]);
        *(u32x4*)(WT + (size_t)(drow0 + n) * ldt + k0 + 8 * c) = o; }
    LDS_WAIT(); asm volatile("" ::: "memory");
}

__device__ __forceinline__ void prologue(Ctx& F) {
    unsigned char* ws = F.ws;
    LAS float* misc = (LAS float*)(F.lds + MISC_OFF + 1024);
    __syncthreads();
    if (F.tid < 64) { misc[F.tid] = __builtin_amdgcn_cosf((float)F.tid * (1.f / 64.f)); misc[64 + F.tid] = __builtin_amdgcn_sinf((float)F.tid * (1.f / 64.f)); }
    if (F.bid < 192) {
        LAS float* scv = (LAS float*)F.lds;
        LAS float* red = (LAS float*)(F.lds + 16384);
        for (int i = F.tid; i < 3072; i += 512) { const int m = i >> 10, k = i & 1023; const float v = (m == 0) ? INP(5)[k] : INP(4)[(m - 1) * 1024 + k]; scv[i] = v * sigmoidf_(v); }
        __syncthreads();
        const int l = F.bid / 96, c0 = (F.bid % 96) * 64;
        const float* w = INP(6) + (size_t)l * 1024 * 6144 + c0 + F.lane;
        float a0 = 0.f, a1 = 0.f, a2 = 0.f;
        const int kb = F.wave * 128;
#pragma unroll 16
        for (int k = 0; k < 128; ++k) { const float wv = w[(size_t)(kb + k) * 6144]; a0 += scv[kb + k] * wv; a1 += scv[1024 + kb + k] * wv; a2 += scv[2048 + kb + k] * wv; }
        red[(F.wave * 3 + 0) * 64 + F.lane] = a0; red[(F.wave * 3 + 1) * 64 + F.lane] = a1; red[(F.wave * 3 + 2) * 64 + F.lane] = a2;
        __syncthreads();
        if (F.wave < 3) { float s = INP(7)[l * 6144 + c0 + F.lane];
#pragma unroll
            for (int w8 = 0; w8 < 8; ++w8) s += red[(w8 * 3 + F.wave) * 64 + F.lane];
            ((float*)(ws + WS_MOD))[(l * 3 + F.wave) * 6144 + c0 + F.lane] = s; }
        __syncthreads();
    } else __syncthreads();
    LAS float* scr = (LAS float*)(F.lds + F.wave * 16384);
    for (int l = 0; l < DEPTH; ++l) {
        unsigned char* wl = ws + WS_W + (size_t)l * W_LAYER;
        {
            const float* W = INP(10) + (size_t)l * 1024 * IN_COLS; bf16_t* WT = (bf16_t*)(wl + W_IN); constexpr int nblk = IN_COLS / 32;
            for (int it = F.gw; it < 16 * nblk; it += F.NGW) { const int kb = it / nblk, nb = it % nblk, n0 = nb * 32;
                if (n0 >= OFF_FN && n0 < OFF_GATE) continue;
                const int dr = (n0 < OFF_FN) ? n0 : 2560 + (n0 - OFF_GATE);
                transpose_item(W, IN_COLS, WT, 1024, kb * 64, n0, dr, scr, F.lane); }
            for (int it = F.gw; it < 96 * 2; it += F.NGW) { const int r = 2464 + it / 2, h = it & 1; *(u32x4*)(WT + (size_t)r * 1024 + h * 512 + F.lane * 8) = (u32x4){0u, 0u, 0u, 0u}; }
        }
#define TR_SIMPLE(idx, KK, NN, OFF) { const float* W = INP(idx) + (size_t)l * (KK) * (NN); bf16_t* WT = (bf16_t*)(wl + (OFF)); constexpr int nblk = (NN) / 32; \
            for (int it = F.gw; it < ((KK) / 64) * nblk; it += F.NGW) { const int kb = it / nblk, nb = it % nblk; transpose_item(W, (NN), WT, (KK), kb * 64, nb * 32, nb * 32, scr, F.lane); } }
        TR_SIMPLE(12, 384, 768, W_QB)
        TR_SIMPLE(14, 256, 1024, W_KVB)
#define TR_CAT(idx, KK, KOFF) { const float* W = INP(idx) + (size_t)l * (KK) * 1024; bf16_t* WT = (bf16_t*)(wl + W_CAT) + (KOFF); \
            for (int it = F.gw; it < ((KK) / 64) * 32; it += F.NGW) { const int kb = it / 32, nb = it % 32; transpose_item(W, 1024, WT, 1280, kb * 64, nb * 32, nb * 32, scr, F.lane); } }
        TR_CAT(15, 512, 0)
        TR_CAT(20, 256, 512)
        TR_CAT(22, 256, 768)
        TR_CAT(23, 256, 1024)
#undef TR_CAT
        TR_SIMPLE(24, 1024, 1024, W_OUT)
        TR_SIMPLE(27, 2816, 1024, W_DN)
#undef TR_SIMPLE
        for (int gu = 0; gu < 2; ++gu) {
            const float* W = (gu ? INP(26) : INP(25)) + (size_t)l * 1024 * FF; bf16_t* WT = (bf16_t*)(wl + W_GU); constexpr int nblk = FF / 32;
            for (int it = F.gw; it < 16 * nblk; it += F.NGW) { const int kb = it / nblk, nb = it % nblk, n0 = nb * 32;
                transpose_item(W, FF, WT, 1024, kb * 64, n0, (n0 / 128) * 256 + gu * 128 + (n0 % 128), scr, F.lane); }
        }
        {
            const float* W = INP(10) + (size_t)l * 1024 * IN_COLS; bf16_t* WT = (bf16_t*)(wl + W_IN);
            for (int it = F.gw; it < 128; it += F.NGW) { const int kc = it >> 2, g = it & 3, k0 = kc * 32;
#pragma unroll 8
                for (int i = 0; i < 32; ++i) scr[i * 64 + F.lane] = W[(size_t)(k0 + i) * IN_COLS + OFF_FN + g * 64 + F.lane];
                LDS_WAIT(); asm volatile("" ::: "memory");
                float aP[32], aQ[32];
#pragma unroll
                for (int k = 0; k < 32; ++k) { aP[k] = 0.f; aQ[k] = 0.f; }
                for (int n4 = 0; n4 < 16; ++n4) { float c[4], sn[4];
#pragma unroll
                    for (int e = 0; e < 4; ++e) { const int ix = (F.lane * (4 * n4 + e)) & 63; c[e] = misc[ix]; sn[e] = misc[64 + ix]; }
#pragma unroll
                    for (int k = 0; k < 32; ++k) { const f32x4 w = *(const LAS f32x4*)(scr + k * 64 + 4 * n4);
                        aP[k] += w.x * c[0] + w.y * c[1] + w.z * c[2] + w.w * c[3]; aQ[k] += w.x * sn[0] + w.y * sn[1] + w.z * sn[2] + w.w * sn[3]; } }
                bf16_t* rp = WT + (size_t)(OFF_FN + g * 64 + F.lane) * 1024 + k0; bf16_t* rq = WT + (size_t)(OFF_GATE + g * 64 + F.lane) * 1024 + k0;
#pragma unroll
                for (int j = 0; j < 4; ++j) {
                    *(u32x4*)(rp + 8 * j) = (u32x4){cvt_pk_bf16(aP[8 * j] * 0.125f, aP[8 * j + 1] * 0.125f), cvt_pk_bf16(aP[8 * j + 2] * 0.125f, aP[8 * j + 3] * 0.125f), cvt_pk_bf16(aP[8 * j + 4] * 0.125f, aP[8 * j + 5] * 0.125f), cvt_pk_bf16(aP[8 * j + 6] * 0.125f, aP[8 * j + 7] * 0.125f)};
                    *(u32x4*)(rq + 8 * j) = (u32x4){cvt_pk_bf16(aQ[8 * j] * 0.125f, aQ[8 * j + 1] * 0.125f), cvt_pk_bf16(aQ[8 * j + 2] * 0.125f, aQ[8 * j + 3] * 0.125f), cvt_pk_bf16(aQ[8 * j + 4] * 0.125f, aQ[8 * j + 5] * 0.125f), cvt_pk_bf16(aQ[8 * j + 6] * 0.125f, aQ[8 * j + 7] * 0.125f)}; }
                LDS_WAIT(); asm volatile("" ::: "memory");
            }
        }
    }
    {
        bf16_t* TL = (bf16_t*)(ws + WS_DFTL); const int gt = F.gw * 64 + F.lane, NT = F.NGW * 64;
        for (int it = gt; it < 2048 * 512; it += NT) { const int k = it >> 9, c8 = (it & 511) * 8; float v[8];
#pragma unroll
            for (int e = 0; e < 8; ++e) { const int c = c8 + e, t = c & 2047; const float fr = (float)((k * t) & 2047) * (1.f / 2048.f);
                v[e] = ((c < 2048) ? __builtin_amdgcn_cosf(fr) : -__builtin_amdgcn_sinf(fr)) * 0.022097086912079608f; }
            *(u32x4*)(TL + (size_t)k * 4096 + c8) = (u32x4){cvt_pk_bf16(v[0], v[1]), cvt_pk_bf16(v[2], v[3]), cvt_pk_bf16(v[4], v[5]), cvt_pk_bf16(v[6], v[7])}; }
        bf16_t* TC = (bf16_t*)(ws + WS_DFTC);
        for (int it = gt; it < 256 * 64; it += NT) { const int k = it >> 6, c8 = (it & 63) * 8; float v[8];
#pragma unroll
            for (int e = 0; e < 8; ++e) { const int c = c8 + e, t = c & 255; const float fr = (float)((k * t) & 255) * (1.f / 256.f);
                v[e] = ((c < 256) ? __builtin_amdgcn_cosf(fr) : -__builtin_amdgcn_sinf(fr)) * 0.0625f; }
            *(u32x4*)(TC + (size_t)k * 512 + c8) = (u32x4){cvt_pk_bf16(v[0], v[1]), cvt_pk_bf16(v[2], v[3]), cvt_pk_bf16(v[4], v[5]), cvt_pk_bf16(v[6], v[7])}; }
        if (F.gw == F.NGW - 1) { float* R = (float*)(ws + WS_ROPE);
            for (int i = F.lane; i < 512; i += 64) { const int pos = i >> 3, f = i & 7; const float inv = __builtin_amdgcn_exp2f(-(float)f * 1.6609640474436813f);
                const float rev = ((float)pos * inv) * 0.15915494309189535f; R[2 * i] = __builtin_amdgcn_cosf(rev); R[2 * i + 1] = __builtin_amdgcn_sinf(rev); } }
    }
}

__device__ __forceinline__ int mod_of_row(int r) { return r < NCTX ? 0 : 1 + ((r - NCTX) >> 11); }
__device__ __forceinline__ int kvrow_of_row(int r) { return r < NCTX ? r : NCTX + ((r - NCTX) >> 11) * 2304 + 256 + ((r - NCTX) & 2047); }

__device__ __forceinline__ void phase_pre(Ctx& F) {
    unsigned char* ws = F.ws; const int lane = F.lane;
    {
        const float* mod = (const float*)(ws + WS_MOD); const float* g = INP(8); bf16_t* XN = (bf16_t*)(ws + WS_XN); float* SS = (float*)(ws + WS_SUMSQ); const float* x0 = INP(0); const float* x1 = INP(1);
        for (int r = F.gw; r < MROWS; r += F.NGW) { const float* sc = mod + mod_of_row(r) * 6144 + 1024;
            const f32x4* xr = (const f32x4*)(r < NCTX ? x0 + (size_t)r * D : x1 + (size_t)(r - NCTX) * D) + lane; f32x4 v[4]; float sq = 0.f;
#pragma unroll
            for (int j = 0; j < 4; ++j) { v[j] = xr[64 * j]; sq += (v[j].x * v[j].x + v[j].y * v[j].y) + (v[j].z * v[j].z + v[j].w * v[j].w); ((f32x4*)(F.out + (size_t)r * D) + lane)[64 * j] = v[j]; }
            sq = wave_sum(sq); if (lane == 0) SS[r] = sq;
#pragma unroll
            for (int j = 0; j < 4; ++j) { const int c = 4 * (64 * j + lane); const f32x4 y = v[j] * *(const f32x4*)(g + c) * (*(const f32x4*)(sc + c) + 1.f);
                *(u32x2*)(XN + (size_t)r * D + c) = (u32x2){cvt_pk_bf16(y.x, y.y), cvt_pk_bf16(y.z, y.w)}; } }
    }
    {
        float* B = (float*)(ws + WS_BIAS); const float* mod = (const float*)(ws + WS_MOD);
        for (int it = F.gw; it < 2 * (WIN_N + 5632); it += F.NGW) { const int l = it / (WIN_N + 5632), r = it % (WIN_N + 5632); const int which = r >= WIN_N, n = which ? r - WIN_N : r;
            const bf16_t* wrow = (const bf16_t*)(ws + WS_W + (size_t)l * W_LAYER + (which ? W_GU : W_IN)) + (size_t)n * 1024 + 16 * lane;
            const u32x4 w0 = *(const u32x4*)wrow, w1 = *(const u32x4*)(wrow + 8);
            const float wf[16] = {bf_lo(w0.x), bf_hi(w0.x), bf_lo(w0.y), bf_hi(w0.y), bf_lo(w0.z), bf_hi(w0.z), bf_lo(w0.w), bf_hi(w0.w), bf_lo(w1.x), bf_hi(w1.x), bf_lo(w1.y), bf_hi(w1.y), bf_lo(w1.z), bf_hi(w1.z), bf_lo(w1.w), bf_hi(w1.w)};
            float a3[3];
#pragma unroll
            for (int m = 0; m < 3; ++m) { const float* sh = mod + (l * 3 + m) * 6144 + (which ? 3072 : 0) + 16 * lane; float a = 0.f;
#pragma unroll
                for (int q = 0; q < 4; ++q) { const f32x4 sv = *(const f32x4*)(sh + 4 * q); a += sv.x * wf[4 * q] + sv.y * wf[4 * q + 1] + sv.z * wf[4 * q + 2] + sv.w * wf[4 * q + 3]; }
                a3[m] = wave_sum(a); }
            if (lane < 3) B[((l * 2 + which) * 3 + lane) * BIAS_LD + n] = (lane == 0) ? a3[0] : (lane == 1) ? a3[1] : a3[2]; }
    }
}

__device__ __forceinline__ void phase_prep(Ctx& F, int l) {
    unsigned char* ws = F.ws; const int lane = F.lane;
    const bf16_t* PROJ = (const bf16_t*)(ws + WS_PROJ);
    bf16_t* QN = (bf16_t*)(ws + WS_XN + XN_QN); bf16_t* CKV = (bf16_t*)(ws + WS_XN + XN_CKV); bf16_t* KR = (bf16_t*)(ws + WS_XN + XN_KR);
    bf16_t* ACAT = (bf16_t*)(ws + WS_ACAT);
    float* out_ckv = F.out + (size_t)MROWS * D; float* out_kr = out_ckv + (size_t)NBC * DEPTH * SEQ * KVL;
    const float* rope = (const float*)(ws + WS_ROPE);
    {
        LAS float* ut = (LAS float*)F.lds;
        LAS float* wl = (LAS float*)(F.lds + 65536);
        const float* wdw = INP(16) + l * 31 * 256; const float* bdw = INP(17) + l * 256; const float* gln = INP(18) + l * 256; const float* bln = INP(19) + l * 256;
        __syncthreads();
        for (int i = F.tid; i < 31 * 256; i += 512) wl[i] = wdw[i];
        for (int item = F.bid; item < 256; item += F.G) {
            const int r0 = item * 32; const int s0 = r0 < NCTX ? (r0 & ~255) : NCTX + ((r0 - NCTX) & ~2047); const int s1 = s0 + (r0 < NCTX ? 256 : 2048);
            __syncthreads();
            for (int idx = F.tid; idx < 62 * 128; idx += 512) { const int rr = idx >> 7, cp = idx & 127; const int row = r0 - 15 + rr; float u0 = 0.f, u1 = 0.f;
                if (row >= s0 && row < s1) { const unsigned a = *(const unsigned*)(PROJ + (size_t)row * PROJ_LD + OFF_CONF + 2 * cp), b = *(const unsigned*)(PROJ + (size_t)row * PROJ_LD + OFF_CONF + 256 + 2 * cp);
                    u0 = bf_lo(a) * sigmoidf_(bf_lo(b)); u1 = bf_hi(a) * sigmoidf_(bf_hi(b)); }
                ut[rr * 256 + 2 * cp] = u0; ut[rr * 256 + 2 * cp + 1] = u1; }
            __syncthreads();
            float acc[4][4];
#pragma unroll
            for (int q = 0; q < 4; ++q) { const float b = bdw[lane + 64 * q];
#pragma unroll
                for (int ri = 0; ri < 4; ++ri) acc[ri][q] = b; }
            for (int j = 0; j < 31; ++j) {
#pragma unroll
                for (int q = 0; q < 4; ++q) { const float w = wl[j * 256 + lane + 64 * q];
#pragma unroll
                    for (int ri = 0; ri < 4; ++ri) acc[ri][q] += ut[(4 * F.wave + ri + j) * 256 + lane + 64 * q] * w; } }
#pragma unroll
            for (int ri = 0; ri < 4; ++ri) { const float mean = wave_sum(acc[ri][0] + acc[ri][1] + acc[ri][2] + acc[ri][3]) * (1.f / 256.f); float q2 = 0.f;
#pragma unroll
                for (int q = 0; q < 4; ++q) { const float d = acc[ri][q] - mean; q2 += d * d; }
                const float rstd = 1.f / sqrtf(wave_sum(q2) * (1.f / 256.f) + EPS);
#pragma unroll
                for (int q = 0; q < 4; ++q) { const int c = lane + 64 * q; const float y = (acc[ri][q] - mean) * rstd * gln[c] + bln[c]; ACAT[(size_t)(r0 + 4 * F.wave + ri) * ACAT_LD + AC_UC + c] = f2bf(y * sigmoidf_(y)); } }
        }
        __syncthreads();
    }
    const float* gqa = INP(11) + l * QL; const float* gkva = INP(13) + l * KVL; const float* wc3 = INP(21) + l * 3 * 256;
    for (int r = F.gw; r < MROWS; r += F.NGW) {
        const bf16_t* pr = PROJ + (size_t)r * PROJ_LD; const int mr = kvrow_of_row(r);
        {
            float v[6]; float s = 0.f;
#pragma unroll
            for (int j = 0; j < 3; ++j) { const unsigned u = *(const unsigned*)(pr + 2 * lane + 128 * j); v[2 * j] = bf_lo(u); v[2 * j + 1] = bf_hi(u); s += v[2 * j] * v[2 * j] + v[2 * j + 1] * v[2 * j + 1]; }
            const float rstd = 1.f / sqrtf(wave_sum(s) * (1.f / QL) + EPS);
#pragma unroll
            for (int j = 0; j < 3; ++j) { const int c = 2 * lane + 128 * j; *(unsigned*)(QN + (size_t)r * QL + c) = cvt_pk_bf16(v[2 * j] * rstd * gqa[c], v[2 * j + 1] * rstd * gqa[c + 1]); }
        }
        {
            const u32x2 u = *(const u32x2*)(pr + OFF_KVA + 4 * lane); f32x4 v = {bf_lo(u.x), bf_hi(u.x), bf_lo(u.y), bf_hi(u.y)};
            const float rstd = 1.f / sqrtf(wave_sum((v.x * v.x + v.y * v.y) + (v.z * v.z + v.w * v.w)) * (1.f / KVL) + EPS);
            v = v * rstd * *(const f32x4*)(gkva + 4 * lane);
            *(u32x2*)(CKV + (size_t)mr * KVL + 4 * lane) = (u32x2){cvt_pk_bf16(v.x, v.y), cvt_pk_bf16(v.z, v.w)};
            if (r < NCTX) { const int b = r >> 8, t = r & 255; *(f32x4*)(out_ckv + ((size_t)(b * DEPTH + l) * SEQ + t) * KVL + 4 * lane) = v; }
        }
        {
            const float v = bf1(pr[OFF_KR + (lane & 31)]);
            if (r < NCTX) { if (lane < 32) { const int b = r >> 8, t = r & 255; out_kr[((size_t)(b * DEPTH + l) * SEQ + t) * QKR + lane] = v; KR[(size_t)mr * QKR + lane] = f2bf(v); } }
            else { const int t = (r - NCTX) & 2047, j = lane & 31; const int pos = (j & 16) ? (t & 63) : (t >> 6); const float c = rope[(pos * 8 + (j & 7)) * 2], s = rope[(pos * 8 + (j & 7)) * 2 + 1];
                const float p = __shfl_xor(v, 8); const float o = (j & 8) ? (v * c + p * s) : (v * c - p * s);
                if (lane < 32) KR[(size_t)mr * QKR + lane] = f2bf(o); }
        }
        {
            const int s0 = r < NCTX ? (r & ~255) : NCTX + ((r - NCTX) & ~2047); const int s1 = s0 + (r < NCTX ? 256 : 2048);
            f32x4 a = {0.f, 0.f, 0.f, 0.f};
#pragma unroll
            for (int d = 0; d < 3; ++d) { const int row = r + d - 1;
                if (row >= s0 && row < s1) { const bf16_t* q = PROJ + (size_t)row * PROJ_LD + OFF_SC; const u32x2 gc = *(const u32x2*)(q + 256 + 4 * lane), xs = *(const u32x2*)(q + 512 + 4 * lane);
                    const f32x4 w = *(const f32x4*)(wc3 + d * 256 + 4 * lane);
                    a.x += w.x * bf_lo(gc.x) * bf_lo(xs.x); a.y += w.y * bf_hi(gc.x) * bf_hi(xs.x); a.z += w.z * bf_lo(gc.y) * bf_lo(xs.y); a.w += w.w * bf_hi(gc.y) * bf_hi(xs.y); } }
            const u32x2 gb = *(const u32x2*)(pr + OFF_SC + 4 * lane);
            *(u32x2*)(ACAT + (size_t)r * ACAT_LD + AC_SC + 4 * lane) = (u32x2){cvt_pk_bf16(a.x * bf_lo(gb.x), a.y * bf_hi(gb.x)), cvt_pk_bf16(a.z * bf_lo(gb.y), a.w * bf_hi(gb.y))};
        }
    }
    const float* cckv = INP(2); const float* ckr = INP(3);
    for (int i = F.gw; i < NBL * PAST; i += F.NGW) { const int b = i >> 8, p = i & 255; const int mr = NCTX + b * 2304 + p;
        const f32x4 v = *(const f32x4*)(cckv + ((size_t)(b * DEPTH + l) * PAST + p) * KVL + 4 * lane);
        *(u32x2*)(CKV + (size_t)mr * KVL + 4 * lane) = (u32x2){cvt_pk_bf16(v.x, v.y), cvt_pk_bf16(v.z, v.w)};
        if (lane < 32) KR[(size_t)mr * QKR + lane] = f2bf(ckr[((size_t)(b * DEPTH + l) * PAST + p) * QKR + lane]); }
    {
        LAS bf16_t* tl = (LAS bf16_t*)(F.lds + F.wave * 16384);
        bf16_t* PQL = (bf16_t*)(ws + WS_PQL); bf16_t* PQC = (bf16_t*)(ws + WS_PQC);
        for (int it = F.gw; it < 128 * 8; it += F.NGW) { const int rc = it >> 3, part = (it >> 2) & 1, cq = it & 3;
            const int col0 = (part ? OFF_GATE : OFF_FN) + cq * 64;
#pragma unroll 4
            for (int i = 0; i < 32; ++i) { const int t = 2 * i + (lane >> 5), c2 = lane & 31; const unsigned u = *(const unsigned*)(PROJ + (size_t)(rc * 64 + t) * PROJ_LD + col0 + 2 * c2);
                tl[(2 * c2) * 72 + t] = (bf16_t)(u & 0xffffu); tl[(2 * c2 + 1) * 72 + t] = (bf16_t)(u >> 16); }
            LDS_WAIT(); asm volatile("" ::: "memory");
            bf16_t* dst; int ldd;
            if (rc < 64) { const int b = rc >> 2, t0 = (rc & 3) * 64; dst = PQC + ((size_t)b * 256 + cq * 64) * 512 + part * 256 + t0; ldd = 512; }
            else { const int b = (rc - 64) >> 5, t0 = ((rc - 64) & 31) * 64; dst = PQL + ((size_t)b * 256 + cq * 64) * 4096 + part * 2048 + t0; ldd = 4096; }
#pragma unroll
            for (int i = 0; i < 8; ++i) { const int ch = 8 * i + (lane >> 3), t8 = (lane & 7) * 8; const u32x4 v = *(const LAS u32x4*)(tl + ch * 72 + t8); *(u32x4*)(dst + (size_t)ch * ldd + t8) = v; }
            LDS_WAIT(); asm volatile("" ::: "memory");
        }
    }
}

__device__ __forceinline__ void phase_attn(Ctx& F) {
    unsigned char* ws = F.ws;
    {
        const bf16_t* P = (const bf16_t*)(ws + WS_DFTP); bf16_t* Fo = (bf16_t*)(ws + WS_ACAT) + (size_t)NCTX * ACAT_LD + AC_F;
        const int gt = F.gw * 64 + F.lane, NT = F.NGW * 64;
        for (int it = gt; it < NLAT * 32; it += NT) { const int row = it >> 5, c8 = (it & 31) * 8; const int b = row >> 11, k = row & 2047; float sv[8] = {0.f, 0.f, 0.f, 0.f, 0.f, 0.f, 0.f, 0.f};
#pragma unroll
            for (int ks = 0; ks < 8; ++ks) { const u32x4 p = *(const u32x4*)(P + ((size_t)(b * 8 + ks) * 2048 + k) * 256 + c8);
                sv[0] += bf_lo(p.x); sv[1] += bf_hi(p.x); sv[2] += bf_lo(p.y); sv[3] += bf_hi(p.y); sv[4] += bf_lo(p.z); sv[5] += bf_hi(p.z); sv[6] += bf_lo(p.w); sv[7] += bf_hi(p.w); }
            *(u32x4*)(Fo + (size_t)row * ACAT_LD + c8) = (u32x4){cvt_pk_bf16(sv[0], sv[1]), cvt_pk_bf16(sv[2], sv[3]), cvt_pk_bf16(sv[4], sv[5]), cvt_pk_bf16(sv[6], sv[7])}; }
    }
    attn::Tensors T{(const bf16_t*)(ws + WS_PROJ + PJ_Q), (const bf16_t*)(ws + WS_PROJ + PJ_KV), (const bf16_t*)(ws + WS_XN + XN_KR), (bf16_t*)(ws + WS_ACAT)};
    for (int u = F.bid; u < 512; u += F.G) {
        if (u < 256) { const int b = u >> 7, h = (u >> 4) & 7, qb = u & 15;
            attn::unit(T, NCTX + b * 2048 + qb * 128, NCTX + b * 2304, 18, h, (char*)F.lds, F.tid); }
        else { const int v = u - 256; const int b = v >> 4, h = (v >> 1) & 7, qb = v & 1;
            attn::unit(T, b * 256 + qb * 128, b * 256, 2, h, (char*)F.lds, F.tid); }
    }
}

__device__ __forceinline__ void phase_final(Ctx& F) {
    const float* g = INP(28);
    for (int r = F.gw; r < MROWS; r += F.NGW) { f32x4* xr = (f32x4*)(F.out + (size_t)r * D) + F.lane; f32x4 v[4]; float s = 0.f;
#pragma unroll
        for (int j = 0; j < 4; ++j) { v[j] = xr[64 * j]; s += (v[j].x * v[j].x + v[j].y * v[j].y) + (v[j].z * v[j].z + v[j].w * v[j].w); }
        const float rstd = 1.f / sqrtf(wave_sum(s) * (1.f / D) + EPS);
#pragma unroll
        for (int j = 0; j < 4; ++j) xr[64 * j] = v[j] * rstd * *(const f32x4*)(g + 4 * (64 * j + F.lane)); }
}

constexpr int STEPS_PER_LAYER = 8, N_STEPS = 3 + DEPTH * STEPS_PER_LAYER;
__host__ __device__ constexpr bool barrier_after(int s) { return s < N_STEPS - 1; }
__host__ __device__ constexpr int probe_key(int step) { return step == 0 ? 16 : step == 1 ? 18 : step == N_STEPS - 1 ? 17 : (step - 2) % STEPS_PER_LAYER; }

__global__ void __launch_bounds__(512, 2) mk_fwd(Args args) {
    extern __shared__ __attribute__((aligned(16))) unsigned char lds_raw[];
    volatile LAS unsigned* MISC = (volatile LAS unsigned*)((LAS unsigned char*)lds_raw + MISC_OFF);
    if (threadIdx.x < 64) MISC[threadIdx.x] = 0u;
    __syncthreads();
    XcdBarrier bar; bar.bar = (unsigned*)(args.ws + WS_CTL) + 1024; bar.x = 0; bar.st = nullptr;
    if (MK_N_LAUNCHES == 1) bar = xcd_barrier_post((unsigned*)(args.ws + WS_CTL) + 1024, MISC + 8);
    unsigned long long tacc = 0;
    const int wave0 = __builtin_amdgcn_readfirstlane(threadIdx.x >> 6);
    for (int step = args.step_lo; step < args.step_hi; ++step) {
        int btid; { int w0 = wave0; unsigned z = 0u; asm volatile("" : "+s"(w0), "+s"(z)); btid = w0 * 64 + (int)__builtin_amdgcn_mbcnt_hi(~0u, __builtin_amdgcn_mbcnt_lo(~0u, z)); }
        unsigned long long t0_ = 0; if (PROBE_TSTEP >= 0) t0_ = __builtin_amdgcn_s_memrealtime();
        const int kprobe = probe_key(step);
        const int nrep = ((PROBE_MASK >> kprobe) & 1) ? 2 : 1;
      for (int rep = 0; rep < nrep; ++rep) {
        unsigned char* ws = args.ws; float* outp = args.out; int tid_; { int w0 = wave0; unsigned z = 0u; asm volatile("" : "+s"(w0), "+s"(z)); tid_ = w0 * 64 + (int)__builtin_amdgcn_mbcnt_hi(~0u, __builtin_amdgcn_mbcnt_lo(~0u, z)); } int bid_ = blockIdx.x;
        asm volatile("" : "+s"(ws), "+s"(outp), "+v"(tid_), "+s"(bid_));
        Ctx F; F.lds = (LAS unsigned char*)lds_raw; F.tid = tid_; F.lane = F.tid & 63; F.wave = __builtin_amdgcn_readfirstlane(F.tid >> 6);
        F.G = gridDim.x; F.gw = bid_ * 8 + F.wave; F.NGW = F.G * 8; F.out = outp; F.ws = ws; F.bid = bid_;
        int ngemm = 0;
        if (step == 0) prologue(F);
        else if (step == 1) phase_pre(F);
        else if (step == N_STEPS - 1) phase_final(F);
        else {
            const int l = (step - 2) / STEPS_PER_LAYER, k = (step - 2) % STEPS_PER_LAYER;
            unsigned char* wl = ws + WS_W + (size_t)l * W_LAYER;
            const float* modl = (const float*)(ws + WS_MOD) + l * 3 * 6144; (void)modl;
            if (k == 1) phase_prep(F, l); else if (k == 3) phase_attn(F); else ngemm = (k == 2) ? 2 : 1;
            for (int r = 0; r < ngemm; ++r) {
                { unsigned char* w2 = F.ws; float* o2 = F.out; asm volatile("" : "+s"(w2), "+s"(o2)); ws = w2; F.out = o2; wl = ws + WS_W + (size_t)l * W_LAYER; modl = (const float*)(ws + WS_MOD) + l * 3 * 6144; }
                pg8::Job J{}; J.nZ = 1; J.a_lo = J.a_hi = J.b_lo = J.b_hi = 0; J.zso = 0; J.aux = 0; J.ldc = 0; int single = -1;
                if (k == 0) { J.p2 = ws + WS_SUMSQ + (size_t)(2 * l) * MROWS * 4; J.p3 = ws + WS_BIAS + (size_t)(l * 2) * 3 * BIAS_LD * 4; J.A = (const char*)(ws + WS_XN); J.Bt = (const char*)(wl + W_IN); J.lda = 1024; J.ldb = 1024; J.K = 1024; J.nM = 32; J.nN = 26; J.kind = pg8::EK_PROJ; J.o0 = ws + WS_PROJ; J.o1 = ws + WS_GATES; }
                else if (k == 2) {
                    const int L = F.bid + r * F.G; if (L >= 376) continue;
                    if (L < 128) { single = L; J.A = (const char*)(ws + WS_DFTL); J.Bt = (const char*)(ws + WS_PQL); J.lda = 4096; J.ldb = 4096; J.K = 512; J.nM = 8; J.nN = 1; J.nZ = 16; J.kind = pg8::EK_BF16;
                        J.a_lo = 1024; J.b_lo = 1024; J.b_hi = (long)256 * 4096 * 2; J.o0 = ws + WS_DFTP; J.ldc = 256; J.zso = (long)2048 * 256; }
                    else if (L < 144) { single = L - 128; J.A = (const char*)(ws + WS_DFTC); J.Bt = (const char*)(ws + WS_PQC); J.lda = 512; J.ldb = 512; J.K = 512; J.nM = 1; J.nN = 1; J.nZ = 16; J.kind = pg8::EK_BF16;
                        J.b_lo = (long)256 * 512 * 2; J.b_hi = (long)8 * 256 * 512 * 2; J.o0 = ws + WS_ACAT + AC_F * 2; J.ldc = ACAT_LD; J.zso = (long)256 * ACAT_LD; }
                    else if (L < 240) { single = L - 144; J.A = (const char*)(ws + WS_XN + XN_QN); J.Bt = (const char*)(wl + W_QB); J.lda = 384; J.ldb = 384; J.K = 384; J.nM = 32; J.nN = 3; J.kind = pg8::EK_Q;
                        J.o0 = ws + WS_PROJ + PJ_Q; J.p0 = ws + WS_ROPE; }
                    else { single = L - 240; J.A = (const char*)(ws + WS_XN + XN_CKV); J.Bt = (const char*)(wl + W_KVB); J.lda = 256; J.ldb = 256; J.K = 256; J.nM = 34; J.nN = 4; J.kind = pg8::EK_BF16;
                        J.o0 = ws + WS_PROJ + PJ_KV; J.ldc = 1024; }
                }
                else if (k == 4) { J.A = (const char*)(ws + WS_ACAT); J.Bt = (const char*)(wl + W_CAT); J.lda = 1280; J.ldb = 1280; J.K = 1280; J.nM = 64; J.nN = 4; J.hm = 1; J.kind = pg8::EK_MERGE; J.o0 = ws + WS_PROJ + PJ_Q; J.p0 = ws + WS_GATES; }
                else if (k == 5) { J.o1 = ws + WS_XN; J.o2 = ws + WS_SUMSQ + (size_t)(2 * l + 1) * MROWS * 4; J.p2 = INP(9) + l * D; J.p3 = modl + 4096; J.A = (const char*)(ws + WS_PROJ + PJ_Q); J.Bt = (const char*)(wl + W_OUT); J.lda = 1024; J.ldb = 1024; J.K = 1024; J.nM = 64; J.nN = 4; J.hm = 1; J.kind = pg8::EK_RESID; J.o0 = F.out; J.p1 = F.out; J.p0 = modl; J.aux = 2048; }
                else if (k == 6) { J.p2 = ws + WS_SUMSQ + (size_t)(2 * l + 1) * MROWS * 4; J.p3 = ws + WS_BIAS + (size_t)(l * 2 + 1) * 3 * BIAS_LD * 4; J.A = (const char*)(ws + WS_XN); J.Bt = (const char*)(wl + W_GU); J.lda = 1024; J.ldb = 1024; J.K = 1024; J.nM = 32; J.nN = 22; J.kind = pg8::EK_SWIGLU; J.o0 = ws + WS_GATES; }
                else { if (l + 1 < DEPTH) { J.o1 = ws + WS_XN; J.o2 = ws + WS_SUMSQ + (size_t)(2 * l + 2) * MROWS * 4; J.p2 = INP(8) + (l + 1) * D; J.p3 = modl + 3 * 6144 + 1024; } J.A = (const char*)(ws + WS_GATES); J.Bt = (const char*)(wl + W_DN); J.lda = FF; J.ldb = FF; J.K = FF; J.nM = 64; J.nN = 4; J.hm = 1; J.kind = pg8::EK_RESID; J.o0 = F.out; J.p1 = F.out; J.p0 = modl; J.aux = 5120; }
                if (PROBE_MASK != 0 && rep + 1 < nrep && J.kind == pg8::EK_RESID) J.o0 = ws + WS_ACAT;
                pg8::Order S; if (single >= 0) S.init_single(J, single); else S.init(J, F.G, F.bid);
                if (J.hm) pg8::gemm_phase_hm(F.lds, J, S, F.tid); else pg8::gemm_phase(F.lds, J, S, F.tid);
            }
        }
      }
        if (step + 1 < args.step_hi && barrier_after(step)) { xcd_barrier(bar, btid); if ((PROBE_MASK >> 18) & 1) xcd_barrier(bar, btid); }
        if (PROBE_TSTEP >= 0) { const int kp = probe_key(step); if (kp == PROBE_TSTEP) tacc += __builtin_amdgcn_s_memrealtime() - t0_; }
    }
    if (PROBE_TSTEP >= 0 && blockIdx.x == 0 && wave0 == 0 && __builtin_amdgcn_mbcnt_lo(~0u, 0u) == 0) { const unsigned long long te = __builtin_amdgcn_s_memrealtime(); while (__builtin_amdgcn_s_memrealtime() - te < 8ull * tacc) __builtin_amdgcn_s_sleep(8); }
}

extern "C" void kernel_launch(void* const* d_in, const int* in_sizes, int n_in, void* d_out, int out_size, void* d_ws, size_t ws_size, hipStream_t stream) {
    static int grid = 0;
    if (grid == 0) {
        if (n_in != 29 || ws_size < WS_END) { fprintf(stderr, "kernel_launch: expected 29 inputs and >= %zu bytes of workspace; got %d, %zu\n", (size_t)WS_END, n_in, ws_size); grid = -1; return; }
        int dev = 0, cus = 0, per_cu = 0;
        if (hipGetDevice(&dev) != hipSuccess || hipDeviceGetAttribute(&cus, hipDeviceAttributeMultiprocessorCount, dev) != hipSuccess) { grid = -1; return; }
        if (hipFuncSetAttribute((const void*)mk_fwd, hipFuncAttributeMaxDynamicSharedMemorySize, LDS_BYTES) != hipSuccess) { fprintf(stderr, "kernel_launch: hipFuncSetAttribute failed\n"); grid = -1; return; }
        if (hipOccupancyMaxActiveBlocksPerMultiprocessor(&per_cu, (const void*)mk_fwd, 512, LDS_BYTES) != hipSuccess || per_cu < 1) fprintf(stderr, "kernel_launch: occupancy query reports %d\n", per_cu);
        (void)hipGetLastError();
        grid = cus;
    }
    if (grid < 0) return;
    (void)hipMemsetAsync((char*)d_ws + WS_CTL, 0, CTL_ZERO_BYTES, stream);
    Args a{};
    for (int i = 0; i < 29; ++i) a.in[i] = (const float*)d_in[i];
    a.out = (float*)d_out; a.ws = (unsigned char*)d_ws;
    if (MK_N_LAUNCHES == 1) { a.step_lo = 0; a.step_hi = N_STEPS; hipLaunchKernelGGL(mk_fwd, dim3(grid), dim3(512), LDS_BYTES, stream, a); }
    else {
        int lo = 0;
        for (int s = 0; s < N_STEPS; ++s) if (barrier_after(s) || s == N_STEPS - 1) { a.step_lo = lo; a.step_hi = s + 1; hipLaunchKernelGGL(mk_fwd, dim3(grid), dim3(512), LDS_BYTES, stream, a); lo = s + 1; }
    }
}
```

```cpp
#include <hip/hip_runtime.h>
#include <hip/hip_bf16.h>
#include <cstdio>
#include <cstdint>

#ifndef MK_N_LAUNCHES
#define MK_N_LAUNCHES 1
#endif
#ifndef PROBE_TSTEP
#define PROBE_TSTEP -1
#endif
#ifndef PROBE_PRO
#define PROBE_PRO 0
#endif
#ifndef PROBE_MASK
#define PROBE_MASK 0
#endif

#define LAS __attribute__((address_space(3)))
#define GAS __attribute__((address_space(1)))
typedef unsigned short bf16_t;
typedef short bf16x8 __attribute__((ext_vector_type(8)));
typedef short s16x4 __attribute__((ext_vector_type(4)));
typedef float f32x4 __attribute__((ext_vector_type(4)));
typedef float f32x2 __attribute__((ext_vector_type(2)));
typedef float f32x16 __attribute__((ext_vector_type(16)));
typedef unsigned u32x4 __attribute__((ext_vector_type(4)));
typedef unsigned u32x2 __attribute__((ext_vector_type(2)));

constexpr int D = 1024, NCTX = 4096, NLAT = 4096, MROWS = 8192, DEPTH = 2;
constexpr int SEQ = 256, DEC_SEQ = 2048, PAST = 256, NBC = 16, NBL = 2;
constexpr int NH = 8, QKN = 64, QKR = 32, VH = 64, QL = 384, KVL = 256;
constexpr int IN_COLS = 6304, FF = 2816;
constexpr int OFF_KVA = 384, OFF_KR = 640, OFF_CONF = 672, OFF_SC = 1184, OFF_FN = 1952, OFF_GATE = 2208;
constexpr int PROJ_LD = 2464;
constexpr int WIN_N = 6656;
constexpr int KVROWS = 8704;
constexpr float EPS = 1e-6f;
constexpr float QSCALE = 0.10206207261596577f * 1.4426950408889634f;

constexpr size_t al256(size_t x) { return (x + 255) & ~(size_t)255; }
constexpr size_t WS_CTL = 0, CTL_ZERO_BYTES = 163840;
constexpr size_t WS_SUMSQ = 32768;
constexpr size_t WS_MOD = CTL_ZERO_BYTES;
constexpr size_t WS_ROPE = WS_MOD + al256(2 * 3 * 6144 * 4);
constexpr size_t WS_BIAS = WS_ROPE + 4096;
constexpr int BIAS_LD = 6656;
constexpr size_t WS_DFTL = WS_BIAS + (size_t)2 * 2 * 3 * BIAS_LD * 4;
constexpr size_t WS_DFTC = WS_DFTL + (size_t)2048 * 4096 * 2;
constexpr size_t WS_W = WS_DFTC + (size_t)256 * 512 * 2;
constexpr size_t W_IN = 0;
constexpr size_t W_QB = W_IN + (size_t)WIN_N * 1024 * 2;
constexpr size_t W_KVB = W_QB + (size_t)768 * 384 * 2;
constexpr size_t W_CAT = W_KVB + (size_t)1024 * 256 * 2;
constexpr size_t W_OUT = W_CAT + (size_t)1024 * 1280 * 2;
constexpr size_t W_GU = W_OUT + (size_t)1024 * 1024 * 2;
constexpr size_t W_DN = W_GU + (size_t)5632 * 1024 * 2;
constexpr size_t W_LAYER = W_DN + (size_t)1024 * 2816 * 2;
constexpr size_t WS_XN = WS_W + 2 * W_LAYER;
constexpr size_t XN_QN = 0, XN_CKV = XN_QN + (size_t)MROWS * 384 * 2, XN_KR = XN_CKV + (size_t)KVROWS * 256 * 2;
static_assert(XN_KR + (size_t)KVROWS * 32 * 2 <= (size_t)MROWS * 1024 * 2, "XN overlay");
constexpr size_t WS_PROJ = WS_XN + (size_t)MROWS * 1024 * 2;
constexpr size_t PJ_Q = 0, PJ_KV = PJ_Q + (size_t)MROWS * 768 * 2;
static_assert(PJ_KV + (size_t)KVROWS * 1024 * 2 <= (size_t)MROWS * PROJ_LD * 2, "PROJ overlay");
constexpr size_t WS_GATES = WS_PROJ + (size_t)MROWS * PROJ_LD * 2;
constexpr size_t WS_ACAT = WS_GATES + (size_t)MROWS * 4096 * 2;
constexpr int ACAT_LD = 1280, AC_UC = 512, AC_SC = 768, AC_F = 1024;
constexpr size_t WS_PQL = WS_ACAT + (size_t)MROWS * ACAT_LD * 2;
constexpr size_t WS_PQC = WS_PQL + (size_t)2 * 256 * 4096 * 2;
constexpr size_t WS_DFTP = WS_PQC + (size_t)16 * 256 * 512 * 2;
constexpr size_t WS_END = WS_DFTP + (size_t)2 * 8 * 2048 * 256 * 2;
static_assert(WS_END <= 268435456, "workspace map exceeds 256 MiB");

constexpr int RING_BYTES = 147456, MISC_OFF = RING_BYTES, LDS_BYTES = 163840;

__device__ __forceinline__ unsigned cvt_pk_bf16(float lo, float hi) { unsigned r; asm volatile("v_cvt_pk_bf16_f32 %0, %1, %2" : "=v"(r) : "v"(lo), "v"(hi)); return r; }
__device__ __forceinline__ float bf_lo(unsigned u) { return __uint_as_float(u << 16); }
__device__ __forceinline__ float bf_hi(unsigned u) { return __uint_as_float(u & 0xffff0000u); }
__device__ __forceinline__ float bf1(bf16_t u) { return __uint_as_float((unsigned)u << 16); }
__device__ __forceinline__ bf16_t f2bf(float f) { return (bf16_t)(cvt_pk_bf16(f, 0.f) & 0xffffu); }
__device__ __forceinline__ float sigmoidf_(float x) { return __builtin_amdgcn_rcpf(1.f + __expf(-x)); }
__device__ __forceinline__ float wave_sum(float v) {
#pragma unroll
    for (int o = 1; o < 64; o <<= 1) v += __shfl_xor(v, o);
    return v;
}
#define LDS_WAIT() asm volatile("s_waitcnt lgkmcnt(0)" ::: "memory")
#define VM_WAIT() asm volatile("s_waitcnt vmcnt(0)" ::: "memory")

namespace pg8 {
constexpr int BM = 256, BK = 64, HALF = 128, HTB = HALF * BK * 2, STAGE_BYTES = 8 * HTB;
__device__ __forceinline__ int lds_byte(int r, int c) { const int st = (r >> 4) * 2 + (c >> 5), rr = r & 15, cc = c & 31, ob = rr * 64 + cc * 2; return st * 1024 + (ob ^ (((ob >> 9) & 1) << 5)); }
__device__ __forceinline__ void stage_rc(int b, int& R, int& C) { const int st = b / 1024, sb = b % 1024, swz = sb ^ (((sb >> 9) & 1) << 5); R = (st >> 1) * 16 + swz / 64; C = (st & 1) * 32 + (swz % 64) / 2; }
__device__ __forceinline__ int perm32(int rho) { const int n = rho >> 4, i = rho & 15; return 8 * (i >> 2) + 4 * n + (i & 3); }

struct Unit { int pm, pn, z, koff, nt, seg; };
struct Job {
    const char* A; const char* Bt; int lda, ldb, K; long a_lo, a_hi, b_lo, b_hi;
    int nM, nN, nZ;
    int kind, hm;
    void* o0; void* o1; void* o2; const void* p0; const void* p1; const void* p2; const void* p3; int ldc; long zso; int aux;
};
enum { EK_PROJ = 0, EK_Q, EK_BF16, EK_MERGE, EK_RESID, EK_SWIGLU };

struct Order {
    int nM, nN, nZ, nwg, G, c, single, nt, chain;
    __device__ __forceinline__ void init(const Job& j, int G_, int c_) { nM = j.nM; nN = j.nN; nZ = j.nZ; nwg = nM * nN * nZ; G = G_; c = c_; single = -1; nt = j.K / BK; chain = (j.kind == EK_MERGE); }
    __device__ __forceinline__ void init_single(const Job& j, int unit) { nM = j.nM; nN = j.nN; nZ = j.nZ; nwg = nM * nN * nZ; G = 1; c = 0; single = unit; nt = j.K / BK; chain = 0; }
    __device__ __forceinline__ bool next(int i, Unit& u) const {
        u.koff = 0; u.nt = nt; u.seg = -1;
        if (single >= 0) { if (i > 0) return false; const int per = nM * nN; u.z = single / per; const int r = single % per; u.pn = r / nM; u.pm = r % nM; return true; }
        if (chain) { u.seg = i & 3; i >>= 2; u.koff = (u.seg == 0) ? 0 : (256 + 256 * u.seg) * 2; u.nt = (u.seg == 0) ? 8 : 4; }
        const long L = (long)i * G + c; if (L >= nwg) return false;
        if (nZ > 1) { const int per = nM * nN; u.z = (int)L / per; const int r = (int)L % per; u.pn = r / nM; u.pm = r % nM; return true; }
        constexpr int NXCD = 8, WGM = 8;
        int wgid = (int)L; { const int q = nwg / NXCD, r = nwg % NXCD, xcd = wgid % NXCD, off = wgid / NXCD; wgid = (xcd < r ? xcd * (q + 1) : r * (q + 1) + (xcd - r) * q) + off; }
        const int nig = WGM * nN, gid = wgid / nig, fm = gid * WGM, gsz = (nM - fm) < WGM ? (nM - fm) : WGM;
        u.pm = fm + ((wgid % nig) % gsz); u.pn = (wgid % nig) / gsz; u.z = 0; return true;
    }
};

__device__ __forceinline__ void epilogue(const Job& J, const f32x4 (&acc)[2][2][4][2], const Unit& u, int wr, int wc, int fr, int fq, const LAS float* aux) {
    const int row0 = u.pm * BM + wr * 64 + fr;
    const int cl = wc * 32 + 8 * fq;
    if (J.kind == EK_PROJ) {
        const bool isg = u.pn >= 10;
        bf16_t* base = isg ? (bf16_t*)J.o1 : (bf16_t*)J.o0; const int ldc = isg ? 4096 : PROJ_LD;
        const int col0 = (isg ? (u.pn - 10) * BM : u.pn * BM) + cl;
        const LAS float* ssq = aux + wr * 64 + fr; const LAS float* bias = aux + 256 + cl;
        f32x4 bb[2][2];
#pragma unroll
        for (int bj = 0; bj < 2; ++bj) { bb[bj][0] = *(const LAS f32x4*)(bias + bj * HALF); bb[bj][1] = *(const LAS f32x4*)(bias + bj * HALF + 4); }
#pragma unroll
        for (int ai = 0; ai < 2; ++ai)
#pragma unroll
            for (int m = 0; m < 4; ++m) { bf16_t* rowp = base + (size_t)(row0 + ai * HALF + m * 16) * ldc + col0;
                const float rs = __builtin_amdgcn_rsqf(ssq[ai * HALF + m * 16] * (1.f / D) + EPS);
#pragma unroll
                for (int bj = 0; bj < 2; ++bj) { f32x4 v0 = acc[ai][bj][m][0] * rs + bb[bj][0], v1 = acc[ai][bj][m][1] * rs + bb[bj][1];
                    if (isg) {
#pragma unroll
                        for (int e = 0; e < 4; ++e) { v0[e] = sigmoidf_(v0[e]); v1[e] = sigmoidf_(v1[e]); } }
                    u32x4 w; w.x = cvt_pk_bf16(v0[0], v0[1]); w.y = cvt_pk_bf16(v0[2], v0[3]); w.z = cvt_pk_bf16(v1[0], v1[1]); w.w = cvt_pk_bf16(v1[2], v1[3]);
                    if (isg || col0 + bj * HALF + 8 <= PROJ_LD) *(u32x4*)(rowp + bj * HALF) = w; } }
    } else if (J.kind == EK_Q) {
        bf16_t* Q = (bf16_t*)J.o0; const float* rope = (const float*)J.p0; const bool lat = u.pm >= 16;
#pragma unroll
        for (int bj = 0; bj < 2; ++bj) {
            const int G = 8 * u.pn + 4 * bj + wc; const bool isrope = lat && (G % 3 == 2);
#pragma unroll
            for (int ai = 0; ai < 2; ++ai)
#pragma unroll
                for (int m = 0; m < 4; ++m) { const int row = row0 + ai * HALF + m * 16;
                    float v[8];
#pragma unroll
                    for (int e = 0; e < 4; ++e) { v[e] = acc[ai][bj][m][0][e] * QSCALE; v[4 + e] = acc[ai][bj][m][1][e] * QSCALE; }
                    if (isrope) { const int t = (row - NCTX) & (DEC_SEQ - 1); const int pos = (fq < 2) ? (t >> 6) : (t & 63);
                        const f32x4* cs = (const f32x4*)(rope + pos * 16);
                        const f32x4 c0 = cs[0], c1 = cs[1], c2 = cs[2], c3 = cs[3];
                        const float cc[8] = {c0[0], c0[2], c1[0], c1[2], c2[0], c2[2], c3[0], c3[2]}, ss[8] = {c0[1], c0[3], c1[1], c1[3], c2[1], c2[3], c3[1], c3[3]};
#pragma unroll
                        for (int e = 0; e < 8; ++e) { const float p = __shfl_xor(v[e], 16); v[e] = (fq & 1) ? (v[e] * cc[e] + p * ss[e]) : (v[e] * cc[e] - p * ss[e]); } }
                    u32x4 w; w.x = cvt_pk_bf16(v[0], v[1]); w.y = cvt_pk_bf16(v[2], v[3]); w.z = cvt_pk_bf16(v[4], v[5]); w.w = cvt_pk_bf16(v[6], v[7]);
                    *(u32x4*)(Q + (size_t)row * 768 + u.pn * BM + bj * HALF + cl) = w; } }
    } else if (J.kind == EK_BF16) {
        bf16_t* O = (bf16_t*)J.o0 + (size_t)u.z * J.zso;
#pragma unroll
        for (int ai = 0; ai < 2; ++ai)
#pragma unroll
            for (int m = 0; m < 4; ++m) { bf16_t* rowp = O + (size_t)(row0 + ai * HALF + m * 16) * J.ldc + u.pn * BM + cl;
#pragma unroll
                for (int bj = 0; bj < 2; ++bj) { const f32x4 v0 = acc[ai][bj][m][0], v1 = acc[ai][bj][m][1];
                    u32x4 w; w.x = cvt_pk_bf16(v0[0], v0[1]); w.y = cvt_pk_bf16(v0[2], v0[3]); w.z = cvt_pk_bf16(v1[0], v1[1]); w.w = cvt_pk_bf16(v1[2], v1[3]);
                    *(u32x4*)(rowp + bj * HALF) = w; } }
    } else {
        bf16_t* ACT = (bf16_t*)J.o0;
        const LAS float* ssq = aux + wr * 64 + fr; const LAS float* bias = aux + 256 + cl;
        const f32x4 bg0 = *(const LAS f32x4*)bias, bg1 = *(const LAS f32x4*)(bias + 4), bu0 = *(const LAS f32x4*)(bias + HALF), bu1 = *(const LAS f32x4*)(bias + HALF + 4);
#pragma unroll
        for (int ai = 0; ai < 2; ++ai)
#pragma unroll
            for (int m = 0; m < 4; ++m) { f32x4 v0, v1; const float rs = __builtin_amdgcn_rsqf(ssq[ai * HALF + m * 16] * (1.f / D) + EPS);
#pragma unroll
                for (int e = 0; e < 4; ++e) { const float g0 = acc[ai][0][m][0][e] * rs + bg0[e], g1 = acc[ai][0][m][1][e] * rs + bg1[e];
                    v0[e] = g0 * sigmoidf_(g0) * (acc[ai][1][m][0][e] * rs + bu0[e]); v1[e] = g1 * sigmoidf_(g1) * (acc[ai][1][m][1][e] * rs + bu1[e]); }
                u32x4 w; w.x = cvt_pk_bf16(v0[0], v0[1]); w.y = cvt_pk_bf16(v0[2], v0[3]); w.z = cvt_pk_bf16(v1[0], v1[1]); w.w = cvt_pk_bf16(v1[2], v1[3]);
                *(u32x4*)(ACT + (size_t)(row0 + ai * HALF + m * 16) * FF + u.pn * HALF + cl) = w; }
    }
}

__device__ __forceinline__ void gemm_phase(LAS unsigned char* lds, const Job& g, const Order& S, const int tid_in) {
    int tid = tid_in; asm volatile("" : "+v"(tid));
    const int wid = __builtin_amdgcn_readfirstlane(tid >> 6), lane = tid & 63, wr = wid >> 2, wc = wid & 3, fr = lane & 15, fq = lane >> 4;
    unsigned voffA[2], voffB[2];
#pragma unroll
    for (int i = 0; i < 2; ++i) { int R, C; stage_rc(tid * 16 + i * 8192, R, C); const int Rb = (R & ~31) + perm32(R & 31);
        voffA[i] = (unsigned)(R * g.lda + C) * 2u; voffB[i] = (unsigned)(Rb * g.ldb + C) * 2u; }
    const size_t kstep = (size_t)(BK * 2);
    const size_t hstepA = (size_t)HALF * g.lda * 2, hstepB = (size_t)HALF * g.ldb * 2;
    const size_t tstepA = 2 * hstepA, tstepB = 2 * hstepB;
    const unsigned ldsw = (unsigned)wid * 1024u;
    const int aoff = lds_byte(wr * 64 + fr, fq * 8), boff = lds_byte(wc * 32 + fr, fq * 8);
#define PG8_SA(b, h) (((b) * 2 + (h)) * HTB)
#define PG8_SB(b, h) ((4 + (b) * 2 + (h)) * HTB)
#define PG8_STAGE(bufoff, gbase, voff) do { _Pragma("unroll") for (int _i = 0; _i < 2; ++_i) \
        __builtin_amdgcn_global_load_lds((const unsigned*)((const char*)(gbase) + (voff)[_i]), (LAS unsigned*)(lds + (bufoff) + ldsw + _i * 8192), 16, 0, 0); } while (0)
#define PG8_LDA(dst, b, h) do { _Pragma("unroll") for (int m = 0; m < 4; ++m) _Pragma("unroll") for (int k = 0; k < 2; ++k) dst[m][k] = *(const LAS bf16x8*)(lds + PG8_SA(b, h) + aoff + m * 2048 + k * 1024); } while (0)
#define PG8_LDB(dst, b, h) do { _Pragma("unroll") for (int n = 0; n < 2; ++n) _Pragma("unroll") for (int k = 0; k < 2; ++k) dst[n][k] = *(const LAS bf16x8*)(lds + PG8_SB(b, h) + boff + n * 2048 + k * 1024); } while (0)
#define PG8_MMA(ai, bj, At, Bt) do { __builtin_amdgcn_s_setprio(1); _Pragma("unroll") for (int m = 0; m < 4; ++m) _Pragma("unroll") for (int n = 0; n < 2; ++n) _Pragma("unroll") for (int k = 0; k < 2; ++k) \
        acc[ai][bj][m][n] = __builtin_amdgcn_mfma_f32_16x16x32_bf16(Bt[n][k], At[m][k], acc[ai][bj][m][n], 0, 0, 0); __builtin_amdgcn_s_setprio(0); } while (0)
#define PG8_WAIT_V(n) asm volatile("s_waitcnt vmcnt(" #n ")" ::: "memory")
#define PG8_WAIT_L(n) asm volatile("s_waitcnt lgkmcnt(" #n ")" ::: "memory")
#define PG8_BAR __builtin_amdgcn_s_barrier()
#define PG8_SCHED __builtin_amdgcn_sched_barrier(0)
#define PG8_UA(u) (g.A + (size_t)((u).z & 7) * g.a_lo + (size_t)((u).z >> 3) * g.a_hi + (size_t)(u).pm * tstepA + (u).koff)
#define PG8_UB(u) (g.Bt + (size_t)((u).z & 7) * g.b_lo + (size_t)((u).z >> 3) * g.b_hi + (size_t)(u).pn * tstepB + (u).koff)
    Unit cur, nxt; int ui = 0;
    if (!S.next(0, cur)) return;
    const bool has_aux = (g.kind == EK_PROJ || g.kind == EK_SWIGLU);
#define PG8_AUX(u, par) do { if (has_aux) { const int mi_ = (u).pm < 16 ? 0 : ((u).pm < 24 ? 1 : 2); \
        const float* src_ = (wid < 4) ? (const float*)g.p2 + (u).pm * BM + wid * 64 + lane : (const float*)g.p3 + mi_ * BIAS_LD + (u).pn * BM + (wid - 4) * 64 + lane; \
        __builtin_amdgcn_global_load_lds((const unsigned*)src_, (LAS unsigned*)(lds + STAGE_BYTES + (par) * 2048 + wid * 256), 4, 0, 0); } } while (0)
    f32x4 acc[2][2][4][2];
#pragma unroll
    for (int a = 0; a < 2; ++a)
#pragma unroll
        for (int b = 0; b < 2; ++b)
#pragma unroll
            for (int m = 0; m < 4; ++m)
#pragma unroll
                for (int n = 0; n < 2; ++n) acc[a][b][m][n] = (f32x4){0.f, 0.f, 0.f, 0.f};
    bf16x8 At[4][2], B0[2][2], B1[2][2];
    const char* cA = PG8_UA(cur); const char* cB = PG8_UB(cur);
    PG8_STAGE(PG8_SB(0, 0), cB, voffB); PG8_STAGE(PG8_SB(0, 1), cB + hstepB, voffB); PG8_STAGE(PG8_SA(0, 0), cA, voffA); PG8_STAGE(PG8_SA(0, 1), cA + hstepA, voffA);
    if (wr == 1) PG8_BAR;
    PG8_WAIT_V(2); PG8_BAR;
    PG8_STAGE(PG8_SB(1, 0), cB + kstep, voffB); PG8_STAGE(PG8_SA(1, 0), cA + kstep, voffA); PG8_STAGE(PG8_SB(1, 1), cB + hstepB + kstep, voffB);
    PG8_WAIT_V(6); PG8_BAR;
    for (;;) {
        const bool has_next = S.next(ui + 1, nxt);
        const char* nA = has_next ? PG8_UA(nxt) : cA; const char* nB = has_next ? PG8_UB(nxt) : cB;
        const int nt = cur.nt;
        PG8_AUX(cur, ui & 1);
        for (int t = 0; t < nt; t += 2) {
            const bool last = (t == nt - 2);
            const char* a1 = cA + (size_t)(t + 1) * kstep;
            const char* a2 = last ? nA : cA + (size_t)(t + 2) * kstep; const char* b2 = last ? nB : cB + (size_t)(t + 2) * kstep;
            const char* a3 = a2 + kstep; const char* b3 = b2 + kstep;
            PG8_LDB(B0, 0, 0); PG8_LDB(B1, 0, 1); PG8_SCHED; PG8_LDA(At, 0, 0); PG8_STAGE(PG8_SA(1, 1), a1 + hstepA, voffA);
            PG8_WAIT_V(8); PG8_WAIT_L(0); PG8_BAR; PG8_MMA(0, 0, At, B0); PG8_MMA(0, 1, At, B1); PG8_BAR; PG8_SCHED;
            PG8_LDA(At, 0, 1); PG8_STAGE(PG8_SB(0, 0), b2, voffB); PG8_STAGE(PG8_SB(0, 1), b2 + hstepB, voffB); PG8_STAGE(PG8_SA(0, 0), a2, voffA);
            PG8_WAIT_V(8); PG8_WAIT_L(0); PG8_BAR; PG8_MMA(1, 0, At, B0); PG8_MMA(1, 1, At, B1); PG8_BAR; PG8_SCHED;
            PG8_LDB(B0, 1, 0); PG8_LDB(B1, 1, 1); PG8_SCHED; PG8_LDA(At, 1, 0); PG8_STAGE(PG8_SA(0, 1), a2 + hstepA, voffA);
            PG8_WAIT_V(8); PG8_WAIT_L(0); PG8_BAR; PG8_MMA(0, 0, At, B0); PG8_MMA(0, 1, At, B1); PG8_BAR; PG8_SCHED;
            PG8_LDA(At, 1, 1); PG8_STAGE(PG8_SB(1, 0), b3, voffB); PG8_STAGE(PG8_SB(1, 1), b3 + hstepB, voffB); PG8_STAGE(PG8_SA(1, 0), a3, voffA);
            PG8_WAIT_V(8); PG8_WAIT_L(0); PG8_BAR; PG8_MMA(1, 0, At, B0); PG8_MMA(1, 1, At, B1); PG8_BAR; PG8_SCHED;
        }
        if (wr == 0) PG8_BAR;
        epilogue(g, acc, cur, wr, wc, fr, fq, (const LAS float*)(lds + STAGE_BYTES + (ui & 1) * 2048));
        if (!has_next) break;
#pragma unroll
        for (int a = 0; a < 2; ++a)
#pragma unroll
            for (int b = 0; b < 2; ++b)
#pragma unroll
                for (int m = 0; m < 4; ++m)
#pragma unroll
                    for (int n = 0; n < 2; ++n) acc[a][b][m][n] = (f32x4){0.f, 0.f, 0.f, 0.f};
        cur = nxt; cA = nA; cB = nB; ++ui;
        if (wr == 1) PG8_BAR;
    }
    PG8_WAIT_V(0);
    PG8_BAR;
#undef PG8_SA
#undef PG8_SB
#undef PG8_STAGE
#undef PG8_LDA
#undef PG8_LDB
#undef PG8_MMA
#undef PG8_WAIT_V
#undef PG8_WAIT_L
#undef PG8_BAR
#undef PG8_SCHED
#undef PG8_UA
#undef PG8_UB
#undef PG8_AUX
}

__device__ __forceinline__ void epilogue_hm(const Job& J, f32x4 (&acc)[2][4][2], f32x4 (&macc)[2][4][2], const Unit& u, int wr, int wc, int fr, int fq) {
    const int row0 = u.pm * HALF + wr * 64 + fr; const int cl = wc * 32 + 8 * fq;
    if (J.kind == EK_MERGE) {
        const bf16_t* gates = (const bf16_t*)J.p0 + u.seg * 1024; bf16_t* MB = (bf16_t*)J.o0;
#pragma unroll
        for (int m = 0; m < 4; ++m) { const size_t row = (size_t)(row0 + m * 16);
#pragma unroll
            for (int bj = 0; bj < 2; ++bj) { const int col = u.pn * BM + bj * HALF + cl;
                const u32x4 g = *(const u32x4*)(gates + row * 4096 + col);
                f32x4 v0 = acc[bj][m][0], v1 = acc[bj][m][1];
                v0[0] *= bf_lo(g.x); v0[1] *= bf_hi(g.x); v0[2] *= bf_lo(g.y); v0[3] *= bf_hi(g.y); v1[0] *= bf_lo(g.z); v1[1] *= bf_hi(g.z); v1[2] *= bf_lo(g.w); v1[3] *= bf_hi(g.w);
                if (u.seg > 0) { v0 += macc[bj][m][0]; v1 += macc[bj][m][1]; }
                macc[bj][m][0] = v0; macc[bj][m][1] = v1;
                if (u.seg == 3) { u32x4 w; w.x = cvt_pk_bf16(v0[0], v0[1]); w.y = cvt_pk_bf16(v0[2], v0[3]); w.z = cvt_pk_bf16(v1[0], v1[1]); w.w = cvt_pk_bf16(v1[2], v1[3]); *(u32x4*)(MB + row * 1024 + col) = w; } } }
    } else {
        float* X = (float*)J.o0; const float* XI = (const float*)J.p1; const int mi = u.pm < 32 ? 0 : (u.pm < 48 ? 1 : 2); const float* gv = (const float*)J.p0 + mi * 6144 + J.aux;
        bf16_t* XS = (bf16_t*)J.o1; float* SS = (float*)J.o2; const float* gn = (const float*)J.p2; const float* scn = (const float*)J.p3 + mi * 6144;
        float sm[4] = {0.f, 0.f, 0.f, 0.f};
#pragma unroll
        for (int bj = 0; bj < 2; ++bj) { const int col = u.pn * BM + bj * HALF + cl; const f32x4 g0 = *(const f32x4*)(gv + col), g1 = *(const f32x4*)(gv + col + 4);
            f32x4 s0 = {0.f, 0.f, 0.f, 0.f}, s1 = s0;
            if (XS) { s0 = *(const f32x4*)(gn + col) * (*(const f32x4*)(scn + col) + 1.f); s1 = *(const f32x4*)(gn + col + 4) * (*(const f32x4*)(scn + col + 4) + 1.f); }
#pragma unroll
            for (int m = 0; m < 4; ++m) { const size_t off = (size_t)(row0 + m * 16) * 1024 + col;
                const f32x4 a = *(const f32x4*)(XI + off) + g0 * acc[bj][m][0], b = *(const f32x4*)(XI + off + 4) + g1 * acc[bj][m][1];
                *(f32x4*)(X + off) = a; *(f32x4*)(X + off + 4) = b;
                if (XS) { const f32x4 ya = a * s0, yb = b * s1; *(u32x4*)(XS + off) = (u32x4){cvt_pk_bf16(ya[0], ya[1]), cvt_pk_bf16(ya[2], ya[3]), cvt_pk_bf16(yb[0], yb[1]), cvt_pk_bf16(yb[2], yb[3])};
                    sm[m] += (a[0] * a[0] + a[1] * a[1]) + (a[2] * a[2] + a[3] * a[3]) + (b[0] * b[0] + b[1] * b[1]) + (b[2] * b[2] + b[3] * b[3]); } } }
        if (XS) {
#pragma unroll
            for (int m = 0; m < 4; ++m) { float v = sm[m]; v += __shfl_xor(v, 16); v += __shfl_xor(v, 32); if (fq == 0) unsafeAtomicAdd(SS + row0 + m * 16, v); } }
    }
}

__device__ __forceinline__ void gemm_phase_hm(LAS unsigned char* lds, const Job& g, const Order& S, const int tid_in) {
    int tid = tid_in; asm volatile("" : "+v"(tid));
    const int wid = __builtin_amdgcn_readfirstlane(tid >> 6), lane = tid & 63, wr = wid >> 2, wc = wid & 3, fr = lane & 15, fq = lane >> 4;
    unsigned voffA[2], voffB[2];
#pragma unroll
    for (int i = 0; i < 2; ++i) { int R, C; stage_rc(tid * 16 + i * 8192, R, C); const int Rb = (R & ~31) + perm32(R & 31);
        voffA[i] = (unsigned)(R * g.lda + C) * 2u; voffB[i] = (unsigned)(Rb * g.ldb + C) * 2u; }
    const size_t kstep = (size_t)(BK * 2);
    const size_t hstepA = (size_t)HALF * g.lda * 2, hstepB = (size_t)HALF * g.ldb * 2, tstepB = 2 * hstepB;
    const unsigned ldsw = (unsigned)wid * 1024u;
    const int aoff = lds_byte(wr * 64 + fr, fq * 8), boff = lds_byte(wc * 32 + fr, fq * 8);
    constexpr int SLOT = 3 * HTB;
#define HM_STAGE(slotoff, gbase, voff) do { _Pragma("unroll") for (int _i = 0; _i < 2; ++_i) \
        __builtin_amdgcn_global_load_lds((const unsigned*)((const char*)(gbase) + (voff)[_i]), (LAS unsigned*)(lds + (slotoff) + ldsw + _i * 8192), 16, 0, 0); } while (0)
#define HM_MMA(bj, Bt) do { __builtin_amdgcn_s_setprio(1); _Pragma("unroll") for (int m = 0; m < 4; ++m) _Pragma("unroll") for (int n = 0; n < 2; ++n) _Pragma("unroll") for (int k = 0; k < 2; ++k) \
        acc[bj][m][n] = __builtin_amdgcn_mfma_f32_16x16x32_bf16(Bt[n][k], At[m][k], acc[bj][m][n], 0, 0, 0); __builtin_amdgcn_s_setprio(0); } while (0)
#define HM_WAIT_V(n) asm volatile("s_waitcnt vmcnt(" #n ")" ::: "memory")
#define HM_WAIT_L(n) asm volatile("s_waitcnt lgkmcnt(" #n ")" ::: "memory")
#define HM_BAR __builtin_amdgcn_s_barrier()
#define HM_SCHED __builtin_amdgcn_sched_barrier(0)
#define HM_UA(u) (g.A + (size_t)(u).pm * hstepA + (u).koff)
#define HM_UB(u) (g.Bt + (size_t)(u).pn * tstepB + (u).koff)
    Unit cur, nxt; int ui = 0;
    if (!S.next(0, cur)) return;
    f32x4 acc[2][4][2], macc[2][4][2];
#pragma unroll
    for (int b = 0; b < 2; ++b)
#pragma unroll
        for (int m = 0; m < 4; ++m)
#pragma unroll
            for (int n = 0; n < 2; ++n) { acc[b][m][n] = (f32x4){0.f, 0.f, 0.f, 0.f}; macc[b][m][n] = (f32x4){0.f, 0.f, 0.f, 0.f}; }
    bf16x8 At[4][2], B0[2][2], B1[2][2];
    const char* cA = HM_UA(cur); const char* cB = HM_UB(cur);
    HM_STAGE(0 * SLOT, cA, voffA); HM_STAGE(0 * SLOT + HTB, cB, voffB); HM_STAGE(0 * SLOT + 2 * HTB, cB + hstepB, voffB);
    HM_STAGE(1 * SLOT, cA + kstep, voffA); HM_STAGE(1 * SLOT + HTB, cB + kstep, voffB); HM_STAGE(1 * SLOT + 2 * HTB, cB + hstepB + kstep, voffB);
    if (wr == 1) HM_BAR;
    HM_WAIT_V(6); HM_BAR; HM_BAR;
    int rd = 0;
    for (;;) {
        const bool has_next = S.next(ui + 1, nxt);
        const char* nA = has_next ? HM_UA(nxt) : cA; const char* nB = has_next ? HM_UB(nxt) : cB;
        const int nt = cur.nt;
        for (int t = 0; t < nt; ++t) {
            const int st = (rd >= SLOT) ? rd - SLOT : rd + 2 * SLOT;
            const int t2 = t + 2;
            const char* a2 = (t2 < nt) ? cA + (size_t)t2 * kstep : nA + (size_t)(t2 - nt) * kstep;
            const char* b2 = (t2 < nt) ? cB + (size_t)t2 * kstep : nB + (size_t)(t2 - nt) * kstep;
            LAS unsigned char* lr = lds + rd;
#pragma unroll
            for (int n = 0; n < 2; ++n)
#pragma unroll
                for (int k = 0; k < 2; ++k) { B0[n][k] = *(const LAS bf16x8*)(lr + HTB + boff + n * 2048 + k * 1024); B1[n][k] = *(const LAS bf16x8*)(lr + 2 * HTB + boff + n * 2048 + k * 1024); }
            HM_SCHED;
#pragma unroll
            for (int m = 0; m < 4; ++m)
#pragma unroll
                for (int k = 0; k < 2; ++k) At[m][k] = *(const LAS bf16x8*)(lr + aoff + m * 2048 + k * 1024);
            HM_STAGE(st, a2, voffA); HM_STAGE(st + HTB, b2, voffB); HM_STAGE(st + 2 * HTB, b2 + hstepB, voffB);
            HM_WAIT_V(6); HM_WAIT_L(0); HM_BAR; HM_MMA(0, B0); HM_MMA(1, B1); HM_BAR; HM_SCHED;
            rd = (rd >= 2 * SLOT) ? 0 : rd + SLOT;
        }
        if (wr == 0) HM_BAR;
        epilogue_hm(g, acc, macc, cur, wr, wc, fr, fq);
        if (!has_next) break;
#pragma unroll
        for (int b = 0; b < 2; ++b)
#pragma unroll
            for (int m = 0; m < 4; ++m)
#pragma unroll
                for (int n = 0; n < 2; ++n) acc[b][m][n] = (f32x4){0.f, 0.f, 0.f, 0.f};
        cur = nxt; cA = nA; cB = nB; ++ui;
        if (wr == 1) HM_BAR;
    }
    HM_WAIT_V(0);
    HM_BAR;
#undef HM_STAGE
#undef HM_MMA
#undef HM_WAIT_V
#undef HM_WAIT_L
#undef HM_BAR
#undef HM_SCHED
#undef HM_UA
#undef HM_UB
}
}

namespace attn {
constexpr int KSLOT = 12288, VSLOT = 8192, BUFB = 2 * KSLOT + 2 * VSLOT;
constexpr int LDS_WS = 2 * BUFB;
constexpr int LDS_CM = LDS_WS + 2048;
constexpr int LDS_CL = LDS_CM + 1024;
constexpr int LDS_OST = LDS_CL + 512;
constexpr int LDS_END = LDS_OST + 8 * 4096;
static_assert(LDS_END <= RING_BYTES, "attention LDS");
__device__ __forceinline__ int crow(int r, int hi) { return (r & 3) + 8 * (r >> 2) + 4 * hi; }
__device__ __forceinline__ void glds16(const void* gsrc, unsigned lds_dst) { unsigned keep;
    asm volatile("s_mov_b32 %0, m0\n\ts_mov_b32 m0, %2\n\ts_nop 0\n\tglobal_load_lds_dwordx4 %1, off\n\ts_mov_b32 m0, %0" : "=&s"(keep) : "v"(gsrc), "s"(lds_dst) : "memory"); }
typedef __bf16 bf16x2_t __attribute__((ext_vector_type(2)));
__device__ __forceinline__ unsigned cvtpk_s(float lo, float hi) { f32x2 v = {lo, hi}; bf16x2_t b = __builtin_convertvector(v, bf16x2_t); return __builtin_bit_cast(unsigned, b); }
typedef LAS const char* lds_cptr;
typedef short v4i16_t __attribute__((ext_vector_type(4)));
__device__ __forceinline__ s16x4 vtr(lds_cptr p) { return __builtin_bit_cast(s16x4, __builtin_amdgcn_ds_read_tr16_b64_v4i16((LAS v4i16_t*)p)); }
__device__ __forceinline__ float swapmax(float m) { auto rr = __builtin_amdgcn_permlane32_swap(__float_as_uint(m), __float_as_uint(m), false, false); return fmaxf(__uint_as_float(rr[0]), __uint_as_float(rr[1])); }
__device__ __forceinline__ float swapsum(float m) { auto rr = __builtin_amdgcn_permlane32_swap(__float_as_uint(m), __float_as_uint(m), false, false); return __uint_as_float(rr[0]) + __uint_as_float(rr[1]); }

struct Tensors { const bf16_t* Q; const bf16_t* KV; const bf16_t* KR; bf16_t* O; };

__device__ __forceinline__ void dma_step(const Tensors& T, int krow0, int h, unsigned ldsbuf, int wid, int lane) {
#pragma unroll
    for (int i = 0; i < 5; ++i) {
        const int p = wid + 8 * i;
        const void* src; unsigned dst;
        if (p < 24) { const int j = p / 12, c = p % 12; const int row = krow0 + j * 64 + lane;
            src = (c < 8) ? (const void*)(T.KV + (size_t)row * 1024 + h * 128 + c * 8) : (const void*)(T.KR + (size_t)row * 32 + (c - 8) * 8);
            dst = ldsbuf + j * KSLOT + c * 1024; }
        else { const int pv = p - 24, j = pv >> 3, q = pv & 7; const int row = krow0 + j * 64 + 16 * (q & 3) + (lane >> 2);
            src = (const void*)(T.KV + (size_t)row * 1024 + h * 128 + 64 + (q >> 2) * 32 + (lane & 3) * 8);
            dst = ldsbuf + 2 * KSLOT + j * VSLOT + q * 1024; }
        glds16(src, (unsigned)__builtin_amdgcn_readfirstlane(dst));
    }
}

__device__ __forceinline__ void unit(const Tensors& T, int qrow0, int krow0, int nsteps, int h, char* shm, const int tid) {
    const int lane = tid & 63, r32 = lane & 31, hi = lane >> 5; const int wid = __builtin_amdgcn_readfirstlane(tid >> 6);
    const int qb = wid & 3, kh = wid >> 2;
    const unsigned lds0 = (unsigned)(uintptr_t)shm;
    float* wsf = (float*)(shm + LDS_WS) + wid * 64;
    dma_step(T, krow0, h, lds0, wid, lane);
    const bf16_t* Qw = T.Q + (size_t)(qrow0 + qb * 32 + r32) * 768 + h * 96 + hi * 8;
    bf16x8 qr[6];
#pragma unroll
    for (int d0 = 0; d0 < 6; ++d0) qr[d0] = *(const bf16x8*)(Qw + d0 * 16);
    float mhat = 0.f, l_reg = 0.f; f32x16 o[2]; o[0] = f32x16{}; o[1] = f32x16{}; f32x16 negm = f32x16{};
    const lds_cptr shm3 = (lds_cptr)shm;
    for (int s = 0; s < nsteps; ++s) {
        asm volatile("s_waitcnt vmcnt(0)" ::: "memory"); __builtin_amdgcn_s_barrier(); asm volatile("" ::: "memory");
        if (s + 1 < nsteps) dma_step(T, krow0 + (s + 1) * 128, h, lds0 + ((s + 1) & 1) * BUFB, wid, lane);
        const int bufo = (s & 1) * BUFB;
        const lds_cptr kp = shm3 + bufo + kh * KSLOT + hi * 1024 + r32 * 16;
        const lds_cptr vp = shm3 + bufo + 2 * KSLOT + kh * VSLOT + ((lane >> 4) & 1) * 32 + (lane & 3) * 8 + (4 * hi + ((lane & 15) >> 2)) * 64;
        f32x16 p0, p1;
#pragma unroll
        for (int d0 = 0; d0 < 6; ++d0) {
            const bf16x8 b0 = *(const LAS bf16x8*)(kp + d0 * 2048), b1 = *(const LAS bf16x8*)(kp + d0 * 2048 + 512);
            if (d0 == 0) { p0 = __builtin_amdgcn_mfma_f32_32x32x16_bf16(b0, qr[0], negm, 0, 0, 0); p1 = __builtin_amdgcn_mfma_f32_32x32x16_bf16(b1, qr[0], negm, 0, 0, 0); }
            else { p0 = __builtin_amdgcn_mfma_f32_32x32x16_bf16(b0, qr[d0], p0, 0, 0, 0); p1 = __builtin_amdgcn_mfma_f32_32x32x16_bf16(b1, qr[d0], p1, 0, 0, 0); } }
        float rm = fmaxf(p0[0], p1[0]);
#pragma unroll
        for (int r = 1; r < 16; ++r) rm = fmaxf(rm, fmaxf(p0[r], p1[r]));
        rm = swapmax(rm);
        bool resc = false;
        if (s == 0 || __any(rm > 8.0f)) {
            const float dl = (s == 0) ? rm : fmaxf(rm, 0.f); mhat += dl;
#pragma unroll
            for (int r = 0; r < 16; ++r) { p0[r] -= dl; p1[r] -= dl; negm[r] = -mhat; }
            if (s != 0) { const float f = __builtin_amdgcn_exp2f(-dl); l_reg *= f; if (hi == 0) wsf[r32] = f; resc = true; }
        }
        float sacc = 0.f;
#pragma unroll
        for (int r = 0; r < 16; ++r) { p0[r] = __builtin_amdgcn_exp2f(p0[r]); p1[r] = __builtin_amdgcn_exp2f(p1[r]); sacc += p0[r] + p1[r]; }
        l_reg += sacc;
        if (resc) { asm volatile("s_waitcnt lgkmcnt(0)" ::: "memory");
#pragma unroll
            for (int d_ = 0; d_ < 2; ++d_)
#pragma unroll
                for (int r = 0; r < 16; ++r) o[d_][r] *= wsf[crow(r, hi)]; }
        u32x4 pw[4];
        pw[0] = (u32x4){cvtpk_s(p0[0], p0[1]), cvtpk_s(p0[2], p0[3]), cvtpk_s(p0[4], p0[5]), cvtpk_s(p0[6], p0[7])};
        pw[1] = (u32x4){cvtpk_s(p0[8], p0[9]), cvtpk_s(p0[10], p0[11]), cvtpk_s(p0[12], p0[13]), cvtpk_s(p0[14], p0[15])};
        pw[2] = (u32x4){cvtpk_s(p1[0], p1[1]), cvtpk_s(p1[2], p1[3]), cvtpk_s(p1[4], p1[5]), cvtpk_s(p1[6], p1[7])};
        pw[3] = (u32x4){cvtpk_s(p1[8], p1[9]), cvtpk_s(p1[10], p1[11]), cvtpk_s(p1[12], p1[13]), cvtpk_s(p1[14], p1[15])};
#pragma unroll
        for (int d0 = 0; d0 < 2; ++d0)
#pragma unroll
            for (int ks = 0; ks < 4; ++ks) {
                const s16x4 lo = vtr(vp + d0 * 4096 + ks * 1024), hh = vtr(vp + d0 * 4096 + ks * 1024 + 512);
                const bf16x8 vf = (bf16x8){lo[0], lo[1], lo[2], lo[3], hh[0], hh[1], hh[2], hh[3]};
                o[d0] = __builtin_amdgcn_mfma_f32_32x32x16_bf16(__builtin_bit_cast(bf16x8, pw[ks]), vf, o[d0], 0, 0, 0); }
    }
    l_reg = swapsum(l_reg);
    float* cm = (float*)(shm + LDS_CM); float* cl = (float*)(shm + LDS_CL);
    if (hi == 0) cm[(kh * 4 + qb) * 32 + r32] = mhat;
    asm volatile("s_waitcnt lgkmcnt(0)" ::: "memory"); __builtin_amdgcn_s_barrier(); asm volatile("" ::: "memory");
    { const float mo = cm[((kh ^ 1) * 4 + qb) * 32 + r32]; const float ms = fmaxf(mhat, mo); const float f = __builtin_amdgcn_exp2f(mhat - ms); l_reg *= f;
      if (hi == 0) wsf[r32] = f; asm volatile("s_waitcnt lgkmcnt(0)" ::: "memory");
#pragma unroll
      for (int d_ = 0; d_ < 2; ++d_)
#pragma unroll
          for (int r = 0; r < 16; ++r) o[d_][r] *= wsf[crow(r, hi)]; }
    float* co = (float*)shm + qb * 2048;
    if (kh == 1) {
#pragma unroll
        for (int d_ = 0; d_ < 2; ++d_)
#pragma unroll
            for (int r = 0; r < 16; ++r) co[(d_ * 16 + r) * 64 + lane] = o[d_][r];
        if (hi == 0) cl[qb * 32 + r32] = l_reg;
    }
    asm volatile("s_waitcnt lgkmcnt(0)" ::: "memory"); __builtin_amdgcn_s_barrier(); asm volatile("" ::: "memory");
    if (kh == 0) {
#pragma unroll
        for (int d_ = 0; d_ < 2; ++d_)
#pragma unroll
            for (int r = 0; r < 16; ++r) o[d_][r] += co[(d_ * 16 + r) * 64 + lane];
        l_reg += cl[qb * 32 + r32];
        if (hi == 0) wsf[32 + r32] = l_reg; asm volatile("s_waitcnt lgkmcnt(0)" ::: "memory");
        float rli[16];
#pragma unroll
        for (int r = 0; r < 16; ++r) rli[r] = __builtin_amdgcn_rcpf(wsf[32 + crow(r, hi)]);
        bf16_t* stg = (bf16_t*)(shm + LDS_OST) + wid * 2048;
#pragma unroll
        for (int r = 0; r < 16; ++r) { const int orow = crow(r, hi);
#pragma unroll
            for (int d0 = 0; d0 < 2; ++d0) stg[orow * 64 + d0 * 32 + r32] = f2bf(o[d0][r] * rli[r]); }
        asm volatile("s_waitcnt lgkmcnt(0)" ::: "memory");
        bf16_t* Ow = T.O + (size_t)(qrow0 + qb * 32) * ACAT_LD + h * 64;
#pragma unroll
        for (int i = 0; i < 4; ++i) { const int row = i * 8 + (lane >> 3), ch = lane & 7; const u32x4 v = *(const u32x4*)(stg + row * 64 + ch * 8); *(u32x4*)(Ow + (size_t)row * ACAT_LD + ch * 8) = v; }
    }
    asm volatile("s_waitcnt lgkmcnt(0)" ::: "memory"); __builtin_amdgcn_s_barrier(); asm volatile("" ::: "memory");
}
}

#define XB_TMO      128
#define XB_XCNT(j)  (256  + 64 * (j))
#define XB_XSUB(j)  (1280 + 64 * (j))
#define XB_XGEN(j)  (2304 + 64 * (j))
#define XB_TOP      3328
#define XB_TOPGEN   3392
#define XCD_BAR_WORDS 3456
#define XB_SPIN_CAP (1u << 18)
__device__ __forceinline__ unsigned xb_ld(unsigned* p)              { return __hip_atomic_load(p, __ATOMIC_RELAXED, __HIP_MEMORY_SCOPE_AGENT); }
__device__ __forceinline__ unsigned xb_add(unsigned* p, unsigned v) { return __hip_atomic_fetch_add(p, v, __ATOMIC_RELAXED, __HIP_MEMORY_SCOPE_AGENT); }
__device__ __forceinline__ unsigned xb_xcc_id() { return (unsigned)__builtin_amdgcn_s_getreg((3 << 11) | 20) & 0xFu; }
#define XB_SPIN(cond, bar) do { unsigned _sp = 0; while (cond) { __builtin_amdgcn_s_sleep(1); \
    if ((++_sp & 255u) == 0u) { if (xb_ld(&(bar)[XB_TMO])) break; if (_sp > XB_SPIN_CAP) { atomicAdd(&(bar)[XB_TMO], 1u); break; } } } } while (0)
struct XcdBarrier { unsigned* bar; unsigned x; volatile LAS unsigned* st; };
__device__ __forceinline__ XcdBarrier xcd_barrier_post(unsigned* bar, volatile LAS unsigned* st) {
    XcdBarrier b; b.bar = bar; b.x = xb_xcc_id(); b.st = st;
    if (threadIdx.x == 0) (void)xb_add(&bar[XB_XCNT(b.x)], 1u);
    return b;
}
__device__ __forceinline__ void xcd_barrier_complete(unsigned* bar, unsigned x, unsigned& nloc, unsigned& nx) {
    const unsigned G = gridDim.x * gridDim.y * gridDim.z;
    unsigned sum, cnt, mine, sp = 0u;
    for (;;) {
        sum = 0u; cnt = 0u; mine = 0u;
#pragma unroll
        for (unsigned j = 0; j < 16; ++j) { const unsigned c = xb_ld(&bar[XB_XCNT(j)]); sum += c; cnt += (c > 0u) ? 1u : 0u; mine = (j == x) ? c : mine; }
        if (sum == G) break;
        __builtin_amdgcn_s_sleep(1);
        if ((++sp & 255u) == 0u) { if (xb_ld(&bar[XB_TMO])) break; if (sp > XB_SPIN_CAP) { atomicAdd(&bar[XB_TMO], 1u); break; } }
    }
    nloc = mine > 0u ? mine : 1u; nx = cnt > 0u ? cnt : 1u;
}
__device__ __forceinline__ void xcd_barrier(const XcdBarrier& b, const int tid) {
    asm volatile("s_waitcnt vmcnt(0)" ::: "memory");
    __syncthreads();
    if (tid == 0) {
        unsigned* bar = b.bar;
        __builtin_amdgcn_s_waitcnt(0);
        unsigned nloc = b.st[0], nx = b.st[1];
        if (nloc == 0u) { xcd_barrier_complete(bar, b.x, nloc, nx); b.st[0] = nloc; b.st[1] = nx; }
        const unsigned old = xb_add(&bar[XB_XSUB(b.x)], 1u);
        const unsigned gen = old / nloc;
        if (old + 1u == (gen + 1u) * nloc) {
            __builtin_amdgcn_fence(__ATOMIC_RELEASE, "agent");
            asm volatile("s_waitcnt vmcnt(0)" ::: "memory");
            const unsigned og = xb_add(&bar[XB_TOP], 1u);
            const unsigned tg = og / nx;
            if (og + 1u == (tg + 1u) * nx) xb_add(&bar[XB_TOPGEN], 1u);
            else XB_SPIN(xb_ld(&bar[XB_TOPGEN]) == tg, bar);
            __builtin_amdgcn_fence(__ATOMIC_ACQUIRE, "agent");
            xb_add(&bar[XB_XGEN(b.x)], 1u);
            asm volatile("s_waitcnt vmcnt(0)" ::: "memory");
        } else {
            XB_SPIN(xb_ld(&bar[XB_XGEN(b.x)]) == gen, bar);
            __builtin_amdgcn_fence(__ATOMIC_ACQUIRE, "agent");
            asm volatile("s_waitcnt vmcnt(0)" ::: "memory");
        }
    }
    __syncthreads();
}

struct Args { const float* in[29]; float* out; unsigned char* ws; int step_lo, step_hi; };
static_assert(sizeof(Args) == 31 * 8 + 8, "Args has no padding");

struct Ctx {
    LAS unsigned char* lds; int tid, lane, wave, G, gw, NGW, bid;
    float* out; unsigned char* ws;
};
__device__ __forceinline__ const float* ldarg(int i) { const char* kp = (const char*)__builtin_amdgcn_kernarg_segment_ptr(); asm volatile("" : "+s"(kp)); return *(const float* const*)(kp + 8 * i); }
#define INP(i) ldarg(i)

__device__ __forceinline__ void transpose_item(const float* W, int N, bf16_t* WT, int ldt, int k0, int n0, int drow0, LAS float* scr, int lane) {
    float v[32];
    const float* wp = W + (size_t)(k0 + (lane >> 5)) * N + n0 + (lane & 31);
#pragma unroll
    for (int i = 0; i < 32; ++i) v[i] = wp[(size_t)(2 * i) * N];
#pragma unroll
    for (int i = 0; i < 32; ++i) scr[(2 * i + (lane >> 5)) * 33 + (lane & 31)] = v[i];
    LDS_WAIT(); asm volatile("" ::: "memory");
    const int c = lane & 7;
#pragma unroll
    for (int j = 0; j < 4; ++j) { const int n = (lane >> 3) + 8 * j; const LAS float* s = scr + (8 * c) * 33 + n;
        u32x4 o; o.x = cvt_pk_bf16(s[0 * 33], s[1 * 33]); o.y = cvt_pk_bf16(s[2 * 33], s[3 * 33]); o.z = cvt_pk_bf16(s[4 * 33], s[5 * 33]); o.w = cvt_pk_bf16(s[6 * 33], s[7 * 33]);
        *(u32x4*)(WT + (size_t)(drow0 + n) * ldt + k0 + 8 * c) = o; }
    LDS_WAIT(); asm volatile("" ::: "memory");
}

__device__ __forceinline__ void prologue(Ctx& F) {
    unsigned char* ws = F.ws;
    LAS float* misc = (LAS float*)(F.lds + MISC_OFF + 1024);
    __syncthreads();
    if (F.tid < 64) { misc[F.tid] = __builtin_amdgcn_cosf((float)F.tid * (1.f / 64.f)); misc[64 + F.tid] = __builtin_amdgcn_sinf((float)F.tid * (1.f / 64.f)); }
    for (int rp_ = 0; rp_ < ((PROBE_PRO & 1) ? 2 : 1); ++rp_) {
    if (F.bid < 192) {
        LAS float* scv = (LAS float*)F.lds;
        LAS float* red = (LAS float*)(F.lds + 16384);
        for (int i = F.tid; i < 3072; i += 512) { const int m = i >> 10, k = i & 1023; const float v = (m == 0) ? INP(5)[k] : INP(4)[(m - 1) * 1024 + k]; scv[i] = v * sigmoidf_(v); }
        __syncthreads();
        const int l = F.bid / 96, c0 = (F.bid % 96) * 64;
        const float* w = INP(6) + (size_t)l * 1024 * 6144 + c0 + F.lane;
        float a0 = 0.f, a1 = 0.f, a2 = 0.f;
        const int kb = F.wave * 128;
#pragma unroll 16
        for (int k = 0; k < 128; ++k) { const float wv = w[(size_t)(kb + k) * 6144]; a0 += scv[kb + k] * wv; a1 += scv[1024 + kb + k] * wv; a2 += scv[2048 + kb + k] * wv; }
        red[(F.wave * 3 + 0) * 64 + F.lane] = a0; red[(F.wave * 3 + 1) * 64 + F.lane] = a1; red[(F.wave * 3 + 2) * 64 + F.lane] = a2;
        __syncthreads();
        if (F.wave < 3) { float s = INP(7)[l * 6144 + c0 + F.lane];
#pragma unroll
            for (int w8 = 0; w8 < 8; ++w8) s += red[(w8 * 3 + F.wave) * 64 + F.lane];
            ((float*)(ws + WS_MOD))[(l * 3 + F.wave) * 6144 + c0 + F.lane] = s; }
        __syncthreads();
    } else __syncthreads();
    }
    LAS float* scr = (LAS float*)(F.lds + F.wave * 16384);
    for (int rp_ = 0; rp_ < ((PROBE_PRO & 4) ? 2 : 1); ++rp_)
    {
        const int pw = F.bid + F.G * F.wave;
        for (int it = pw; it < 1024; it += F.NGW) { const int l = it >> 9, kc = (it & 511) >> 2, g = it & 3, k0 = kc * 8;
            const float* W = INP(10) + (size_t)l * 1024 * IN_COLS; bf16_t* WT = (bf16_t*)(ws + WS_W + (size_t)l * W_LAYER + W_IN);
#pragma unroll
            for (int i = 0; i < 8; ++i) scr[i * 64 + F.lane] = W[(size_t)(k0 + i) * IN_COLS + OFF_FN + g * 64 + F.lane];
            LDS_WAIT(); asm volatile("" ::: "memory");
            float aP[8], aQ[8];
#pragma unroll
            for (int k = 0; k < 8; ++k) { aP[k] = 0.f; aQ[k] = 0.f; }
#pragma unroll 4
            for (int n4 = 0; n4 < 16; ++n4) { float c[4], sn[4];
#pragma unroll
                for (int e = 0; e < 4; ++e) { const int ix = (F.lane * (4 * n4 + e)) & 63; c[e] = misc[ix]; sn[e] = misc[64 + ix]; }
#pragma unroll
                for (int k = 0; k < 8; ++k) { const f32x4 w = *(const LAS f32x4*)(scr + k * 64 + 4 * n4);
                    aP[k] += w.x * c[0] + w.y * c[1] + w.z * c[2] + w.w * c[3]; aQ[k] += w.x * sn[0] + w.y * sn[1] + w.z * sn[2] + w.w * sn[3]; } }
            *(u32x4*)(WT + (size_t)(OFF_FN + g * 64 + F.lane) * 1024 + k0) = (u32x4){cvt_pk_bf16(aP[0] * 0.125f, aP[1] * 0.125f), cvt_pk_bf16(aP[2] * 0.125f, aP[3] * 0.125f), cvt_pk_bf16(aP[4] * 0.125f, aP[5] * 0.125f), cvt_pk_bf16(aP[6] * 0.125f, aP[7] * 0.125f)};
            *(u32x4*)(WT + (size_t)(OFF_GATE + g * 64 + F.lane) * 1024 + k0) = (u32x4){cvt_pk_bf16(aQ[0] * 0.125f, aQ[1] * 0.125f), cvt_pk_bf16(aQ[2] * 0.125f, aQ[3] * 0.125f), cvt_pk_bf16(aQ[4] * 0.125f, aQ[5] * 0.125f), cvt_pk_bf16(aQ[6] * 0.125f, aQ[7] * 0.125f)};
            LDS_WAIT(); asm volatile("" ::: "memory");
        }
    }
    for (int l2_ = 0; l2_ < DEPTH * ((PROBE_PRO & 2) ? 2 : 1); ++l2_) { const int l = l2_ % DEPTH;
        unsigned char* wl = ws + WS_W + (size_t)l * W_LAYER;
      {
        {
            const float* W = INP(10) + (size_t)l * 1024 * IN_COLS; bf16_t* WT = (bf16_t*)(wl + W_IN); constexpr int nblk = IN_COLS / 32;
            for (int it = F.gw; it < 16 * nblk; it += F.NGW) { const int kb = it / nblk, nb = it % nblk, n0 = nb * 32;
                if (n0 >= OFF_FN && n0 < OFF_GATE) continue;
                const int dr = (n0 < OFF_FN) ? n0 : 2560 + (n0 - OFF_GATE);
                transpose_item(W, IN_COLS, WT, 1024, kb * 64, n0, dr, scr, F.lane); }
            for (int it = F.gw; it < 96 * 2; it += F.NGW) { const int r = 2464 + it / 2, h = it & 1; *(u32x4*)(WT + (size_t)r * 1024 + h * 512 + F.lane * 8) = (u32x4){0u, 0u, 0u, 0u}; }
        }
#define TR_SIMPLE(idx, KK, NN, OFF) { const float* W = INP(idx) + (size_t)l * (KK) * (NN); bf16_t* WT = (bf16_t*)(wl + (OFF)); constexpr int nblk = (NN) / 32; \
            for (int it = F.gw; it < ((KK) / 64) * nblk; it += F.NGW) { const int kb = it / nblk, nb = it % nblk; transpose_item(W, (NN), WT, (KK), kb * 64, nb * 32, nb * 32, scr, F.lane); } }
        TR_SIMPLE(12, 384, 768, W_QB)
        TR_SIMPLE(14, 256, 1024, W_KVB)
#define TR_CAT(idx, KK, KOFF) { const float* W = INP(idx) + (size_t)l * (KK) * 1024; bf16_t* WT = (bf16_t*)(wl + W_CAT) + (KOFF); \
            for (int it = F.gw; it < ((KK) / 64) * 32; it += F.NGW) { const int kb = it / 32, nb = it % 32; transpose_item(W, 1024, WT, 1280, kb * 64, nb * 32, nb * 32, scr, F.lane); } }
        TR_CAT(15, 512, 0)
        TR_CAT(20, 256, 512)
        TR_CAT(22, 256, 768)
        TR_CAT(23, 256, 1024)
#undef TR_CAT
        TR_SIMPLE(24, 1024, 1024, W_OUT)
        TR_SIMPLE(27, 2816, 1024, W_DN)
#undef TR_SIMPLE
        for (int gu = 0; gu < 2; ++gu) {
            const float* W = (gu ? INP(26) : INP(25)) + (size_t)l * 1024 * FF; bf16_t* WT = (bf16_t*)(wl + W_GU); constexpr int nblk = FF / 32;
            for (int it = F.gw; it < 16 * nblk; it += F.NGW) { const int kb = it / nblk, nb = it % nblk, n0 = nb * 32;
                transpose_item(W, FF, WT, 1024, kb * 64, n0, (n0 / 128) * 256 + gu * 128 + (n0 % 128), scr, F.lane); }
        }
      }
    }
    for (int rp_ = 0; rp_ < ((PROBE_PRO & 8) ? 2 : 1); ++rp_) {
        bf16_t* TL = (bf16_t*)(ws + WS_DFTL); const int gt = F.gw * 64 + F.lane, NT = F.NGW * 64;
        for (int it = gt; it < 2048 * 512; it += NT) { const int k = it >> 9, c8 = (it & 511) * 8; float v[8];
#pragma unroll
            for (int e = 0; e < 8; ++e) { const int c = c8 + e, t = c & 2047; const float fr = (float)((k * t) & 2047) * (1.f / 2048.f);
                v[e] = ((c < 2048) ? __builtin_amdgcn_cosf(fr) : -__builtin_amdgcn_sinf(fr)) * 0.022097086912079608f; }
            *(u32x4*)(TL + (size_t)k * 4096 + c8) = (u32x4){cvt_pk_bf16(v[0], v[1]), cvt_pk_bf16(v[2], v[3]), cvt_pk_bf16(v[4], v[5]), cvt_pk_bf16(v[6], v[7])}; }
        bf16_t* TC = (bf16_t*)(ws + WS_DFTC);
        for (int it = gt; it < 256 * 64; it += NT) { const int k = it >> 6, c8 = (it & 63) * 8; float v[8];
#pragma unroll
            for (int e = 0; e < 8; ++e) { const int c = c8 + e, t = c & 255; const float fr = (float)((k * t) & 255) * (1.f / 256.f);
                v[e] = ((c < 256) ? __builtin_amdgcn_cosf(fr) : -__builtin_amdgcn_sinf(fr)) * 0.0625f; }
            *(u32x4*)(TC + (size_t)k * 512 + c8) = (u32x4){cvt_pk_bf16(v[0], v[1]), cvt_pk_bf16(v[2], v[3]), cvt_pk_bf16(v[4], v[5]), cvt_pk_bf16(v[6], v[7])}; }
        if (F.gw == F.NGW - 1) { float* R = (float*)(ws + WS_ROPE);
            for (int i = F.lane; i < 512; i += 64) { const int pos = i >> 3, f = i & 7; const float inv = __builtin_amdgcn_exp2f(-(float)f * 1.6609640474436813f);
                const float rev = ((float)pos * inv) * 0.15915494309189535f; R[2 * i] = __builtin_amdgcn_cosf(rev); R[2 * i + 1] = __builtin_amdgcn_sinf(rev); } }
    }
}

__device__ __forceinline__ int mod_of_row(int r) { return r < NCTX ? 0 : 1 + ((r - NCTX) >> 11); }
__device__ __forceinline__ int kvrow_of_row(int r) { return r < NCTX ? r : NCTX + ((r - NCTX) >> 11) * 2304 + 256 + ((r - NCTX) & 2047); }

__device__ __forceinline__ void phase_pre(Ctx& F) {
    unsigned char* ws = F.ws; const int lane = F.lane;
    {
        const float* mod = (const float*)(ws + WS_MOD); const float* g = INP(8); bf16_t* XN = (bf16_t*)(ws + WS_XN); float* SS = (float*)(ws + WS_SUMSQ); const float* x0 = INP(0); const float* x1 = INP(1);
        for (int r = F.gw; r < MROWS; r += F.NGW) { const float* sc = mod + mod_of_row(r) * 6144 + 1024;
            const f32x4* xr = (const f32x4*)(r < NCTX ? x0 + (size_t)r * D : x1 + (size_t)(r - NCTX) * D) + lane; f32x4 v[4]; float sq = 0.f;
#pragma unroll
            for (int j = 0; j < 4; ++j) { v[j] = xr[64 * j]; sq += (v[j].x * v[j].x + v[j].y * v[j].y) + (v[j].z * v[j].z + v[j].w * v[j].w); ((f32x4*)(F.out + (size_t)r * D) + lane)[64 * j] = v[j]; }
            sq = wave_sum(sq); if (lane == 0) SS[r] = sq;
#pragma unroll
            for (int j = 0; j < 4; ++j) { const int c = 4 * (64 * j + lane); const f32x4 y = v[j] * *(const f32x4*)(g + c) * (*(const f32x4*)(sc + c) + 1.f);
                *(u32x2*)(XN + (size_t)r * D + c) = (u32x2){cvt_pk_bf16(y.x, y.y), cvt_pk_bf16(y.z, y.w)}; } }
    }
    {
        float* B = (float*)(ws + WS_BIAS); const float* mod = (const float*)(ws + WS_MOD);
        constexpr int NCH = (WIN_N + 5632) / 16;
        for (int it = F.gw; it < 2 * NCH; it += F.NGW) { const int l = it / NCH, r = (it % NCH) * 16; const int which = r >= WIN_N, n0 = which ? r - WIN_N : r;
            float sh[3][16];
#pragma unroll
            for (int m = 0; m < 3; ++m) { const float* sp = mod + (l * 3 + m) * 6144 + (which ? 3072 : 0) + 16 * lane;
#pragma unroll
                for (int q = 0; q < 4; ++q) { const f32x4 sv = *(const f32x4*)(sp + 4 * q); sh[m][4 * q] = sv.x; sh[m][4 * q + 1] = sv.y; sh[m][4 * q + 2] = sv.z; sh[m][4 * q + 3] = sv.w; } }
            const bf16_t* wbase = (const bf16_t*)(ws + WS_W + (size_t)l * W_LAYER + (which ? W_GU : W_IN)) + (size_t)n0 * 1024 + 16 * lane;
#pragma unroll
            for (int h = 0; h < 2; ++h) { u32x4 w0[8], w1[8];
#pragma unroll
                for (int j = 0; j < 8; ++j) { w0[j] = *(const u32x4*)(wbase + (size_t)(8 * h + j) * 1024); w1[j] = *(const u32x4*)(wbase + (size_t)(8 * h + j) * 1024 + 8); }
#pragma unroll
                for (int j = 0; j < 8; ++j) {
                    const float wf[16] = {bf_lo(w0[j].x), bf_hi(w0[j].x), bf_lo(w0[j].y), bf_hi(w0[j].y), bf_lo(w0[j].z), bf_hi(w0[j].z), bf_lo(w0[j].w), bf_hi(w0[j].w), bf_lo(w1[j].x), bf_hi(w1[j].x), bf_lo(w1[j].y), bf_hi(w1[j].y), bf_lo(w1[j].z), bf_hi(w1[j].z), bf_lo(w1[j].w), bf_hi(w1[j].w)};
                    float a3[3];
#pragma unroll
                    for (int m = 0; m < 3; ++m) { float a = 0.f;
#pragma unroll
                        for (int e = 0; e < 16; ++e) a += sh[m][e] * wf[e];
                        a3[m] = wave_sum(a); }
                    if (lane < 3) B[((l * 2 + which) * 3 + lane) * BIAS_LD + n0 + 8 * h + j] = (lane == 0) ? a3[0] : (lane == 1) ? a3[1] : a3[2]; } }
        }
    }
}


__device__ __forceinline__ void phase_prep(Ctx& F, int l) {
    unsigned char* ws = F.ws; const int lane = F.lane;
    const bf16_t* PROJ = (const bf16_t*)(ws + WS_PROJ);
    bf16_t* QN = (bf16_t*)(ws + WS_XN + XN_QN); bf16_t* CKV = (bf16_t*)(ws + WS_XN + XN_CKV); bf16_t* KR = (bf16_t*)(ws + WS_XN + XN_KR);
    bf16_t* ACAT = (bf16_t*)(ws + WS_ACAT);
    float* out_ckv = F.out + (size_t)MROWS * D; float* out_kr = out_ckv + (size_t)NBC * DEPTH * SEQ * KVL;
    const float* rope = (const float*)(ws + WS_ROPE);
    {
        LAS float* ut = (LAS float*)F.lds;
        LAS float* wl = (LAS float*)(F.lds + 65536);
        const float* wdw = INP(16) + l * 31 * 256; const float* bdw = INP(17) + l * 256; const float* gln = INP(18) + l * 256; const float* bln = INP(19) + l * 256;
        __syncthreads();
        for (int i = F.tid; i < 31 * 256; i += 512) wl[i] = wdw[i];
        for (int item = F.bid; item < 256; item += F.G) {
            const int r0 = item * 32; const int s0 = r0 < NCTX ? (r0 & ~255) : NCTX + ((r0 - NCTX) & ~2047); const int s1 = s0 + (r0 < NCTX ? 256 : 2048);
            __syncthreads();
            for (int idx = F.tid; idx < 62 * 128; idx += 512) { const int rr = idx >> 7, cp = idx & 127; const int row = r0 - 15 + rr; float u0 = 0.f, u1 = 0.f;
                if (row >= s0 && row < s1) { const unsigned a = *(const unsigned*)(PROJ + (size_t)row * PROJ_LD + OFF_CONF + 2 * cp), b = *(const unsigned*)(PROJ + (size_t)row * PROJ_LD + OFF_CONF + 256 + 2 * cp);
                    u0 = bf_lo(a) * sigmoidf_(bf_lo(b)); u1 = bf_hi(a) * sigmoidf_(bf_hi(b)); }
                ut[rr * 256 + 2 * cp] = u0; ut[rr * 256 + 2 * cp + 1] = u1; }
            __syncthreads();
            float acc[4][4];
#pragma unroll
            for (int q = 0; q < 4; ++q) { const float b = bdw[lane + 64 * q];
#pragma unroll
                for (int ri = 0; ri < 4; ++ri) acc[ri][q] = b; }
            for (int j = 0; j < 31; ++j) {
#pragma unroll
                for (int q = 0; q < 4; ++q) { const float w = wl[j * 256 + lane + 64 * q];
#pragma unroll
                    for (int ri = 0; ri < 4; ++ri) acc[ri][q] += ut[(4 * F.wave + ri + j) * 256 + lane + 64 * q] * w; } }
#pragma unroll
            for (int ri = 0; ri < 4; ++ri) { const float mean = wave_sum(acc[ri][0] + acc[ri][1] + acc[ri][2] + acc[ri][3]) * (1.f / 256.f); float q2 = 0.f;
#pragma unroll
                for (int q = 0; q < 4; ++q) { const float d = acc[ri][q] - mean; q2 += d * d; }
                const float rstd = 1.f / sqrtf(wave_sum(q2) * (1.f / 256.f) + EPS);
#pragma unroll
                for (int q = 0; q < 4; ++q) { const int c = lane + 64 * q; const float y = (acc[ri][q] - mean) * rstd * gln[c] + bln[c]; ACAT[(size_t)(r0 + 4 * F.wave + ri) * ACAT_LD + AC_UC + c] = f2bf(y * sigmoidf_(y)); } }
        }
        __syncthreads();
    }
    const float* gqa = INP(11) + l * QL; const float* gkva = INP(13) + l * KVL; const float* wc3 = INP(21) + l * 3 * 256;
    for (int r = F.gw; r < MROWS; r += F.NGW) {
        const bf16_t* pr = PROJ + (size_t)r * PROJ_LD; const int mr = kvrow_of_row(r);
        {
            float v[6]; float s = 0.f;
#pragma unroll
            for (int j = 0; j < 3; ++j) { const unsigned u = *(const unsigned*)(pr + 2 * lane + 128 * j); v[2 * j] = bf_lo(u); v[2 * j + 1] = bf_hi(u); s += v[2 * j] * v[2 * j] + v[2 * j + 1] * v[2 * j + 1]; }
            const float rstd = 1.f / sqrtf(wave_sum(s) * (1.f / QL) + EPS);
#pragma unroll
            for (int j = 0; j < 3; ++j) { const int c = 2 * lane + 128 * j; *(unsigned*)(QN + (size_t)r * QL + c) = cvt_pk_bf16(v[2 * j] * rstd * gqa[c], v[2 * j + 1] * rstd * gqa[c + 1]); }
        }
        {
            const u32x2 u = *(const u32x2*)(pr + OFF_KVA + 4 * lane); f32x4 v = {bf_lo(u.x), bf_hi(u.x), bf_lo(u.y), bf_hi(u.y)};
            const float rstd = 1.f / sqrtf(wave_sum((v.x * v.x + v.y * v.y) + (v.z * v.z + v.w * v.w)) * (1.f / KVL) + EPS);
            v = v * rstd * *(const f32x4*)(gkva + 4 * lane);
            *(u32x2*)(CKV + (size_t)mr * KVL + 4 * lane) = (u32x2){cvt_pk_bf16(v.x, v.y), cvt_pk_bf16(v.z, v.w)};
            if (r < NCTX) { const int b = r >> 8, t = r & 255; *(f32x4*)(out_ckv + ((size_t)(b * DEPTH + l) * SEQ + t) * KVL + 4 * lane) = v; }
        }
        {
            const float v = bf1(pr[OFF_KR + (lane & 31)]);
            if (r < NCTX) { if (lane < 32) { const int b = r >> 8, t = r & 255; out_kr[((size_t)(b * DEPTH + l) * SEQ + t) * QKR + lane] = v; KR[(size_t)mr * QKR + lane] = f2bf(v); } }
            else { const int t = (r - NCTX) & 2047, j = lane & 31; const int pos = (j & 16) ? (t & 63) : (t >> 6); const float c = rope[(pos * 8 + (j & 7)) * 2], s = rope[(pos * 8 + (j & 7)) * 2 + 1];
                const float p = __shfl_xor(v, 8); const float o = (j & 8) ? (v * c + p * s) : (v * c - p * s);
                if (lane < 32) KR[(size_t)mr * QKR + lane] = f2bf(o); }
        }
        {
            const int s0 = r < NCTX ? (r & ~255) : NCTX + ((r - NCTX) & ~2047); const int s1 = s0 + (r < NCTX ? 256 : 2048);
            f32x4 a = {0.f, 0.f, 0.f, 0.f};
#pragma unroll
            for (int d = 0; d < 3; ++d) { const int row = r + d - 1;
                if (row >= s0 && row < s1) { const bf16_t* q = PROJ + (size_t)row * PROJ_LD + OFF_SC; const u32x2 gc = *(const u32x2*)(q + 256 + 4 * lane), xs = *(const u32x2*)(q + 512 + 4 * lane);
                    const f32x4 w = *(const f32x4*)(wc3 + d * 256 + 4 * lane);
                    a.x += w.x * bf_lo(gc.x) * bf_lo(xs.x); a.y += w.y * bf_hi(gc.x) * bf_hi(xs.x); a.z += w.z * bf_lo(gc.y) * bf_lo(xs.y); a.w += w.w * bf_hi(gc.y) * bf_hi(xs.y); } }
            const u32x2 gb = *(const u32x2*)(pr + OFF_SC + 4 * lane);
            *(u32x2*)(ACAT + (size_t)r * ACAT_LD + AC_SC + 4 * lane) = (u32x2){cvt_pk_bf16(a.x * bf_lo(gb.x), a.y * bf_hi(gb.x)), cvt_pk_bf16(a.z * bf_lo(gb.y), a.w * bf_hi(gb.y))};
        }
    }
    const float* cckv = INP(2); const float* ckr = INP(3);
    for (int i = F.gw; i < NBL * PAST; i += F.NGW) { const int b = i >> 8, p = i & 255; const int mr = NCTX + b * 2304 + p;
        const f32x4 v = *(const f32x4*)(cckv + ((size_t)(b * DEPTH + l) * PAST + p) * KVL + 4 * lane);
        *(u32x2*)(CKV + (size_t)mr * KVL + 4 * lane) = (u32x2){cvt_pk_bf16(v.x, v.y), cvt_pk_bf16(v.z, v.w)};
        if (lane < 32) KR[(size_t)mr * QKR + lane] = f2bf(ckr[((size_t)(b * DEPTH + l) * PAST + p) * QKR + lane]); }
    {
        LAS bf16_t* tl = (LAS bf16_t*)(F.lds + F.wave * 16384);
        bf16_t* PQL = (bf16_t*)(ws + WS_PQL); bf16_t* PQC = (bf16_t*)(ws + WS_PQC);
        for (int it = F.gw; it < 128 * 8; it += F.NGW) { const int rc = it >> 3, part = (it >> 2) & 1, cq = it & 3;
            const int col0 = (part ? OFF_GATE : OFF_FN) + cq * 64;
#pragma unroll 4
            for (int i = 0; i < 32; ++i) { const int t = 2 * i + (lane >> 5), c2 = lane & 31; const unsigned u = *(const unsigned*)(PROJ + (size_t)(rc * 64 + t) * PROJ_LD + col0 + 2 * c2);
                tl[(2 * c2) * 72 + t] = (bf16_t)(u & 0xffffu); tl[(2 * c2 + 1) * 72 + t] = (bf16_t)(u >> 16); }
            LDS_WAIT(); asm volatile("" ::: "memory");
            bf16_t* dst; int ldd;
            if (rc < 64) { const int b = rc >> 2, t0 = (rc & 3) * 64; dst = PQC + ((size_t)b * 256 + cq * 64) * 512 + part * 256 + t0; ldd = 512; }
            else { const int b = (rc - 64) >> 5, t0 = ((rc - 64) & 31) * 64; dst = PQL + ((size_t)b * 256 + cq * 64) * 4096 + part * 2048 + t0; ldd = 4096; }
#pragma unroll
            for (int i = 0; i < 8; ++i) { const int ch = 8 * i + (lane >> 3), t8 = (lane & 7) * 8; const u32x4 v = *(const LAS u32x4*)(tl + ch * 72 + t8); *(u32x4*)(dst + (size_t)ch * ldd + t8) = v; }
            LDS_WAIT(); asm volatile("" ::: "memory");
        }
    }
}

__device__ __forceinline__ void phase_attn(Ctx& F) {
    unsigned char* ws = F.ws;
    {
        const bf16_t* P = (const bf16_t*)(ws + WS_DFTP); bf16_t* Fo = (bf16_t*)(ws + WS_ACAT) + (size_t)NCTX * ACAT_LD + AC_F;
        const int gt = F.gw * 64 + F.lane, NT = F.NGW * 64;
        for (int it = gt; it < NLAT * 32; it += NT) { const int row = it >> 5, c8 = (it & 31) * 8; const int b = row >> 11, k = row & 2047; float sv[8] = {0.f, 0.f, 0.f, 0.f, 0.f, 0.f, 0.f, 0.f};
#pragma unroll
            for (int ks = 0; ks < 8; ++ks) { const u32x4 p = *(const u32x4*)(P + ((size_t)(b * 8 + ks) * 2048 + k) * 256 + c8);
                sv[0] += bf_lo(p.x); sv[1] += bf_hi(p.x); sv[2] += bf_lo(p.y); sv[3] += bf_hi(p.y); sv[4] += bf_lo(p.z); sv[5] += bf_hi(p.z); sv[6] += bf_lo(p.w); sv[7] += bf_hi(p.w); }
            *(u32x4*)(Fo + (size_t)row * ACAT_LD + c8) = (u32x4){cvt_pk_bf16(sv[0], sv[1]), cvt_pk_bf16(sv[2], sv[3]), cvt_pk_bf16(sv[4], sv[5]), cvt_pk_bf16(sv[6], sv[7])}; }
    }
    attn::Tensors T{(const bf16_t*)(ws + WS_PROJ + PJ_Q), (const bf16_t*)(ws + WS_PROJ + PJ_KV), (const bf16_t*)(ws + WS_XN + XN_KR), (bf16_t*)(ws + WS_ACAT)};
    for (int u = F.bid; u < 512; u += F.G) {
        if (u < 256) { const int b = u >> 7, h = (u >> 4) & 7, qb = u & 15;
            attn::unit(T, NCTX + b * 2048 + qb * 128, NCTX + b * 2304, 18, h, (char*)F.lds, F.tid); }
        else { const int v = u - 256; const int b = v >> 4, h = (v >> 1) & 7, qb = v & 1;
            attn::unit(T, b * 256 + qb * 128, b * 256, 2, h, (char*)F.lds, F.tid); }
    }
}

__device__ __forceinline__ void phase_final(Ctx& F) {
    const float* g = INP(28);
    for (int r = F.gw; r < MROWS; r += F.NGW) { f32x4* xr = (f32x4*)(F.out + (size_t)r * D) + F.lane; f32x4 v[4]; float s = 0.f;
#pragma unroll
        for (int j = 0; j < 4; ++j) { v[j] = xr[64 * j]; s += (v[j].x * v[j].x + v[j].y * v[j].y) + (v[j].z * v[j].z + v[j].w * v[j].w); }
        const float rstd = 1.f / sqrtf(wave_sum(s) * (1.f / D) + EPS);
#pragma unroll
        for (int j = 0; j < 4; ++j) xr[64 * j] = v[j] * rstd * *(const f32x4*)(g + 4 * (64 * j + F.lane)); }
}

constexpr int STEPS_PER_LAYER = 8, N_STEPS = 3 + DEPTH * STEPS_PER_LAYER;
__host__ __device__ constexpr bool barrier_after(int s) { return s < N_STEPS - 1; }
__host__ __device__ constexpr int probe_key(int step) { return step == 0 ? 16 : step == 1 ? 18 : step == N_STEPS - 1 ? 17 : (step - 2) % STEPS_PER_LAYER; }

__global__ void __launch_bounds__(512, 2) mk_fwd(Args args) {
    extern __shared__ __attribute__((aligned(16))) unsigned char lds_raw[];
    volatile LAS unsigned* MISC = (volatile LAS unsigned*)((LAS unsigned char*)lds_raw + MISC_OFF);
    if (threadIdx.x < 64) MISC[threadIdx.x] = 0u;
    __syncthreads();
    XcdBarrier bar; bar.bar = (unsigned*)(args.ws + WS_CTL) + 1024; bar.x = 0; bar.st = nullptr;
    if (MK_N_LAUNCHES == 1) bar = xcd_barrier_post((unsigned*)(args.ws + WS_CTL) + 1024, MISC + 8);
    unsigned long long tacc = 0;
    const int wave0 = __builtin_amdgcn_readfirstlane(threadIdx.x >> 6);
    for (int step = args.step_lo; step < args.step_hi; ++step) {
        int btid; { int w0 = wave0; unsigned z = 0u; asm volatile("" : "+s"(w0), "+s"(z)); btid = w0 * 64 + (int)__builtin_amdgcn_mbcnt_hi(~0u, __builtin_amdgcn_mbcnt_lo(~0u, z)); }
        unsigned long long t0_ = 0; if (PROBE_TSTEP >= 0) t0_ = __builtin_amdgcn_s_memrealtime();
        const int kprobe = probe_key(step);
        const int nrep = ((PROBE_MASK >> kprobe) & 1) ? 2 : 1;
      for (int rep = 0; rep < nrep; ++rep) {
        unsigned char* ws = args.ws; float* outp = args.out; int tid_; { int w0 = wave0; unsigned z = 0u; asm volatile("" : "+s"(w0), "+s"(z)); tid_ = w0 * 64 + (int)__builtin_amdgcn_mbcnt_hi(~0u, __builtin_amdgcn_mbcnt_lo(~0u, z)); } int bid_ = blockIdx.x;
        asm volatile("" : "+s"(ws), "+s"(outp), "+v"(tid_), "+s"(bid_));
        Ctx F; F.lds = (LAS unsigned char*)lds_raw; F.tid = tid_; F.lane = F.tid & 63; F.wave = __builtin_amdgcn_readfirstlane(F.tid >> 6);
        F.G = gridDim.x; F.gw = bid_ * 8 + F.wave; F.NGW = F.G * 8; F.out = outp; F.ws = ws; F.bid = bid_;
        int ngemm = 0;
        if (step == 0) prologue(F);
        else if (step == 1) phase_pre(F);
        else if (step == N_STEPS - 1) phase_final(F);
        else {
            const int l = (step - 2) / STEPS_PER_LAYER, k = (step - 2) % STEPS_PER_LAYER;
            unsigned char* wl = ws + WS_W + (size_t)l * W_LAYER;
            const float* modl = (const float*)(ws + WS_MOD) + l * 3 * 6144; (void)modl;
            if (k == 1) phase_prep(F, l); else if (k == 3) phase_attn(F); else ngemm = (k == 2) ? 2 : 1;
            for (int r = 0; r < ngemm; ++r) {
                { unsigned char* w2 = F.ws; float* o2 = F.out; asm volatile("" : "+s"(w2), "+s"(o2)); ws = w2; F.out = o2; wl = ws + WS_W + (size_t)l * W_LAYER; modl = (const float*)(ws + WS_MOD) + l * 3 * 6144; }
                pg8::Job J{}; J.nZ = 1; J.a_lo = J.a_hi = J.b_lo = J.b_hi = 0; J.zso = 0; J.aux = 0; J.ldc = 0; int single = -1;
                if (k == 0) { J.p2 = ws + WS_SUMSQ + (size_t)(2 * l) * MROWS * 4; J.p3 = ws + WS_BIAS + (size_t)(l * 2) * 3 * BIAS_LD * 4; J.A = (const char*)(ws + WS_XN); J.Bt = (const char*)(wl + W_IN); J.lda = 1024; J.ldb = 1024; J.K = 1024; J.nM = 32; J.nN = 26; J.kind = pg8::EK_PROJ; J.o0 = ws + WS_PROJ; J.o1 = ws + WS_GATES; }
                else if (k == 2) {
                    const int L = F.bid + r * F.G; if (L >= 376) continue;
                    if (L < 128) { single = L; J.A = (const char*)(ws + WS_DFTL); J.Bt = (const char*)(ws + WS_PQL); J.lda = 4096; J.ldb = 4096; J.K = 512; J.nM = 8; J.nN = 1; J.nZ = 16; J.kind = pg8::EK_BF16;
                        J.a_lo = 1024; J.b_lo = 1024; J.b_hi = (long)256 * 4096 * 2; J.o0 = ws + WS_DFTP; J.ldc = 256; J.zso = (long)2048 * 256; }
                    else if (L < 144) { single = L - 128; J.A = (const char*)(ws + WS_DFTC); J.Bt = (const char*)(ws + WS_PQC); J.lda = 512; J.ldb = 512; J.K = 512; J.nM = 1; J.nN = 1; J.nZ = 16; J.kind = pg8::EK_BF16;
                        J.b_lo = (long)256 * 512 * 2; J.b_hi = (long)8 * 256 * 512 * 2; J.o0 = ws + WS_ACAT + AC_F * 2; J.ldc = ACAT_LD; J.zso = (long)256 * ACAT_LD; }
                    else if (L < 240) { single = L - 144; J.A = (const char*)(ws + WS_XN + XN_QN); J.Bt = (const char*)(wl + W_QB); J.lda = 384; J.ldb = 384; J.K = 384; J.nM = 32; J.nN = 3; J.kind = pg8::EK_Q;
                        J.o0 = ws + WS_PROJ + PJ_Q; J.p0 = ws + WS_ROPE; }
                    else { single = L - 240; J.A = (const char*)(ws + WS_XN + XN_CKV); J.Bt = (const char*)(wl + W_KVB); J.lda = 256; J.ldb = 256; J.K = 256; J.nM = 34; J.nN = 4; J.kind = pg8::EK_BF16;
                        J.o0 = ws + WS_PROJ + PJ_KV; J.ldc = 1024; }
                }
                else if (k == 4) { J.A = (const char*)(ws + WS_ACAT); J.Bt = (const char*)(wl + W_CAT); J.lda = 1280; J.ldb = 1280; J.K = 1280; J.nM = 64; J.nN = 4; J.hm = 1; J.kind = pg8::EK_MERGE; J.o0 = ws + WS_PROJ + PJ_Q; J.p0 = ws + WS_GATES; }
                else if (k == 5) { J.o1 = ws + WS_XN; J.o2 = ws + WS_SUMSQ + (size_t)(2 * l + 1) * MROWS * 4; J.p2 = INP(9) + l * D; J.p3 = modl + 4096; J.A = (const char*)(ws + WS_PROJ + PJ_Q); J.Bt = (const char*)(wl + W_OUT); J.lda = 1024; J.ldb = 1024; J.K = 1024; J.nM = 64; J.nN = 4; J.hm = 1; J.kind = pg8::EK_RESID; J.o0 = F.out; J.p1 = F.out; J.p0 = modl; J.aux = 2048; }
                else if (k == 6) { J.p2 = ws + WS_SUMSQ + (size_t)(2 * l + 1) * MROWS * 4; J.p3 = ws + WS_BIAS + (size_t)(l * 2 + 1) * 3 * BIAS_LD * 4; J.A = (const char*)(ws + WS_XN); J.Bt = (const char*)(wl + W_GU); J.lda = 1024; J.ldb = 1024; J.K = 1024; J.nM = 32; J.nN = 22; J.kind = pg8::EK_SWIGLU; J.o0 = ws + WS_GATES; }
                else { if (l + 1 < DEPTH) { J.o1 = ws + WS_XN; J.o2 = ws + WS_SUMSQ + (size_t)(2 * l + 2) * MROWS * 4; J.p2 = INP(8) + (l + 1) * D; J.p3 = modl + 3 * 6144 + 1024; } J.A = (const char*)(ws + WS_GATES); J.Bt = (const char*)(wl + W_DN); J.lda = FF; J.ldb = FF; J.K = FF; J.nM = 64; J.nN = 4; J.hm = 1; J.kind = pg8::EK_RESID; J.o0 = F.out; J.p1 = F.out; J.p0 = modl; J.aux = 5120; }
                if (PROBE_MASK != 0 && rep + 1 < nrep && J.kind == pg8::EK_RESID) J.o0 = ws + WS_ACAT;
                pg8::Order S; if (single >= 0) S.init_single(J, single); else S.init(J, F.G, F.bid);
                if (J.hm) pg8::gemm_phase_hm(F.lds, J, S, F.tid); else pg8::gemm_phase(F.lds, J, S, F.tid);
            }
        }
      }
        if (step + 1 < args.step_hi && barrier_after(step)) { xcd_barrier(bar, btid); if ((PROBE_MASK >> 18) & 1) xcd_barrier(bar, btid); }
        if (PROBE_TSTEP >= 0) { const int kp = probe_key(step); if (kp == PROBE_TSTEP) tacc += __builtin_amdgcn_s_memrealtime() - t0_; }
    }
    if (PROBE_TSTEP >= 0 && blockIdx.x == 0 && wave0 == 0 && __builtin_amdgcn_mbcnt_lo(~0u, 0u) == 0) { const unsigned long long te = __builtin_amdgcn_s_memrealtime(); while (__builtin_amdgcn_s_memrealtime() - te < 8ull * tacc) __builtin_amdgcn_s_sleep(8); }
}

extern "C" void kernel_launch(void* const* d_in, const int* in_sizes, int n_in, void* d_out, int out_size, void* d_ws, size_t ws_size, hipStream_t stream) {
    static int grid = 0;
    if (grid == 0) {
        if (n_in != 29 || ws_size < WS_END) { fprintf(stderr, "kernel_launch: expected 29 inputs and >= %zu bytes of workspace; got %d, %zu\n", (size_t)WS_END, n_in, ws_size); grid = -1; return; }
        int dev = 0, cus = 0, per_cu = 0;
        if (hipGetDevice(&dev) != hipSuccess || hipDeviceGetAttribute(&cus, hipDeviceAttributeMultiprocessorCount, dev) != hipSuccess) { grid = -1; return; }
        if (hipFuncSetAttribute((const void*)mk_fwd, hipFuncAttributeMaxDynamicSharedMemorySize, LDS_BYTES) != hipSuccess) { fprintf(stderr, "kernel_launch: hipFuncSetAttribute failed\n"); grid = -1; return; }
        if (hipOccupancyMaxActiveBlocksPerMultiprocessor(&per_cu, (const void*)mk_fwd, 512, LDS_BYTES) != hipSuccess || per_cu < 1) fprintf(stderr, "kernel_launch: occupancy query reports %d\n", per_cu);
        (void)hipGetLastError();
        grid = cus;
    }
    if (grid < 0) return;
    (void)hipMemsetAsync((char*)d_ws + WS_CTL, 0, CTL_ZERO_BYTES, stream);
    Args a{};
    for (int i = 0; i < 29; ++i) a.in[i] = (const float*)d_in[i];
    a.out = (float*)d_out; a.ws = (unsigned char*)d_ws;
    if (MK_N_LAUNCHES == 1) { a.step_lo = 0; a.step_hi = N_STEPS; hipLaunchKernelGGL(mk_fwd, dim3(grid), dim3(512), LDS_BYTES, stream, a); }
    else {
        int lo = 0;
        for (int s = 0; s < N_STEPS; ++s) if (barrier_after(s) || s == N_STEPS - 1) { a.step_lo = lo; a.step_hi = s + 1; hipLaunchKernelGGL(mk_fwd, dim3(grid), dim3(512), LDS_BYTES, stream, a); lo = s + 1; }
    }
}
```

```cpp
#include <hip/hip_runtime.h>
#include <hip/hip_bf16.h>
#include <cstdio>
#include <cstdint>

#ifndef MK_N_LAUNCHES
#define MK_N_LAUNCHES 1
#endif
#ifndef PROBE_TSTEP
#define PROBE_TSTEP -1
#endif
#ifndef PROBE_PRO
#define PROBE_PRO 0
#endif
#ifndef PROBE_MASK
#define PROBE_MASK 0
#endif

#define LAS __attribute__((address_space(3)))
#define GAS __attribute__((address_space(1)))
typedef unsigned short bf16_t;
typedef short bf16x8 __attribute__((ext_vector_type(8)));
typedef short s16x4 __attribute__((ext_vector_type(4)));
typedef float f32x4 __attribute__((ext_vector_type(4)));
typedef float f32x2 __attribute__((ext_vector_type(2)));
typedef float f32x16 __attribute__((ext_vector_type(16)));
typedef unsigned u32x4 __attribute__((ext_vector_type(4)));
typedef unsigned u32x2 __attribute__((ext_vector_type(2)));

constexpr int D = 1024, NCTX = 4096, NLAT = 4096, MROWS = 8192, DEPTH = 2;
constexpr int SEQ = 256, DEC_SEQ = 2048, PAST = 256, NBC = 16, NBL = 2;
constexpr int NH = 8, QKN = 64, QKR = 32, VH = 64, QL = 384, KVL = 256;
constexpr int IN_COLS = 6304, FF = 2816;
constexpr int OFF_KVA = 384, OFF_KR = 640, OFF_CONF = 672, OFF_SC = 1184, OFF_FN = 1952, OFF_GATE = 2208;
constexpr int PROJ_LD = 2464;
constexpr int WIN_N = 6656;
constexpr int KVROWS = 8704;
constexpr float EPS = 1e-6f;
constexpr float QSCALE = 0.10206207261596577f * 1.4426950408889634f;

constexpr size_t al256(size_t x) { return (x + 255) & ~(size_t)255; }
constexpr size_t WS_CTL = 0, CTL_ZERO_BYTES = 163840;
constexpr size_t WS_SUMSQ = 32768;
constexpr size_t WS_MOD = CTL_ZERO_BYTES;
constexpr size_t WS_ROPE = WS_MOD + al256(2 * 3 * 6144 * 4);
constexpr size_t WS_BIAS = WS_ROPE + 4096;
constexpr int BIAS_LD = 6656;
constexpr size_t WS_DFTL = WS_BIAS + (size_t)2 * 2 * 3 * BIAS_LD * 4;
constexpr size_t WS_DFTC = WS_DFTL + (size_t)2048 * 4096 * 2;
constexpr size_t WS_W = WS_DFTC + (size_t)256 * 512 * 2;
constexpr size_t W_IN = 0;
constexpr size_t W_QB = W_IN + (size_t)WIN_N * 1024 * 2;
constexpr size_t W_KVB = W_QB + (size_t)768 * 384 * 2;
constexpr size_t W_CAT = W_KVB + (size_t)1024 * 256 * 2;
constexpr size_t W_OUT = W_CAT + (size_t)1024 * 1280 * 2;
constexpr size_t W_GU = W_OUT + (size_t)1024 * 1024 * 2;
constexpr size_t W_DN = W_GU + (size_t)5632 * 1024 * 2;
constexpr size_t W_LAYER = W_DN + (size_t)1024 * 2816 * 2;
constexpr size_t WS_XN = WS_W + 2 * W_LAYER;
constexpr size_t XN_QN = 0, XN_CKV = XN_QN + (size_t)MROWS * 384 * 2, XN_KR = XN_CKV + (size_t)KVROWS * 256 * 2;
static_assert(XN_KR + (size_t)KVROWS * 32 * 2 <= (size_t)MROWS * 1024 * 2, "XN overlay");
constexpr size_t WS_PROJ = WS_XN + (size_t)MROWS * 1024 * 2;
constexpr size_t PJ_Q = 0, PJ_KV = PJ_Q + (size_t)MROWS * 768 * 2;
static_assert(PJ_KV + (size_t)KVROWS * 1024 * 2 <= (size_t)MROWS * PROJ_LD * 2, "PROJ overlay");
constexpr size_t WS_GATES = WS_PROJ + (size_t)MROWS * PROJ_LD * 2;
constexpr size_t WS_ACAT = WS_GATES + (size_t)MROWS * 4096 * 2;
constexpr int ACAT_LD = 1280, AC_UC = 512, AC_SC = 768, AC_F = 1024;
constexpr size_t WS_PQL = WS_ACAT + (size_t)MROWS * ACAT_LD * 2;
constexpr size_t WS_PQC = WS_PQL + (size_t)2 * 256 * 4096 * 2;
constexpr size_t WS_DFTP = WS_PQC + (size_t)16 * 256 * 512 * 2;
constexpr size_t WS_END = WS_DFTP + (size_t)2 * 8 * 2048 * 256 * 2;
static_assert(WS_END <= 268435456, "workspace map exceeds 256 MiB");

constexpr int RING_BYTES = 147456, MISC_OFF = RING_BYTES, LDS_BYTES = 163840;

__device__ __forceinline__ unsigned cvt_pk_bf16(float lo, float hi) { unsigned r; asm volatile("v_cvt_pk_bf16_f32 %0, %1, %2" : "=v"(r) : "v"(lo), "v"(hi)); return r; }
__device__ __forceinline__ float bf_lo(unsigned u) { return __uint_as_float(u << 16); }
__device__ __forceinline__ float bf_hi(unsigned u) { return __uint_as_float(u & 0xffff0000u); }
__device__ __forceinline__ float bf1(bf16_t u) { return __uint_as_float((unsigned)u << 16); }
__device__ __forceinline__ bf16_t f2bf(float f) { return (bf16_t)(cvt_pk_bf16(f, 0.f) & 0xffffu); }
__device__ __forceinline__ float sigmoidf_(float x) { return __builtin_amdgcn_rcpf(1.f + __expf(-x)); }
__device__ __forceinline__ float wave_sum(float v) {
#pragma unroll
    for (int o = 1; o < 64; o <<= 1) v += __shfl_xor(v, o);
    return v;
}
#define LDS_WAIT() asm volatile("s_waitcnt lgkmcnt(0)" ::: "memory")
#define VM_WAIT() asm volatile("s_waitcnt vmcnt(0)" ::: "memory")

namespace pg8 {
constexpr int BM = 256, BK = 64, HALF = 128, HTB = HALF * BK * 2, STAGE_BYTES = 8 * HTB;
__device__ __forceinline__ int lds_byte(int r, int c) { const int st = (r >> 4) * 2 + (c >> 5), rr = r & 15, cc = c & 31, ob = rr * 64 + cc * 2; return st * 1024 + (ob ^ (((ob >> 9) & 1) << 5)); }
__device__ __forceinline__ void stage_rc(int b, int& R, int& C) { const int st = b / 1024, sb = b % 1024, swz = sb ^ (((sb >> 9) & 1) << 5); R = (st >> 1) * 16 + swz / 64; C = (st & 1) * 32 + (swz % 64) / 2; }
__device__ __forceinline__ int perm32(int rho) { const int n = rho >> 4, i = rho & 15; return 8 * (i >> 2) + 4 * n + (i & 3); }

struct Unit { int pm, pn, z, koff, nt, seg; };
struct Job {
    const char* A; const char* Bt; int lda, ldb, K; long a_lo, a_hi, b_lo, b_hi;
    int nM, nN, nZ;
    int kind, hm;
    void* o0; void* o1; void* o2; const void* p0; const void* p1; const void* p2; const void* p3; int ldc; long zso; int aux;
};
enum { EK_PROJ = 0, EK_Q, EK_BF16, EK_MERGE, EK_RESID, EK_SWIGLU, EK_NONE };

struct Order {
    int nM, nN, nZ, nwg, G, c, single, nt, chain;
    __device__ __forceinline__ void init(const Job& j, int G_, int c_) { nM = j.nM; nN = j.nN; nZ = j.nZ; nwg = nM * nN * nZ; G = G_; c = c_; single = -1; nt = j.K / BK; chain = (j.kind == EK_MERGE); }
    __device__ __forceinline__ void init_single(const Job& j, int unit) { nM = j.nM; nN = j.nN; nZ = j.nZ; nwg = nM * nN * nZ; G = 1; c = 0; single = unit; nt = j.K / BK; chain = 0; }
    __device__ __forceinline__ bool next(int i, Unit& u) const {
        u.koff = 0; u.nt = nt; u.seg = -1;
        if (single >= 0) { if (i > 0) return false; const int per = nM * nN; u.z = single / per; const int r = single % per; u.pn = r / nM; u.pm = r % nM; return true; }
        if (chain) { u.seg = i & 3; i >>= 2; u.koff = (u.seg == 0) ? 0 : (256 + 256 * u.seg) * 2; u.nt = (u.seg == 0) ? 8 : 4; }
        const long L = (long)i * G + c; if (L >= nwg) return false;
        if (nZ > 1) { const int per = nM * nN; u.z = (int)L / per; const int r = (int)L % per; u.pn = r / nM; u.pm = r % nM; return true; }
        constexpr int NXCD = 8, WGM = 8;
        int wgid = (int)L; { const int q = nwg / NXCD, r = nwg % NXCD, xcd = wgid % NXCD, off = wgid / NXCD; wgid = (xcd < r ? xcd * (q + 1) : r * (q + 1) + (xcd - r) * q) + off; }
        const int nig = WGM * nN, gid = wgid / nig, fm = gid * WGM, gsz = (nM - fm) < WGM ? (nM - fm) : WGM;
        u.pm = fm + ((wgid % nig) % gsz); u.pn = (wgid % nig) / gsz; u.z = 0; return true;
    }
};

__device__ __forceinline__ void epilogue(const Job& J, const f32x4 (&acc)[2][2][4][2], const Unit& u, int wr, int wc, int fr, int fq, const LAS float* aux) {
    const int row0 = u.pm * BM + wr * 64 + fr;
    const int cl = wc * 32 + 8 * fq;
    if (J.kind == EK_PROJ) {
        const bool isg = u.pn >= 10;
        bf16_t* base = isg ? (bf16_t*)J.o1 : (bf16_t*)J.o0; const int ldc = isg ? 4096 : PROJ_LD;
        const int col0 = (isg ? (u.pn - 10) * BM : u.pn * BM) + cl;
        const LAS float* ssq = aux + wr * 64 + fr; const LAS float* bias = aux + 256 + cl;
        f32x4 bb[2][2];
#pragma unroll
        for (int bj = 0; bj < 2; ++bj) { bb[bj][0] = *(const LAS f32x4*)(bias + bj * HALF); bb[bj][1] = *(const LAS f32x4*)(bias + bj * HALF + 4); }
#pragma unroll
        for (int ai = 0; ai < 2; ++ai)
#pragma unroll
            for (int m = 0; m < 4; ++m) { bf16_t* rowp = base + (size_t)(row0 + ai * HALF + m * 16) * ldc + col0;
                const float rs = __builtin_amdgcn_rsqf(ssq[ai * HALF + m * 16] * (1.f / D) + EPS);
#pragma unroll
                for (int bj = 0; bj < 2; ++bj) { f32x4 v0 = acc[ai][bj][m][0] * rs + bb[bj][0], v1 = acc[ai][bj][m][1] * rs + bb[bj][1];
                    if (isg) {
#pragma unroll
                        for (int e = 0; e < 4; ++e) { v0[e] = sigmoidf_(v0[e]); v1[e] = sigmoidf_(v1[e]); } }
                    u32x4 w; w.x = cvt_pk_bf16(v0[0], v0[1]); w.y = cvt_pk_bf16(v0[2], v0[3]); w.z = cvt_pk_bf16(v1[0], v1[1]); w.w = cvt_pk_bf16(v1[2], v1[3]);
                    if (isg || col0 + bj * HALF + 8 <= PROJ_LD) *(u32x4*)(rowp + bj * HALF) = w; } }
    } else if (J.kind == EK_Q) {
        bf16_t* Q = (bf16_t*)J.o0; const float* rope = (const float*)J.p0; const bool lat = u.pm >= 16;
#pragma unroll
        for (int bj = 0; bj < 2; ++bj) {
            const int G = 8 * u.pn + 4 * bj + wc; const bool isrope = lat && (G % 3 == 2);
#pragma unroll
            for (int ai = 0; ai < 2; ++ai)
#pragma unroll
                for (int m = 0; m < 4; ++m) { const int row = row0 + ai * HALF + m * 16;
                    float v[8];
#pragma unroll
                    for (int e = 0; e < 4; ++e) { v[e] = acc[ai][bj][m][0][e] * QSCALE; v[4 + e] = acc[ai][bj][m][1][e] * QSCALE; }
                    if (isrope) { const int t = (row - NCTX) & (DEC_SEQ - 1); const int pos = (fq < 2) ? (t >> 6) : (t & 63);
                        const f32x4* cs = (const f32x4*)(rope + pos * 16);
                        const f32x4 c0 = cs[0], c1 = cs[1], c2 = cs[2], c3 = cs[3];
                        const float cc[8] = {c0[0], c0[2], c1[0], c1[2], c2[0], c2[2], c3[0], c3[2]}, ss[8] = {c0[1], c0[3], c1[1], c1[3], c2[1], c2[3], c3[1], c3[3]};
#pragma unroll
                        for (int e = 0; e < 8; ++e) { const float p = __shfl_xor(v[e], 16); v[e] = (fq & 1) ? (v[e] * cc[e] + p * ss[e]) : (v[e] * cc[e] - p * ss[e]); } }
                    u32x4 w; w.x = cvt_pk_bf16(v[0], v[1]); w.y = cvt_pk_bf16(v[2], v[3]); w.z = cvt_pk_bf16(v[4], v[5]); w.w = cvt_pk_bf16(v[6], v[7]);
                    *(u32x4*)(Q + (size_t)row * 768 + u.pn * BM + bj * HALF + cl) = w; } }
    } else if (J.kind == EK_BF16) {
        bf16_t* O = (bf16_t*)J.o0 + (size_t)u.z * J.zso;
#pragma unroll
        for (int ai = 0; ai < 2; ++ai)
#pragma unroll
            for (int m = 0; m < 4; ++m) { bf16_t* rowp = O + (size_t)(row0 + ai * HALF + m * 16) * J.ldc + u.pn * BM + cl;
#pragma unroll
                for (int bj = 0; bj < 2; ++bj) { const f32x4 v0 = acc[ai][bj][m][0], v1 = acc[ai][bj][m][1];
                    u32x4 w; w.x = cvt_pk_bf16(v0[0], v0[1]); w.y = cvt_pk_bf16(v0[2], v0[3]); w.z = cvt_pk_bf16(v1[0], v1[1]); w.w = cvt_pk_bf16(v1[2], v1[3]);
                    *(u32x4*)(rowp + bj * HALF) = w; } }
    } else if (J.kind == EK_NONE) {
#pragma unroll
        for (int ai = 0; ai < 2; ++ai)
#pragma unroll
            for (int bj = 0; bj < 2; ++bj)
#pragma unroll
                for (int m = 0; m < 4; ++m) asm volatile("" :: "v"(acc[ai][bj][m][0]), "v"(acc[ai][bj][m][1]));
    } else {
        bf16_t* ACT = (bf16_t*)J.o0;
        const LAS float* ssq = aux + wr * 64 + fr; const LAS float* bias = aux + 256 + cl;
        const f32x4 bg0 = *(const LAS f32x4*)bias, bg1 = *(const LAS f32x4*)(bias + 4), bu0 = *(const LAS f32x4*)(bias + HALF), bu1 = *(const LAS f32x4*)(bias + HALF + 4);
#pragma unroll
        for (int ai = 0; ai < 2; ++ai)
#pragma unroll
            for (int m = 0; m < 4; ++m) { f32x4 v0, v1; const float rs = __builtin_amdgcn_rsqf(ssq[ai * HALF + m * 16] * (1.f / D) + EPS);
#pragma unroll
                for (int e = 0; e < 4; ++e) { const float g0 = acc[ai][0][m][0][e] * rs + bg0[e], g1 = acc[ai][0][m][1][e] * rs + bg1[e];
                    v0[e] = g0 * sigmoidf_(g0) * (acc[ai][1][m][0][e] * rs + bu0[e]); v1[e] = g1 * sigmoidf_(g1) * (acc[ai][1][m][1][e] * rs + bu1[e]); }
                u32x4 w; w.x = cvt_pk_bf16(v0[0], v0[1]); w.y = cvt_pk_bf16(v0[2], v0[3]); w.z = cvt_pk_bf16(v1[0], v1[1]); w.w = cvt_pk_bf16(v1[2], v1[3]);
                *(u32x4*)(ACT + (size_t)(row0 + ai * HALF + m * 16) * FF + u.pn * HALF + cl) = w; }
    }
}

__device__ __forceinline__ void gemm_phase(LAS unsigned char* lds, const Job& g, const Order& S, const int tid_in) {
    int tid = tid_in; asm volatile("" : "+v"(tid));
    const int wid = __builtin_amdgcn_readfirstlane(tid >> 6), lane = tid & 63, wr = wid >> 2, wc = wid & 3, fr = lane & 15, fq = lane >> 4;
    unsigned voffA[2], voffB[2];
#pragma unroll
    for (int i = 0; i < 2; ++i) { int R, C; stage_rc(tid * 16 + i * 8192, R, C); const int Rb = (R & ~31) + perm32(R & 31);
        voffA[i] = (unsigned)(R * g.lda + C) * 2u; voffB[i] = (unsigned)(Rb * g.ldb + C) * 2u; }
    const size_t kstep = (size_t)(BK * 2);
    const size_t hstepA = (size_t)HALF * g.lda * 2, hstepB = (size_t)HALF * g.ldb * 2;
    const size_t tstepA = 2 * hstepA, tstepB = 2 * hstepB;
    const unsigned ldsw = (unsigned)wid * 1024u;
    const int aoff = lds_byte(wr * 64 + fr, fq * 8), boff = lds_byte(wc * 32 + fr, fq * 8);
#define PG8_SA(b, h) (((b) * 2 + (h)) * HTB)
#define PG8_SB(b, h) ((4 + (b) * 2 + (h)) * HTB)
#define PG8_STAGE(bufoff, gbase, voff) do { _Pragma("unroll") for (int _i = 0; _i < 2; ++_i) \
        __builtin_amdgcn_global_load_lds((const unsigned*)((const char*)(gbase) + (voff)[_i]), (LAS unsigned*)(lds + (bufoff) + ldsw + _i * 8192), 16, 0, 0); } while (0)
#define PG8_LDA(dst, b, h) do { _Pragma("unroll") for (int m = 0; m < 4; ++m) _Pragma("unroll") for (int k = 0; k < 2; ++k) dst[m][k] = *(const LAS bf16x8*)(lds + PG8_SA(b, h) + aoff + m * 2048 + k * 1024); } while (0)
#define PG8_LDB(dst, b, h) do { _Pragma("unroll") for (int n = 0; n < 2; ++n) _Pragma("unroll") for (int k = 0; k < 2; ++k) dst[n][k] = *(const LAS bf16x8*)(lds + PG8_SB(b, h) + boff + n * 2048 + k * 1024); } while (0)
#define PG8_MMA(ai, bj, At, Bt) do { __builtin_amdgcn_s_setprio(1); _Pragma("unroll") for (int m = 0; m < 4; ++m) _Pragma("unroll") for (int n = 0; n < 2; ++n) _Pragma("unroll") for (int k = 0; k < 2; ++k) \
        acc[ai][bj][m][n] = __builtin_amdgcn_mfma_f32_16x16x32_bf16(Bt[n][k], At[m][k], acc[ai][bj][m][n], 0, 0, 0); __builtin_amdgcn_s_setprio(0); } while (0)
#define PG8_WAIT_V(n) asm volatile("s_waitcnt vmcnt(" #n ")" ::: "memory")
#define PG8_WAIT_L(n) asm volatile("s_waitcnt lgkmcnt(" #n ")" ::: "memory")
#define PG8_BAR __builtin_amdgcn_s_barrier()
#define PG8_SCHED __builtin_amdgcn_sched_barrier(0)
#define PG8_UA(u) (g.A + (size_t)((u).z & 7) * g.a_lo + (size_t)((u).z >> 3) * g.a_hi + (size_t)(u).pm * tstepA + (u).koff)
#define PG8_UB(u) (g.Bt + (size_t)((u).z & 7) * g.b_lo + (size_t)((u).z >> 3) * g.b_hi + (size_t)(u).pn * tstepB + (u).koff)
    Unit cur, nxt; int ui = 0;
    if (!S.next(0, cur)) return;
    const bool has_aux = (g.kind == EK_PROJ || g.kind == EK_SWIGLU);
#define PG8_AUX(u, par) do { if (has_aux) { const int mi_ = (u).pm < 16 ? 0 : ((u).pm < 24 ? 1 : 2); \
        const float* src_ = (wid < 4) ? (const float*)g.p2 + (u).pm * BM + wid * 64 + lane : (const float*)g.p3 + mi_ * BIAS_LD + (u).pn * BM + (wid - 4) * 64 + lane; \
        __builtin_amdgcn_global_load_lds((const unsigned*)src_, (LAS unsigned*)(lds + STAGE_BYTES + (par) * 2048 + wid * 256), 4, 0, 0); } } while (0)
    f32x4 acc[2][2][4][2];
#pragma unroll
    for (int a = 0; a < 2; ++a)
#pragma unroll
        for (int b = 0; b < 2; ++b)
#pragma unroll
            for (int m = 0; m < 4; ++m)
#pragma unroll
                for (int n = 0; n < 2; ++n) acc[a][b][m][n] = (f32x4){0.f, 0.f, 0.f, 0.f};
    bf16x8 At[4][2], B0[2][2], B1[2][2];
    const char* cA = PG8_UA(cur); const char* cB = PG8_UB(cur);
    PG8_STAGE(PG8_SB(0, 0), cB, voffB); PG8_STAGE(PG8_SB(0, 1), cB + hstepB, voffB); PG8_STAGE(PG8_SA(0, 0), cA, voffA); PG8_STAGE(PG8_SA(0, 1), cA + hstepA, voffA);
    if (wr == 1) PG8_BAR;
    PG8_WAIT_V(2); PG8_BAR;
    PG8_STAGE(PG8_SB(1, 0), cB + kstep, voffB); PG8_STAGE(PG8_SA(1, 0), cA + kstep, voffA); PG8_STAGE(PG8_SB(1, 1), cB + hstepB + kstep, voffB);
    PG8_WAIT_V(6); PG8_BAR;
    for (;;) {
        const bool has_next = S.next(ui + 1, nxt);
        const char* nA = has_next ? PG8_UA(nxt) : cA; const char* nB = has_next ? PG8_UB(nxt) : cB;
        const int nt = cur.nt;
        PG8_AUX(cur, ui & 1);
        for (int t = 0; t < nt; t += 2) {
            const bool last = (t == nt - 2);
            const char* a1 = cA + (size_t)(t + 1) * kstep;
            const char* a2 = last ? nA : cA + (size_t)(t + 2) * kstep; const char* b2 = last ? nB : cB + (size_t)(t + 2) * kstep;
            const char* a3 = a2 + kstep; const char* b3 = b2 + kstep;
            PG8_LDB(B0, 0, 0); PG8_LDB(B1, 0, 1); PG8_SCHED; PG8_LDA(At, 0, 0); PG8_STAGE(PG8_SA(1, 1), a1 + hstepA, voffA);
            PG8_WAIT_V(8); PG8_WAIT_L(0); PG8_BAR; PG8_MMA(0, 0, At, B0); PG8_MMA(0, 1, At, B1); PG8_BAR; PG8_SCHED;
            PG8_LDA(At, 0, 1); PG8_STAGE(PG8_SB(0, 0), b2, voffB); PG8_STAGE(PG8_SB(0, 1), b2 + hstepB, voffB); PG8_STAGE(PG8_SA(0, 0), a2, voffA);
            PG8_WAIT_V(8); PG8_WAIT_L(0); PG8_BAR; PG8_MMA(1, 0, At, B0); PG8_MMA(1, 1, At, B1); PG8_BAR; PG8_SCHED;
            PG8_LDB(B0, 1, 0); PG8_LDB(B1, 1, 1); PG8_SCHED; PG8_LDA(At, 1, 0); PG8_STAGE(PG8_SA(0, 1), a2 + hstepA, voffA);
            PG8_WAIT_V(8); PG8_WAIT_L(0); PG8_BAR; PG8_MMA(0, 0, At, B0); PG8_MMA(0, 1, At, B1); PG8_BAR; PG8_SCHED;
            PG8_LDA(At, 1, 1); PG8_STAGE(PG8_SB(1, 0), b3, voffB); PG8_STAGE(PG8_SB(1, 1), b3 + hstepB, voffB); PG8_STAGE(PG8_SA(1, 0), a3, voffA);
            PG8_WAIT_V(8); PG8_WAIT_L(0); PG8_BAR; PG8_MMA(1, 0, At, B0); PG8_MMA(1, 1, At, B1); PG8_BAR; PG8_SCHED;
        }
        if (wr == 0) PG8_BAR;
        epilogue(g, acc, cur, wr, wc, fr, fq, (const LAS float*)(lds + STAGE_BYTES + (ui & 1) * 2048));
        if (!has_next) break;
#pragma unroll
        for (int a = 0; a < 2; ++a)
#pragma unroll
            for (int b = 0; b < 2; ++b)
#pragma unroll
                for (int m = 0; m < 4; ++m)
#pragma unroll
                    for (int n = 0; n < 2; ++n) acc[a][b][m][n] = (f32x4){0.f, 0.f, 0.f, 0.f};
        cur = nxt; cA = nA; cB = nB; ++ui;
        if (wr == 1) PG8_BAR;
    }
    PG8_WAIT_V(0);
    PG8_BAR;
#undef PG8_SA
#undef PG8_SB
#undef PG8_STAGE
#undef PG8_LDA
#undef PG8_LDB
#undef PG8_MMA
#undef PG8_WAIT_V
#undef PG8_WAIT_L
#undef PG8_BAR
#undef PG8_SCHED
#undef PG8_UA
#undef PG8_UB
#undef PG8_AUX
}

__device__ __forceinline__ void epilogue_hm(const Job& J, f32x4 (&acc)[2][4][2], f32x4 (&macc)[2][4][2], const Unit& u, int wr, int wc, int fr, int fq) {
    const int row0 = u.pm * HALF + wr * 64 + fr; const int cl = wc * 32 + 8 * fq;
    if (J.kind == EK_MERGE) {
        const bf16_t* gates = (const bf16_t*)J.p0 + u.seg * 1024; bf16_t* MB = (bf16_t*)J.o0;
#pragma unroll
        for (int m = 0; m < 4; ++m) { const size_t row = (size_t)(row0 + m * 16);
#pragma unroll
            for (int bj = 0; bj < 2; ++bj) { const int col = u.pn * BM + bj * HALF + cl;
                const u32x4 g = *(const u32x4*)(gates + row * 4096 + col);
                f32x4 v0 = acc[bj][m][0], v1 = acc[bj][m][1];
                v0[0] *= bf_lo(g.x); v0[1] *= bf_hi(g.x); v0[2] *= bf_lo(g.y); v0[3] *= bf_hi(g.y); v1[0] *= bf_lo(g.z); v1[1] *= bf_hi(g.z); v1[2] *= bf_lo(g.w); v1[3] *= bf_hi(g.w);
                if (u.seg > 0) { v0 += macc[bj][m][0]; v1 += macc[bj][m][1]; }
                macc[bj][m][0] = v0; macc[bj][m][1] = v1;
                if (u.seg == 3) { u32x4 w; w.x = cvt_pk_bf16(v0[0], v0[1]); w.y = cvt_pk_bf16(v0[2], v0[3]); w.z = cvt_pk_bf16(v1[0], v1[1]); w.w = cvt_pk_bf16(v1[2], v1[3]); *(u32x4*)(MB + row * 1024 + col) = w; } } }
    } else {
        float* X = (float*)J.o0; const float* XI = (const float*)J.p1; const int mi = u.pm < 32 ? 0 : (u.pm < 48 ? 1 : 2); const float* gv = (const float*)J.p0 + mi * 6144 + J.aux;
        bf16_t* XS = (bf16_t*)J.o1; float* SS = (float*)J.o2; const float* gn = (const float*)J.p2; const float* scn = (const float*)J.p3 + mi * 6144;
        float sm[4] = {0.f, 0.f, 0.f, 0.f};
#pragma unroll
        for (int bj = 0; bj < 2; ++bj) { const int col = u.pn * BM + bj * HALF + cl; const f32x4 g0 = *(const f32x4*)(gv + col), g1 = *(const f32x4*)(gv + col + 4);
            f32x4 s0 = {0.f, 0.f, 0.f, 0.f}, s1 = s0;
            if (XS) { s0 = *(const f32x4*)(gn + col) * (*(const f32x4*)(scn + col) + 1.f); s1 = *(const f32x4*)(gn + col + 4) * (*(const f32x4*)(scn + col + 4) + 1.f); }
#pragma unroll
            for (int m = 0; m < 4; ++m) { const size_t off = (size_t)(row0 + m * 16) * 1024 + col;
                const f32x4 a = *(const f32x4*)(XI + off) + g0 * acc[bj][m][0], b = *(const f32x4*)(XI + off + 4) + g1 * acc[bj][m][1];
                *(f32x4*)(X + off) = a; *(f32x4*)(X + off + 4) = b;
                if (XS) { const f32x4 ya = a * s0, yb = b * s1; *(u32x4*)(XS + off) = (u32x4){cvt_pk_bf16(ya[0], ya[1]), cvt_pk_bf16(ya[2], ya[3]), cvt_pk_bf16(yb[0], yb[1]), cvt_pk_bf16(yb[2], yb[3])};
                    sm[m] += (a[0] * a[0] + a[1] * a[1]) + (a[2] * a[2] + a[3] * a[3]) + (b[0] * b[0] + b[1] * b[1]) + (b[2] * b[2] + b[3] * b[3]); } } }
        if (XS) {
#pragma unroll
            for (int m = 0; m < 4; ++m) { float v = sm[m]; v += __shfl_xor(v, 16); v += __shfl_xor(v, 32); if (fq == 0) unsafeAtomicAdd(SS + row0 + m * 16, v); } }
    }
}

__device__ __forceinline__ void gemm_phase_hm(LAS unsigned char* lds, const Job& g, const Order& S, const int tid_in) {
    int tid = tid_in; asm volatile("" : "+v"(tid));
    const int wid = __builtin_amdgcn_readfirstlane(tid >> 6), lane = tid & 63, wr = wid >> 2, wc = wid & 3, fr = lane & 15, fq = lane >> 4;
    unsigned voffA[2], voffB[2];
#pragma unroll
    for (int i = 0; i < 2; ++i) { int R, C; stage_rc(tid * 16 + i * 8192, R, C); const int Rb = (R & ~31) + perm32(R & 31);
        voffA[i] = (unsigned)(R * g.lda + C) * 2u; voffB[i] = (unsigned)(Rb * g.ldb + C) * 2u; }
    const size_t kstep = (size_t)(BK * 2);
    const size_t hstepA = (size_t)HALF * g.lda * 2, hstepB = (size_t)HALF * g.ldb * 2, tstepB = 2 * hstepB;
    const unsigned ldsw = (unsigned)wid * 1024u;
    const int aoff = lds_byte(wr * 64 + fr, fq * 8), boff = lds_byte(wc * 32 + fr, fq * 8);
    constexpr int SLOT = 3 * HTB;
#define HM_STAGE(slotoff, gbase, voff) do { _Pragma("unroll") for (int _i = 0; _i < 2; ++_i) \
        __builtin_amdgcn_global_load_lds((const unsigned*)((const char*)(gbase) + (voff)[_i]), (LAS unsigned*)(lds + (slotoff) + ldsw + _i * 8192), 16, 0, 0); } while (0)
#define HM_MMA(bj, Bt) do { __builtin_amdgcn_s_setprio(1); _Pragma("unroll") for (int m = 0; m < 4; ++m) _Pragma("unroll") for (int n = 0; n < 2; ++n) _Pragma("unroll") for (int k = 0; k < 2; ++k) \
        acc[bj][m][n] = __builtin_amdgcn_mfma_f32_16x16x32_bf16(Bt[n][k], At[m][k], acc[bj][m][n], 0, 0, 0); __builtin_amdgcn_s_setprio(0); } while (0)
#define HM_WAIT_V(n) asm volatile("s_waitcnt vmcnt(" #n ")" ::: "memory")
#define HM_WAIT_L(n) asm volatile("s_waitcnt lgkmcnt(" #n ")" ::: "memory")
#define HM_BAR __builtin_amdgcn_s_barrier()
#define HM_SCHED __builtin_amdgcn_sched_barrier(0)
#define HM_UA(u) (g.A + (size_t)(u).pm * hstepA + (u).koff)
#define HM_UB(u) (g.Bt + (size_t)(u).pn * tstepB + (u).koff)
    Unit cur, nxt; int ui = 0;
    if (!S.next(0, cur)) return;
    f32x4 acc[2][4][2], macc[2][4][2];
#pragma unroll
    for (int b = 0; b < 2; ++b)
#pragma unroll
        for (int m = 0; m < 4; ++m)
#pragma unroll
            for (int n = 0; n < 2; ++n) { acc[b][m][n] = (f32x4){0.f, 0.f, 0.f, 0.f}; macc[b][m][n] = (f32x4){0.f, 0.f, 0.f, 0.f}; }
    bf16x8 At[4][2], B0[2][2], B1[2][2];
    const char* cA = HM_UA(cur); const char* cB = HM_UB(cur);
    HM_STAGE(0 * SLOT, cA, voffA); HM_STAGE(0 * SLOT + HTB, cB, voffB); HM_STAGE(0 * SLOT + 2 * HTB, cB + hstepB, voffB);
    HM_STAGE(1 * SLOT, cA + kstep, voffA); HM_STAGE(1 * SLOT + HTB, cB + kstep, voffB); HM_STAGE(1 * SLOT + 2 * HTB, cB + hstepB + kstep, voffB);
    if (wr == 1) HM_BAR;
    HM_WAIT_V(6); HM_BAR; HM_BAR;
    int rd = 0;
    for (;;) {
        const bool has_next = S.next(ui + 1, nxt);
        const char* nA = has_next ? HM_UA(nxt) : cA; const char* nB = has_next ? HM_UB(nxt) : cB;
        const int nt = cur.nt;
        for (int t = 0; t < nt; ++t) {
            const int st = (rd >= SLOT) ? rd - SLOT : rd + 2 * SLOT;
            const int t2 = t + 2;
            const char* a2 = (t2 < nt) ? cA + (size_t)t2 * kstep : nA + (size_t)(t2 - nt) * kstep;
            const char* b2 = (t2 < nt) ? cB + (size_t)t2 * kstep : nB + (size_t)(t2 - nt) * kstep;
            LAS unsigned char* lr = lds + rd;
#pragma unroll
            for (int n = 0; n < 2; ++n)
#pragma unroll
                for (int k = 0; k < 2; ++k) { B0[n][k] = *(const LAS bf16x8*)(lr + HTB + boff + n * 2048 + k * 1024); B1[n][k] = *(const LAS bf16x8*)(lr + 2 * HTB + boff + n * 2048 + k * 1024); }
            HM_SCHED;
#pragma unroll
            for (int m = 0; m < 4; ++m)
#pragma unroll
                for (int k = 0; k < 2; ++k) At[m][k] = *(const LAS bf16x8*)(lr + aoff + m * 2048 + k * 1024);
            HM_STAGE(st, a2, voffA); HM_STAGE(st + HTB, b2, voffB); HM_STAGE(st + 2 * HTB, b2 + hstepB, voffB);
            HM_WAIT_V(6); HM_WAIT_L(0); HM_BAR; HM_MMA(0, B0); HM_MMA(1, B1); HM_BAR; HM_SCHED;
            rd = (rd >= 2 * SLOT) ? 0 : rd + SLOT;
        }
        if (wr == 0) HM_BAR;
        epilogue_hm(g, acc, macc, cur, wr, wc, fr, fq);
        if (!has_next) break;
#pragma unroll
        for (int b = 0; b < 2; ++b)
#pragma unroll
            for (int m = 0; m < 4; ++m)
#pragma unroll
                for (int n = 0; n < 2; ++n) acc[b][m][n] = (f32x4){0.f, 0.f, 0.f, 0.f};
        cur = nxt; cA = nA; cB = nB; ++ui;
        if (wr == 1) HM_BAR;
    }
    HM_WAIT_V(0);
    HM_BAR;
#undef HM_STAGE
#undef HM_MMA
#undef HM_WAIT_V
#undef HM_WAIT_L
#undef HM_BAR
#undef HM_SCHED
#undef HM_UA
#undef HM_UB
}
}

namespace attn {
constexpr int KSLOT = 12288, VSLOT = 8192, BUFB = 2 * KSLOT + 2 * VSLOT;
constexpr int NBUF = 3;
constexpr int LDS_WS = NBUF * BUFB;
constexpr int LDS_CM = LDS_WS + 2048;
constexpr int LDS_CL = LDS_CM + 1024;
constexpr int LDS_END = LDS_CL + 512;
constexpr int LDS_OST = BUFB;
static_assert(LDS_END <= RING_BYTES, "attention LDS");
__device__ __forceinline__ int crow(int r, int hi) { return (r & 3) + 8 * (r >> 2) + 4 * hi; }
__device__ __forceinline__ void glds16(const void* gsrc, unsigned lds_dst) { unsigned keep;
    asm volatile("s_mov_b32 %0, m0\n\ts_mov_b32 m0, %2\n\ts_nop 0\n\tglobal_load_lds_dwordx4 %1, off\n\ts_mov_b32 m0, %0" : "=&s"(keep) : "v"(gsrc), "s"(lds_dst) : "memory"); }
typedef __bf16 bf16x2_t __attribute__((ext_vector_type(2)));
__device__ __forceinline__ unsigned cvtpk_s(float lo, float hi) { f32x2 v = {lo, hi}; bf16x2_t b = __builtin_convertvector(v, bf16x2_t); return __builtin_bit_cast(unsigned, b); }
typedef LAS const char* lds_cptr;
typedef short v4i16_t __attribute__((ext_vector_type(4)));
__device__ __forceinline__ s16x4 vtr(lds_cptr p) { return __builtin_bit_cast(s16x4, __builtin_amdgcn_ds_read_tr16_b64_v4i16((LAS v4i16_t*)p)); }
__device__ __forceinline__ float swapmax(float m) { auto rr = __builtin_amdgcn_permlane32_swap(__float_as_uint(m), __float_as_uint(m), false, false); return fmaxf(__uint_as_float(rr[0]), __uint_as_float(rr[1])); }
__device__ __forceinline__ float swapsum(float m) { auto rr = __builtin_amdgcn_permlane32_swap(__float_as_uint(m), __float_as_uint(m), false, false); return __uint_as_float(rr[0]) + __uint_as_float(rr[1]); }

struct Tensors { const bf16_t* Q; const bf16_t* KV; const bf16_t* KR; bf16_t* O; };

__device__ __forceinline__ void dma_step(const Tensors& T, int krow0, int h, unsigned ldsbuf, int wid, int lane) {
#pragma unroll
    for (int i = 0; i < 5; ++i) {
        const int p = wid + 8 * i;
        const void* src; unsigned dst;
        if (p < 24) { const int j = p / 12, c = p % 12; const int row = krow0 + j * 64 + lane;
            src = (c < 8) ? (const void*)(T.KV + (size_t)row * 1024 + h * 128 + c * 8) : (const void*)(T.KR + (size_t)row * 32 + (c - 8) * 8);
            dst = ldsbuf + j * KSLOT + c * 1024; }
        else { const int pv = p - 24, j = pv >> 3, q = pv & 7; const int row = krow0 + j * 64 + 16 * (q & 3) + (lane >> 2);
            src = (const void*)(T.KV + (size_t)row * 1024 + h * 128 + 64 + (q >> 2) * 32 + (lane & 3) * 8);
            dst = ldsbuf + 2 * KSLOT + j * VSLOT + q * 1024; }
        glds16(src, (unsigned)__builtin_amdgcn_readfirstlane(dst));
    }
}

__device__ __forceinline__ void unit(const Tensors& T, int qrow0, int krow0, int nsteps, int h, char* shm, const int tid) {
    const int lane = tid & 63, r32 = lane & 31, hi = lane >> 5; const int wid = __builtin_amdgcn_readfirstlane(tid >> 6);
    const int qb = wid & 3, kh = wid >> 2;
    const unsigned lds0 = (unsigned)(uintptr_t)shm;
    float* wsf = (float*)(shm + LDS_WS) + wid * 64;
    dma_step(T, krow0, h, lds0, wid, lane);
    const bf16_t* Qw = T.Q + (size_t)(qrow0 + qb * 32 + r32) * 768 + h * 96 + hi * 8;
    bf16x8 qr[6];
#pragma unroll
    for (int d0 = 0; d0 < 6; ++d0) qr[d0] = *(const bf16x8*)(Qw + d0 * 16);
    float mhat = 0.f, l_reg = 0.f; f32x16 o[2]; o[0] = f32x16{}; o[1] = f32x16{}; f32x16 negm = f32x16{};
    const lds_cptr shm3 = (lds_cptr)shm;
    dma_step(T, krow0 + 128, h, lds0 + BUFB, wid, lane);
    int bufo = 0, bufn = 2 * BUFB;
    for (int s = 0; s < nsteps; ++s) {
        if (s + 1 < nsteps) asm volatile("s_waitcnt vmcnt(5)" ::: "memory"); else asm volatile("s_waitcnt vmcnt(0)" ::: "memory");
        __builtin_amdgcn_s_barrier(); asm volatile("" ::: "memory");
        if (s + 2 < nsteps) dma_step(T, krow0 + (s + 2) * 128, h, lds0 + bufn, wid, lane);
        const lds_cptr kp = shm3 + bufo + kh * KSLOT + hi * 1024 + r32 * 16;
        const lds_cptr vp = shm3 + bufo + 2 * KSLOT + kh * VSLOT + ((lane >> 4) & 1) * 32 + (lane & 3) * 8 + (4 * hi + ((lane & 15) >> 2)) * 64;
        f32x16 p0, p1;
#pragma unroll
        for (int d0 = 0; d0 < 6; ++d0) {
            const bf16x8 b0 = *(const LAS bf16x8*)(kp + d0 * 2048), b1 = *(const LAS bf16x8*)(kp + d0 * 2048 + 512);
            if (d0 == 0) { p0 = __builtin_amdgcn_mfma_f32_32x32x16_bf16(b0, qr[0], negm, 0, 0, 0); p1 = __builtin_amdgcn_mfma_f32_32x32x16_bf16(b1, qr[0], negm, 0, 0, 0); }
            else { p0 = __builtin_amdgcn_mfma_f32_32x32x16_bf16(b0, qr[d0], p0, 0, 0, 0); p1 = __builtin_amdgcn_mfma_f32_32x32x16_bf16(b1, qr[d0], p1, 0, 0, 0); } }
        float rm = fmaxf(p0[0], p1[0]);
#pragma unroll
        for (int r = 1; r < 16; ++r) rm = fmaxf(rm, fmaxf(p0[r], p1[r]));
        rm = swapmax(rm);
        bool resc = false;
        if (s == 0 || __any(rm > 8.0f)) {
            const float dl = (s == 0) ? rm : fmaxf(rm, 0.f); mhat += dl;
#pragma unroll
            for (int r = 0; r < 16; ++r) { p0[r] -= dl; p1[r] -= dl; negm[r] = -mhat; }
            if (s != 0) { const float f = __builtin_amdgcn_exp2f(-dl); l_reg *= f; if (hi == 0) wsf[r32] = f; resc = true; }
        }
        float sacc = 0.f;
#pragma unroll
        for (int r = 0; r < 16; ++r) { p0[r] = __builtin_amdgcn_exp2f(p0[r]); p1[r] = __builtin_amdgcn_exp2f(p1[r]); sacc += p0[r] + p1[r]; }
        l_reg += sacc;
        if (resc) { asm volatile("s_waitcnt lgkmcnt(0)" ::: "memory");
#pragma unroll
            for (int d_ = 0; d_ < 2; ++d_)
#pragma unroll
                for (int r = 0; r < 16; ++r) o[d_][r] *= wsf[crow(r, hi)]; }
        u32x4 pw[4];
        pw[0] = (u32x4){cvtpk_s(p0[0], p0[1]), cvtpk_s(p0[2], p0[3]), cvtpk_s(p0[4], p0[5]), cvtpk_s(p0[6], p0[7])};
        pw[1] = (u32x4){cvtpk_s(p0[8], p0[9]), cvtpk_s(p0[10], p0[11]), cvtpk_s(p0[12], p0[13]), cvtpk_s(p0[14], p0[15])};
        pw[2] = (u32x4){cvtpk_s(p1[0], p1[1]), cvtpk_s(p1[2], p1[3]), cvtpk_s(p1[4], p1[5]), cvtpk_s(p1[6], p1[7])};
        pw[3] = (u32x4){cvtpk_s(p1[8], p1[9]), cvtpk_s(p1[10], p1[11]), cvtpk_s(p1[12], p1[13]), cvtpk_s(p1[14], p1[15])};
#pragma unroll
        for (int d0 = 0; d0 < 2; ++d0)
#pragma unroll
            for (int ks = 0; ks < 4; ++ks) {
                const s16x4 lo = vtr(vp + d0 * 4096 + ks * 1024), hh = vtr(vp + d0 * 4096 + ks * 1024 + 512);
                const bf16x8 vf = (bf16x8){lo[0], lo[1], lo[2], lo[3], hh[0], hh[1], hh[2], hh[3]};
                o[d0] = __builtin_amdgcn_mfma_f32_32x32x16_bf16(__builtin_bit_cast(bf16x8, pw[ks]), vf, o[d0], 0, 0, 0); }
        bufn = bufo; bufo = (bufo == 2 * BUFB) ? 0 : bufo + BUFB;
    }
    l_reg = swapsum(l_reg);
    float* cm = (float*)(shm + LDS_CM); float* cl = (float*)(shm + LDS_CL);
    if (hi == 0) cm[(kh * 4 + qb) * 32 + r32] = mhat;
    asm volatile("s_waitcnt lgkmcnt(0)" ::: "memory"); __builtin_amdgcn_s_barrier(); asm volatile("" ::: "memory");
    { const float mo = cm[((kh ^ 1) * 4 + qb) * 32 + r32]; const float ms = fmaxf(mhat, mo); const float f = __builtin_amdgcn_exp2f(mhat - ms); l_reg *= f;
      if (hi == 0) wsf[r32] = f; asm volatile("s_waitcnt lgkmcnt(0)" ::: "memory");
#pragma unroll
      for (int d_ = 0; d_ < 2; ++d_)
#pragma unroll
          for (int r = 0; r < 16; ++r) o[d_][r] *= wsf[crow(r, hi)]; }
    float* co = (float*)shm + qb * 2048;
    if (kh == 1) {
#pragma unroll
        for (int d_ = 0; d_ < 2; ++d_)
#pragma unroll
            for (int r = 0; r < 16; ++r) co[(d_ * 16 + r) * 64 + lane] = o[d_][r];
        if (hi == 0) cl[qb * 32 + r32] = l_reg;
    }
    asm volatile("s_waitcnt lgkmcnt(0)" ::: "memory"); __builtin_amdgcn_s_barrier(); asm volatile("" ::: "memory");
    if (kh == 0) {
#pragma unroll
        for (int d_ = 0; d_ < 2; ++d_)
#pragma unroll
            for (int r = 0; r < 16; ++r) o[d_][r] += co[(d_ * 16 + r) * 64 + lane];
        l_reg += cl[qb * 32 + r32];
        if (hi == 0) wsf[32 + r32] = l_reg; asm volatile("s_waitcnt lgkmcnt(0)" ::: "memory");
        float rli[16];
#pragma unroll
        for (int r = 0; r < 16; ++r) rli[r] = __builtin_amdgcn_rcpf(wsf[32 + crow(r, hi)]);
        bf16_t* stg = (bf16_t*)(shm + LDS_OST) + wid * 2048;
#pragma unroll
        for (int r = 0; r < 16; ++r) { const int orow = crow(r, hi);
#pragma unroll
            for (int d0 = 0; d0 < 2; ++d0) stg[orow * 64 + d0 * 32 + r32] = f2bf(o[d0][r] * rli[r]); }
        asm volatile("s_waitcnt lgkmcnt(0)" ::: "memory");
        bf16_t* Ow = T.O + (size_t)(qrow0 + qb * 32) * ACAT_LD + h * 64;
#pragma unroll
        for (int i = 0; i < 4; ++i) { const int row = i * 8 + (lane >> 3), ch = lane & 7; const u32x4 v = *(const u32x4*)(stg + row * 64 + ch * 8); *(u32x4*)(Ow + (size_t)row * ACAT_LD + ch * 8) = v; }
    }
    asm volatile("s_waitcnt lgkmcnt(0)" ::: "memory"); __builtin_amdgcn_s_barrier(); asm volatile("" ::: "memory");
}
}

#define XB_TMO      128
#define XB_XCNT(j)  (256  + 64 * (j))
#define XB_XSUB(j)  (1280 + 64 * (j))
#define XB_XGEN(j)  (2304 + 64 * (j))
#define XB_TOP      3328
#define XB_TOPGEN   3392
#define XCD_BAR_WORDS 3456
#define XB_SPIN_CAP (1u << 18)
__device__ __forceinline__ unsigned xb_ld(unsigned* p)              { return __hip_atomic_load(p, __ATOMIC_RELAXED, __HIP_MEMORY_SCOPE_AGENT); }
__device__ __forceinline__ unsigned xb_add(unsigned* p, unsigned v) { return __hip_atomic_fetch_add(p, v, __ATOMIC_RELAXED, __HIP_MEMORY_SCOPE_AGENT); }
__device__ __forceinline__ unsigned xb_xcc_id() { return (unsigned)__builtin_amdgcn_s_getreg((3 << 11) | 20) & 0xFu; }
#define XB_SPIN(cond, bar) do { unsigned _sp = 0; while (cond) { __builtin_amdgcn_s_sleep(1); \
    if ((++_sp & 255u) == 0u) { if (xb_ld(&(bar)[XB_TMO])) break; if (_sp > XB_SPIN_CAP) { atomicAdd(&(bar)[XB_TMO], 1u); break; } } } } while (0)
struct XcdBarrier { unsigned* bar; unsigned x; volatile LAS unsigned* st; };
__device__ __forceinline__ XcdBarrier xcd_barrier_post(unsigned* bar, volatile LAS unsigned* st) {
    XcdBarrier b; b.bar = bar; b.x = xb_xcc_id(); b.st = st;
    if (threadIdx.x == 0) (void)xb_add(&bar[XB_XCNT(b.x)], 1u);
    return b;
}
__device__ __forceinline__ void xcd_barrier_complete(unsigned* bar, unsigned x, unsigned& nloc, unsigned& nx) {
    const unsigned G = gridDim.x * gridDim.y * gridDim.z;
    unsigned sum, cnt, mine, sp = 0u;
    for (;;) {
        sum = 0u; cnt = 0u; mine = 0u;
#pragma unroll
        for (unsigned j = 0; j < 16; ++j) { const unsigned c = xb_ld(&bar[XB_XCNT(j)]); sum += c; cnt += (c > 0u) ? 1u : 0u; mine = (j == x) ? c : mine; }
        if (sum == G) break;
        __builtin_amdgcn_s_sleep(1);
        if ((++sp & 255u) == 0u) { if (xb_ld(&bar[XB_TMO])) break; if (sp > XB_SPIN_CAP) { atomicAdd(&bar[XB_TMO], 1u); break; } }
    }
    nloc = mine > 0u ? mine : 1u; nx = cnt > 0u ? cnt : 1u;
}
__device__ __forceinline__ void xcd_barrier(const XcdBarrier& b, const int tid) {
    asm volatile("s_waitcnt vmcnt(0)" ::: "memory");
    __syncthreads();
    if (tid == 0) {
        unsigned* bar = b.bar;
        __builtin_amdgcn_s_waitcnt(0);
        unsigned nloc = b.st[0], nx = b.st[1];
        if (nloc == 0u) { xcd_barrier_complete(bar, b.x, nloc, nx); b.st[0] = nloc; b.st[1] = nx; }
        const unsigned old = xb_add(&bar[XB_XSUB(b.x)], 1u);
        const unsigned gen = old / nloc;
        if (old + 1u == (gen + 1u) * nloc) {
            __builtin_amdgcn_fence(__ATOMIC_RELEASE, "agent");
            asm volatile("s_waitcnt vmcnt(0)" ::: "memory");
            const unsigned og = xb_add(&bar[XB_TOP], 1u);
            const unsigned tg = og / nx;
            if (og + 1u == (tg + 1u) * nx) xb_add(&bar[XB_TOPGEN], 1u);
            else XB_SPIN(xb_ld(&bar[XB_TOPGEN]) == tg, bar);
            __builtin_amdgcn_fence(__ATOMIC_ACQUIRE, "agent");
            xb_add(&bar[XB_XGEN(b.x)], 1u);
            asm volatile("s_waitcnt vmcnt(0)" ::: "memory");
        } else {
            XB_SPIN(xb_ld(&bar[XB_XGEN(b.x)]) == gen, bar);
            __builtin_amdgcn_fence(__ATOMIC_ACQUIRE, "agent");
            asm volatile("s_waitcnt vmcnt(0)" ::: "memory");
        }
    }
    __syncthreads();
}

struct Args { const float* in[29]; float* out; unsigned char* ws; int step_lo, step_hi; };
static_assert(sizeof(Args) == 31 * 8 + 8, "Args has no padding");

struct Ctx {
    LAS unsigned char* lds; int tid, lane, wave, G, gw, NGW, bid;
    float* out; unsigned char* ws;
};
template <class T> __device__ __forceinline__ T as_global_(T p) {
#if defined(__HIP_DEVICE_COMPILE__)
    __builtin_assume(!__builtin_amdgcn_is_shared((const void*)p) && !__builtin_amdgcn_is_private((const void*)p));
#endif
    return p; }
#define AS_GLOBAL(T, p) as_global_<T>((T)(p))
typedef const float* gfptr_t;
__device__ __forceinline__ const float* ldarg(int i) { unsigned z = 0u; asm volatile("" : "+s"(z));
    const __attribute__((address_space(4))) char* kp = (const __attribute__((address_space(4))) char*)__builtin_amdgcn_kernarg_segment_ptr();
    const GAS float* p = *(const GAS float* const __attribute__((address_space(4)))*)(kp + 8 * i + z); return (const float*)p; }
#define INP(i) ldarg(i)

__device__ __forceinline__ void transpose_item(const float* W, int N, bf16_t* WT, int ldt, int k0, int n0, int drow0, LAS float* scr, int lane) {
    float v[32];
    const float* wp = W + (size_t)(k0 + (lane >> 5)) * N + n0 + (lane & 31);
#pragma unroll
    for (int i = 0; i < 32; ++i) v[i] = wp[(size_t)(2 * i) * N];
#pragma unroll
    for (int i = 0; i < 32; ++i) scr[(2 * i + (lane >> 5)) * 33 + (lane & 31)] = v[i];
    LDS_WAIT(); asm volatile("" ::: "memory");
    const int c = lane & 7;
#pragma unroll
    for (int j = 0; j < 4; ++j) { const int n = (lane >> 3) + 8 * j; const LAS float* s = scr + (8 * c) * 33 + n;
        u32x4 o; o.x = cvt_pk_bf16(s[0 * 33], s[1 * 33]); o.y = cvt_pk_bf16(s[2 * 33], s[3 * 33]); o.z = cvt_pk_bf16(s[4 * 33], s[5 * 33]); o.w = cvt_pk_bf16(s[6 * 33], s[7 * 33]);
        *(u32x4*)(WT + (size_t)(drow0 + n) * ldt + k0 + 8 * c) = o; }
    LDS_WAIT(); asm volatile("" ::: "memory");
}

__device__ __forceinline__ void prologue(Ctx& F) {
    unsigned char* ws = F.ws;
    LAS float* misc = (LAS float*)(F.lds + MISC_OFF + 1024);
    __syncthreads();
    if (F.tid < 64) { misc[F.tid] = __builtin_amdgcn_cosf((float)F.tid * (1.f / 64.f)); misc[64 + F.tid] = __builtin_amdgcn_sinf((float)F.tid * (1.f / 64.f)); }
    for (int rp_ = 0; rp_ < ((PROBE_PRO & 1) ? 2 : 1); ++rp_) {
    if (F.bid < 192) {
        LAS float* scv = (LAS float*)F.lds;
        LAS float* red = (LAS float*)(F.lds + 16384);
        for (int i = F.tid; i < 3072; i += 512) { const int m = i >> 10, k = i & 1023; const float v = (m == 0) ? INP(5)[k] : INP(4)[(m - 1) * 1024 + k]; scv[i] = v * sigmoidf_(v); }
        __syncthreads();
        const int l = F.bid / 96, c0 = (F.bid % 96) * 64;
        const float* w = INP(6) + (size_t)l * 1024 * 6144 + c0 + F.lane;
        float a0 = 0.f, a1 = 0.f, a2 = 0.f;
        const int kb = F.wave * 128;
#pragma unroll 16
        for (int k = 0; k < 128; ++k) { const float wv = w[(size_t)(kb + k) * 6144]; a0 += scv[kb + k] * wv; a1 += scv[1024 + kb + k] * wv; a2 += scv[2048 + kb + k] * wv; }
        red[(F.wave * 3 + 0) * 64 + F.lane] = a0; red[(F.wave * 3 + 1) * 64 + F.lane] = a1; red[(F.wave * 3 + 2) * 64 + F.lane] = a2;
        __syncthreads();
        if (F.wave < 3) { float s = INP(7)[l * 6144 + c0 + F.lane];
#pragma unroll
            for (int w8 = 0; w8 < 8; ++w8) s += red[(w8 * 3 + F.wave) * 64 + F.lane];
            ((float*)(ws + WS_MOD))[(l * 3 + F.wave) * 6144 + c0 + F.lane] = s; }
        __syncthreads();
    } else __syncthreads();
    }
    LAS float* scr = (LAS float*)(F.lds + F.wave * 16384);
    for (int rp_ = 0; rp_ < ((PROBE_PRO & 4) ? 2 : 1); ++rp_)
    {
        const int pw = F.bid + F.G * F.wave;
        for (int it = pw; it < 1024; it += F.NGW) { const int l = it >> 9, kc = (it & 511) >> 2, g = it & 3, k0 = kc * 8;
            const float* W = INP(10) + (size_t)l * 1024 * IN_COLS; bf16_t* WT = (bf16_t*)(ws + WS_W + (size_t)l * W_LAYER + W_IN);
#pragma unroll
            for (int i = 0; i < 8; ++i) scr[i * 64 + F.lane] = W[(size_t)(k0 + i) * IN_COLS + OFF_FN + g * 64 + F.lane];
            LDS_WAIT(); asm volatile("" ::: "memory");
            float aP[8], aQ[8];
#pragma unroll
            for (int k = 0; k < 8; ++k) { aP[k] = 0.f; aQ[k] = 0.f; }
#pragma unroll 4
            for (int n4 = 0; n4 < 16; ++n4) { float c[4], sn[4];
#pragma unroll
                for (int e = 0; e < 4; ++e) { const int ix = (F.lane * (4 * n4 + e)) & 63; c[e] = misc[ix]; sn[e] = misc[64 + ix]; }
#pragma unroll
                for (int k = 0; k < 8; ++k) { const f32x4 w = *(const LAS f32x4*)(scr + k * 64 + 4 * n4);
                    aP[k] += w.x * c[0] + w.y * c[1] + w.z * c[2] + w.w * c[3]; aQ[k] += w.x * sn[0] + w.y * sn[1] + w.z * sn[2] + w.w * sn[3]; } }
            *(u32x4*)(WT + (size_t)(OFF_FN + g * 64 + F.lane) * 1024 + k0) = (u32x4){cvt_pk_bf16(aP[0] * 0.125f, aP[1] * 0.125f), cvt_pk_bf16(aP[2] * 0.125f, aP[3] * 0.125f), cvt_pk_bf16(aP[4] * 0.125f, aP[5] * 0.125f), cvt_pk_bf16(aP[6] * 0.125f, aP[7] * 0.125f)};
            *(u32x4*)(WT + (size_t)(OFF_GATE + g * 64 + F.lane) * 1024 + k0) = (u32x4){cvt_pk_bf16(aQ[0] * 0.125f, aQ[1] * 0.125f), cvt_pk_bf16(aQ[2] * 0.125f, aQ[3] * 0.125f), cvt_pk_bf16(aQ[4] * 0.125f, aQ[5] * 0.125f), cvt_pk_bf16(aQ[6] * 0.125f, aQ[7] * 0.125f)};
            LDS_WAIT(); asm volatile("" ::: "memory");
        }
    }
    for (int l2_ = 0; l2_ < DEPTH * ((PROBE_PRO & 2) ? 2 : 1); ++l2_) { const int l = l2_ % DEPTH;
        unsigned char* wl = ws + WS_W + (size_t)l * W_LAYER;
      {
        {
            const float* W = INP(10) + (size_t)l * 1024 * IN_COLS; bf16_t* WT = (bf16_t*)(wl + W_IN); constexpr int nblk = IN_COLS / 32;
            for (int it = F.gw; it < 16 * nblk; it += F.NGW) { const int kb = it / nblk, nb = it % nblk, n0 = nb * 32;
                if (n0 >= OFF_FN && n0 < OFF_GATE) continue;
                const int dr = (n0 < OFF_FN) ? n0 : 2560 + (n0 - OFF_GATE);
                transpose_item(W, IN_COLS, WT, 1024, kb * 64, n0, dr, scr, F.lane); }
            for (int it = F.gw; it < 96 * 2; it += F.NGW) { const int r = 2464 + it / 2, h = it & 1; *(u32x4*)(WT + (size_t)r * 1024 + h * 512 + F.lane * 8) = (u32x4){0u, 0u, 0u, 0u}; }
        }
#define TR_SIMPLE(idx, KK, NN, OFF) { const float* W = INP(idx) + (size_t)l * (KK) * (NN); bf16_t* WT = (bf16_t*)(wl + (OFF)); constexpr int nblk = (NN) / 32; \
            for (int it = F.gw; it < ((KK) / 64) * nblk; it += F.NGW) { const int kb = it / nblk, nb = it % nblk; transpose_item(W, (NN), WT, (KK), kb * 64, nb * 32, nb * 32, scr, F.lane); } }
        TR_SIMPLE(12, 384, 768, W_QB)
        TR_SIMPLE(14, 256, 1024, W_KVB)
#define TR_CAT(idx, KK, KOFF) { const float* W = INP(idx) + (size_t)l * (KK) * 1024; bf16_t* WT = (bf16_t*)(wl + W_CAT) + (KOFF); \
            for (int it = F.gw; it < ((KK) / 64) * 32; it += F.NGW) { const int kb = it / 32, nb = it % 32; transpose_item(W, 1024, WT, 1280, kb * 64, nb * 32, nb * 32, scr, F.lane); } }
        TR_CAT(15, 512, 0)
        TR_CAT(20, 256, 512)
        TR_CAT(22, 256, 768)
        TR_CAT(23, 256, 1024)
#undef TR_CAT
        TR_SIMPLE(24, 1024, 1024, W_OUT)
        TR_SIMPLE(27, 2816, 1024, W_DN)
#undef TR_SIMPLE
        for (int gu = 0; gu < 2; ++gu) {
            const float* W = (gu ? INP(26) : INP(25)) + (size_t)l * 1024 * FF; bf16_t* WT = (bf16_t*)(wl + W_GU); constexpr int nblk = FF / 32;
            for (int it = F.gw; it < 16 * nblk; it += F.NGW) { const int kb = it / nblk, nb = it % nblk, n0 = nb * 32;
                transpose_item(W, FF, WT, 1024, kb * 64, n0, (n0 / 128) * 256 + gu * 128 + (n0 % 128), scr, F.lane); }
        }
      }
    }
    for (int rp_ = 0; rp_ < ((PROBE_PRO & 8) ? 2 : 1); ++rp_) {
        bf16_t* TL = (bf16_t*)(ws + WS_DFTL); const int gt = F.gw * 64 + F.lane, NT = F.NGW * 64;
        for (int it = gt; it < 2048 * 512; it += NT) { const int k = it >> 9, c8 = (it & 511) * 8; float v[8];
#pragma unroll
            for (int e = 0; e < 8; ++e) { const int c = c8 + e, t = c & 2047; const float fr = (float)((k * t) & 2047) * (1.f / 2048.f);
                v[e] = ((c < 2048) ? __builtin_amdgcn_cosf(fr) : -__builtin_amdgcn_sinf(fr)) * 0.022097086912079608f; }
            *(u32x4*)(TL + (size_t)k * 4096 + c8) = (u32x4){cvt_pk_bf16(v[0], v[1]), cvt_pk_bf16(v[2], v[3]), cvt_pk_bf16(v[4], v[5]), cvt_pk_bf16(v[6], v[7])}; }
        bf16_t* TC = (bf16_t*)(ws + WS_DFTC);
        for (int it = gt; it < 256 * 64; it += NT) { const int k = it >> 6, c8 = (it & 63) * 8; float v[8];
#pragma unroll
            for (int e = 0; e < 8; ++e) { const int c = c8 + e, t = c & 255; const float fr = (float)((k * t) & 255) * (1.f / 256.f);
                v[e] = ((c < 256) ? __builtin_amdgcn_cosf(fr) : -__builtin_amdgcn_sinf(fr)) * 0.0625f; }
            *(u32x4*)(TC + (size_t)k * 512 + c8) = (u32x4){cvt_pk_bf16(v[0], v[1]), cvt_pk_bf16(v[2], v[3]), cvt_pk_bf16(v[4], v[5]), cvt_pk_bf16(v[6], v[7])}; }
        if (F.gw == F.NGW - 1) { float* R = (float*)(ws + WS_ROPE);
            for (int i = F.lane; i < 512; i += 64) { const int pos = i >> 3, f = i & 7; const float inv = __builtin_amdgcn_exp2f(-(float)f * 1.6609640474436813f);
                const float rev = ((float)pos * inv) * 0.15915494309189535f; R[2 * i] = __builtin_amdgcn_cosf(rev); R[2 * i + 1] = __builtin_amdgcn_sinf(rev); } }
    }
}

__device__ __forceinline__ int mod_of_row(int r) { return r < NCTX ? 0 : 1 + ((r - NCTX) >> 11); }
__device__ __forceinline__ int kvrow_of_row(int r) { return r < NCTX ? r : NCTX + ((r - NCTX) >> 11) * 2304 + 256 + ((r - NCTX) & 2047); }

__device__ __forceinline__ void phase_pre(Ctx& F) {
    unsigned char* ws = F.ws; const int lane = F.lane;
    {
        const float* mod = (const float*)(ws + WS_MOD); const float* g = INP(8); bf16_t* XN = (bf16_t*)(ws + WS_XN); float* SS = (float*)(ws + WS_SUMSQ); const float* x0 = INP(0); const float* x1 = INP(1);
        for (int rbase = F.gw; rbase < MROWS; rbase += 4 * F.NGW) { f32x4 v[4][4];
#pragma unroll
            for (int i = 0; i < 4; ++i) { const int r = min(rbase + i * F.NGW, MROWS - 1); const f32x4* xr = (const f32x4*)(r < NCTX ? x0 + (size_t)r * D : x1 + (size_t)(r - NCTX) * D) + lane;
#pragma unroll
                for (int j = 0; j < 4; ++j) v[i][j] = xr[64 * j]; }
#pragma unroll
            for (int i = 0; i < 4; ++i) { const int r = rbase + i * F.NGW; if (r >= MROWS) break; const float* sc = mod + mod_of_row(r) * 6144 + 1024; float sq = 0.f;
#pragma unroll
                for (int j = 0; j < 4; ++j) { sq += (v[i][j].x * v[i][j].x + v[i][j].y * v[i][j].y) + (v[i][j].z * v[i][j].z + v[i][j].w * v[i][j].w); ((f32x4*)(F.out + (size_t)r * D) + lane)[64 * j] = v[i][j]; }
                sq = wave_sum(sq); if (lane == 0) SS[r] = sq;
#pragma unroll
                for (int j = 0; j < 4; ++j) { const int c = 4 * (64 * j + lane); const f32x4 y = v[i][j] * *(const f32x4*)(g + c) * (*(const f32x4*)(sc + c) + 1.f);
                    *(u32x2*)(XN + (size_t)r * D + c) = (u32x2){cvt_pk_bf16(y.x, y.y), cvt_pk_bf16(y.z, y.w)}; } } }
    }
    {
        float* B = (float*)(ws + WS_BIAS); const float* mod = (const float*)(ws + WS_MOD);
        constexpr int NCH = (WIN_N + 5632) / 16;
        for (int it = F.gw; it < 2 * NCH; it += F.NGW) { const int l = it / NCH, r = (it % NCH) * 16; const int which = r >= WIN_N, n0 = which ? r - WIN_N : r;
            float sh[3][16];
#pragma unroll
            for (int m = 0; m < 3; ++m) { const float* sp = mod + (l * 3 + m) * 6144 + (which ? 3072 : 0) + 16 * lane;
#pragma unroll
                for (int q = 0; q < 4; ++q) { const f32x4 sv = *(const f32x4*)(sp + 4 * q); sh[m][4 * q] = sv.x; sh[m][4 * q + 1] = sv.y; sh[m][4 * q + 2] = sv.z; sh[m][4 * q + 3] = sv.w; } }
            const bf16_t* wbase = (const bf16_t*)(ws + WS_W + (size_t)l * W_LAYER + (which ? W_GU : W_IN)) + (size_t)n0 * 1024 + 16 * lane;
#pragma unroll
            for (int h = 0; h < 2; ++h) { u32x4 w0[8], w1[8];
#pragma unroll
                for (int j = 0; j < 8; ++j) { w0[j] = *(const u32x4*)(wbase + (size_t)(8 * h + j) * 1024); w1[j] = *(const u32x4*)(wbase + (size_t)(8 * h + j) * 1024 + 8); }
#pragma unroll
                for (int j = 0; j < 8; ++j) {
                    const float wf[16] = {bf_lo(w0[j].x), bf_hi(w0[j].x), bf_lo(w0[j].y), bf_hi(w0[j].y), bf_lo(w0[j].z), bf_hi(w0[j].z), bf_lo(w0[j].w), bf_hi(w0[j].w), bf_lo(w1[j].x), bf_hi(w1[j].x), bf_lo(w1[j].y), bf_hi(w1[j].y), bf_lo(w1[j].z), bf_hi(w1[j].z), bf_lo(w1[j].w), bf_hi(w1[j].w)};
                    float a3[3];
#pragma unroll
                    for (int m = 0; m < 3; ++m) { float a = 0.f;
#pragma unroll
                        for (int e = 0; e < 16; ++e) a += sh[m][e] * wf[e];
                        a3[m] = wave_sum(a); }
                    if (lane < 3) B[((l * 2 + which) * 3 + lane) * BIAS_LD + n0 + 8 * h + j] = (lane == 0) ? a3[0] : (lane == 1) ? a3[1] : a3[2]; } }
        }
    }
}


__device__ __forceinline__ void phase_prep(Ctx& F, int l) {
    unsigned char* ws = F.ws; const int lane = F.lane;
    const bf16_t* PROJ = (const bf16_t*)(ws + WS_PROJ);
    bf16_t* QN = (bf16_t*)(ws + WS_XN + XN_QN); bf16_t* CKV = (bf16_t*)(ws + WS_XN + XN_CKV); bf16_t* KR = (bf16_t*)(ws + WS_XN + XN_KR);
    bf16_t* ACAT = (bf16_t*)(ws + WS_ACAT);
    float* out_ckv = F.out + (size_t)MROWS * D; float* out_kr = out_ckv + (size_t)NBC * DEPTH * SEQ * KVL;
    const float* rope = (const float*)(ws + WS_ROPE);
    {
        LAS float* ut = (LAS float*)F.lds;
        LAS float* wl = (LAS float*)(F.lds + 65536);
        const float* wdw = INP(16) + l * 31 * 256; const float* bdw = INP(17) + l * 256; const float* gln = INP(18) + l * 256; const float* bln = INP(19) + l * 256;
        __syncthreads();
        { float wv[16];
#pragma unroll
          for (int i = 0; i < 16; ++i) { const int ix = F.tid + 512 * i; wv[i] = wdw[ix < 31 * 256 ? ix : 0]; }
#pragma unroll
          for (int i = 0; i < 16; ++i) { const int ix = F.tid + 512 * i; if (ix < 31 * 256) wl[ix] = wv[i]; } }
        for (int item = F.bid; item < 256; item += F.G) {
            const int r0 = item * 32; const int s0 = r0 < NCTX ? (r0 & ~255) : NCTX + ((r0 - NCTX) & ~2047); const int s1 = s0 + (r0 < NCTX ? 256 : 2048);
            __syncthreads();
            { const int cp = F.tid & 127, rb = F.tid >> 7; unsigned av[16], bv[16];
#pragma unroll
              for (int i = 0; i < 16; ++i) { const int row = r0 - 15 + rb + 4 * i; const int rc = row < s0 ? s0 : (row >= s1 ? s1 - 1 : row);
                  av[i] = *(const unsigned*)(PROJ + (size_t)rc * PROJ_LD + OFF_CONF + 2 * cp); bv[i] = *(const unsigned*)(PROJ + (size_t)rc * PROJ_LD + OFF_CONF + 256 + 2 * cp); }
#pragma unroll
              for (int i = 0; i < 16; ++i) { const int rr = rb + 4 * i, row = r0 - 15 + rr; const bool ok = row >= s0 && row < s1;
                  const float u0 = ok ? bf_lo(av[i]) * sigmoidf_(bf_lo(bv[i])) : 0.f, u1 = ok ? bf_hi(av[i]) * sigmoidf_(bf_hi(bv[i])) : 0.f;
                  if (rr < 62) { ut[rr * 256 + 2 * cp] = u0; ut[rr * 256 + 2 * cp + 1] = u1; } } }
            __syncthreads();
            float acc[4][4];
#pragma unroll
            for (int q = 0; q < 4; ++q) { const float b = bdw[lane + 64 * q];
#pragma unroll
                for (int ri = 0; ri < 4; ++ri) acc[ri][q] = b; }
            for (int j = 0; j < 31; ++j) {
#pragma unroll
                for (int q = 0; q < 4; ++q) { const float w = wl[j * 256 + lane + 64 * q];
#pragma unroll
                    for (int ri = 0; ri < 4; ++ri) acc[ri][q] += ut[(4 * F.wave + ri + j) * 256 + lane + 64 * q] * w; } }
#pragma unroll
            for (int ri = 0; ri < 4; ++ri) { const float mean = wave_sum(acc[ri][0] + acc[ri][1] + acc[ri][2] + acc[ri][3]) * (1.f / 256.f); float q2 = 0.f;
#pragma unroll
                for (int q = 0; q < 4; ++q) { const float d = acc[ri][q] - mean; q2 += d * d; }
                const float rstd = 1.f / sqrtf(wave_sum(q2) * (1.f / 256.f) + EPS);
#pragma unroll
                for (int q = 0; q < 4; ++q) { const int c = lane + 64 * q; const float y = (acc[ri][q] - mean) * rstd * gln[c] + bln[c]; ACAT[(size_t)(r0 + 4 * F.wave + ri) * ACAT_LD + AC_UC + c] = f2bf(y * sigmoidf_(y)); } }
        }
        __syncthreads();
    }
    const float* gqa = INP(11) + l * QL; const float* gkva = INP(13) + l * KVL; const float* wc3 = INP(21) + l * 3 * 256;
    for (int rbase = F.gw; rbase < MROWS; rbase += 4 * F.NGW) {
        unsigned qa[4][3]; u32x2 kva[4]; bf16_t krv[4]; u32x2 gcv[4][3], xsv[4][3], gbv[4];
#pragma unroll
        for (int i = 0; i < 4; ++i) { const int r = min(rbase + i * F.NGW, MROWS - 1); const bf16_t* pr = PROJ + (size_t)r * PROJ_LD;
            const int s0 = r < NCTX ? (r & ~255) : NCTX + ((r - NCTX) & ~2047); const int s1 = s0 + (r < NCTX ? 256 : 2048);
#pragma unroll
            for (int j = 0; j < 3; ++j) qa[i][j] = *(const unsigned*)(pr + 2 * lane + 128 * j);
            kva[i] = *(const u32x2*)(pr + OFF_KVA + 4 * lane); krv[i] = pr[OFF_KR + (lane & 31)]; gbv[i] = *(const u32x2*)(pr + OFF_SC + 4 * lane);
#pragma unroll
            for (int d = 0; d < 3; ++d) { const int row = r + d - 1; const int rc = row < s0 ? s0 : (row >= s1 ? s1 - 1 : row); const bf16_t* q = PROJ + (size_t)rc * PROJ_LD + OFF_SC;
                gcv[i][d] = *(const u32x2*)(q + 256 + 4 * lane); xsv[i][d] = *(const u32x2*)(q + 512 + 4 * lane); } }
#pragma unroll
        for (int i = 0; i < 4; ++i) { const int r = rbase + i * F.NGW; if (r >= MROWS) break; const int mr = kvrow_of_row(r);
            {
                float v[6]; float sq = 0.f;
#pragma unroll
                for (int j = 0; j < 3; ++j) { v[2 * j] = bf_lo(qa[i][j]); v[2 * j + 1] = bf_hi(qa[i][j]); sq += v[2 * j] * v[2 * j] + v[2 * j + 1] * v[2 * j + 1]; }
                const float rstd = __builtin_amdgcn_rsqf(wave_sum(sq) * (1.f / QL) + EPS);
#pragma unroll
                for (int j = 0; j < 3; ++j) { const int c = 2 * lane + 128 * j; *(unsigned*)(QN + (size_t)r * QL + c) = cvt_pk_bf16(v[2 * j] * rstd * gqa[c], v[2 * j + 1] * rstd * gqa[c + 1]); }
            }
            {
                f32x4 v = {bf_lo(kva[i].x), bf_hi(kva[i].x), bf_lo(kva[i].y), bf_hi(kva[i].y)};
                const float rstd = __builtin_amdgcn_rsqf(wave_sum((v.x * v.x + v.y * v.y) + (v.z * v.z + v.w * v.w)) * (1.f / KVL) + EPS);
                v = v * rstd * *(const f32x4*)(gkva + 4 * lane);
                *(u32x2*)(CKV + (size_t)mr * KVL + 4 * lane) = (u32x2){cvt_pk_bf16(v.x, v.y), cvt_pk_bf16(v.z, v.w)};
                if (r < NCTX) { const int b = r >> 8, t = r & 255; *(f32x4*)(out_ckv + ((size_t)(b * DEPTH + l) * SEQ + t) * KVL + 4 * lane) = v; }
            }
            {
                const float v = bf1(krv[i]);
                if (r < NCTX) { if (lane < 32) { const int b = r >> 8, t = r & 255; out_kr[((size_t)(b * DEPTH + l) * SEQ + t) * QKR + lane] = v; KR[(size_t)mr * QKR + lane] = krv[i]; } }
                else { const int t = (r - NCTX) & 2047, j = lane & 31; const int pos = (j & 16) ? (t & 63) : (t >> 6); const float c = rope[(pos * 8 + (j & 7)) * 2], sn = rope[(pos * 8 + (j & 7)) * 2 + 1];
                    const float p = __shfl_xor(v, 8); const float o = (j & 8) ? (v * c + p * sn) : (v * c - p * sn);
                    if (lane < 32) KR[(size_t)mr * QKR + lane] = f2bf(o); }
            }
            {
                const int s0 = r < NCTX ? (r & ~255) : NCTX + ((r - NCTX) & ~2047); const int s1 = s0 + (r < NCTX ? 256 : 2048);
                f32x4 a = {0.f, 0.f, 0.f, 0.f};
#pragma unroll
                for (int d = 0; d < 3; ++d) { const int row = r + d - 1;
                    if (row >= s0 && row < s1) { const u32x2 gc = gcv[i][d], xs = xsv[i][d]; const f32x4 w = *(const f32x4*)(wc3 + d * 256 + 4 * lane);
                        a.x += w.x * bf_lo(gc.x) * bf_lo(xs.x); a.y += w.y * bf_hi(gc.x) * bf_hi(xs.x); a.z += w.z * bf_lo(gc.y) * bf_lo(xs.y); a.w += w.w * bf_hi(gc.y) * bf_hi(xs.y); } }
                const u32x2 gb = gbv[i];
                *(u32x2*)(ACAT + (size_t)r * ACAT_LD + AC_SC + 4 * lane) = (u32x2){cvt_pk_bf16(a.x * bf_lo(gb.x), a.y * bf_hi(gb.x)), cvt_pk_bf16(a.z * bf_lo(gb.y), a.w * bf_hi(gb.y))};
            }
        }
    }
    const float* cckv = INP(2); const float* ckr = INP(3);
    for (int i = F.gw; i < NBL * PAST; i += F.NGW) { const int b = i >> 8, p = i & 255; const int mr = NCTX + b * 2304 + p;
        const f32x4 v = *(const f32x4*)(cckv + ((size_t)(b * DEPTH + l) * PAST + p) * KVL + 4 * lane);
        *(u32x2*)(CKV + (size_t)mr * KVL + 4 * lane) = (u32x2){cvt_pk_bf16(v.x, v.y), cvt_pk_bf16(v.z, v.w)};
        if (lane < 32) KR[(size_t)mr * QKR + lane] = f2bf(ckr[((size_t)(b * DEPTH + l) * PAST + p) * QKR + lane]); }
    {
        LAS bf16_t* tl = (LAS bf16_t*)(F.lds + F.wave * 16384);
        bf16_t* PQL = (bf16_t*)(ws + WS_PQL); bf16_t* PQC = (bf16_t*)(ws + WS_PQC);
        for (int it = F.gw; it < 128 * 8; it += F.NGW) { const int rc = it >> 3, part = (it >> 2) & 1, cq = it & 3;
            const int col0 = (part ? OFF_GATE : OFF_FN) + cq * 64;
            unsigned uv[32];
#pragma unroll
            for (int i = 0; i < 32; ++i) uv[i] = *(const unsigned*)(PROJ + (size_t)(rc * 64 + 2 * i + (lane >> 5)) * PROJ_LD + col0 + 2 * (lane & 31));
#pragma unroll
            for (int i = 0; i < 32; ++i) { const int t = 2 * i + (lane >> 5), c2 = lane & 31; tl[(2 * c2) * 72 + t] = (bf16_t)(uv[i] & 0xffffu); tl[(2 * c2 + 1) * 72 + t] = (bf16_t)(uv[i] >> 16); }
            LDS_WAIT(); asm volatile("" ::: "memory");
            bf16_t* dst; int ldd;
            if (rc < 64) { const int b = rc >> 2, t0 = (rc & 3) * 64; dst = PQC + ((size_t)b * 256 + cq * 64) * 512 + part * 256 + t0; ldd = 512; }
            else { const int b = (rc - 64) >> 5, t0 = ((rc - 64) & 31) * 64; dst = PQL + ((size_t)b * 256 + cq * 64) * 4096 + part * 2048 + t0; ldd = 4096; }
#pragma unroll
            for (int i = 0; i < 8; ++i) { const int ch = 8 * i + (lane >> 3), t8 = (lane & 7) * 8; const u32x4 v = *(const LAS u32x4*)(tl + ch * 72 + t8); *(u32x4*)(dst + (size_t)ch * ldd + t8) = v; }
            LDS_WAIT(); asm volatile("" ::: "memory");
        }
    }
}

__device__ __forceinline__ void phase_attn(Ctx& F) {
    unsigned char* ws = F.ws;
    {
        const bf16_t* P = (const bf16_t*)(ws + WS_DFTP); bf16_t* Fo = (bf16_t*)(ws + WS_ACAT) + (size_t)NCTX * ACAT_LD + AC_F;
        const int gt = F.gw * 64 + F.lane, NT = F.NGW * 64;
        for (int it = gt; it < NLAT * 32; it += NT) { const int row = it >> 5, c8 = (it & 31) * 8; const int b = row >> 11, k = row & 2047; float sv[8] = {0.f, 0.f, 0.f, 0.f, 0.f, 0.f, 0.f, 0.f};
#pragma unroll
            for (int ks = 0; ks < 8; ++ks) { const u32x4 p = *(const u32x4*)(P + ((size_t)(b * 8 + ks) * 2048 + k) * 256 + c8);
                sv[0] += bf_lo(p.x); sv[1] += bf_hi(p.x); sv[2] += bf_lo(p.y); sv[3] += bf_hi(p.y); sv[4] += bf_lo(p.z); sv[5] += bf_hi(p.z); sv[6] += bf_lo(p.w); sv[7] += bf_hi(p.w); }
            *(u32x4*)(Fo + (size_t)row * ACAT_LD + c8) = (u32x4){cvt_pk_bf16(sv[0], sv[1]), cvt_pk_bf16(sv[2], sv[3]), cvt_pk_bf16(sv[4], sv[5]), cvt_pk_bf16(sv[6], sv[7])}; }
    }
    attn::Tensors T{(const bf16_t*)(ws + WS_PROJ + PJ_Q), (const bf16_t*)(ws + WS_PROJ + PJ_KV), (const bf16_t*)(ws + WS_XN + XN_KR), (bf16_t*)(ws + WS_ACAT)};
    for (int u = F.bid; u < 512; u += F.G) {
        if (u < 256) { const int b = u >> 7, h = (u >> 4) & 7, qb = u & 15;
            attn::unit(T, NCTX + b * 2048 + qb * 128, NCTX + b * 2304, 18, h, (char*)F.lds, F.tid); }
        else { const int v = u - 256; const int b = v >> 4, h = (v >> 1) & 7, qb = v & 1;
            attn::unit(T, b * 256 + qb * 128, b * 256, 2, h, (char*)F.lds, F.tid); }
    }
}

__device__ __forceinline__ void phase_final(Ctx& F) {
    const float* g = INP(28);
    for (int r = F.gw; r < MROWS; r += F.NGW) { f32x4* xr = (f32x4*)(F.out + (size_t)r * D) + F.lane; f32x4 v[4]; float s = 0.f;
#pragma unroll
        for (int j = 0; j < 4; ++j) { v[j] = xr[64 * j]; s += (v[j].x * v[j].x + v[j].y * v[j].y) + (v[j].z * v[j].z + v[j].w * v[j].w); }
        const float rstd = 1.f / sqrtf(wave_sum(s) * (1.f / D) + EPS);
#pragma unroll
        for (int j = 0; j < 4; ++j) xr[64 * j] = v[j] * rstd * *(const f32x4*)(g + 4 * (64 * j + F.lane)); }
}

constexpr int STEPS_PER_LAYER = 8, N_STEPS = 3 + DEPTH * STEPS_PER_LAYER;
__host__ __device__ constexpr bool barrier_after(int s) { return s < N_STEPS - 1; }
__host__ __device__ constexpr int probe_key(int step) { return step == 0 ? 16 : step == 1 ? 18 : step == N_STEPS - 1 ? 17 : (step - 2) % STEPS_PER_LAYER; }

__global__ void __launch_bounds__(512, 2) mk_fwd(Args args) {
    extern __shared__ __attribute__((aligned(16))) unsigned char lds_raw[];
    volatile LAS unsigned* MISC = (volatile LAS unsigned*)((LAS unsigned char*)lds_raw + MISC_OFF);
    if (threadIdx.x < 64) MISC[threadIdx.x] = 0u;
    __syncthreads();
    XcdBarrier bar; bar.bar = (unsigned*)(args.ws + WS_CTL) + 1024; bar.x = 0; bar.st = nullptr;
    if (MK_N_LAUNCHES == 1) bar = xcd_barrier_post((unsigned*)(args.ws + WS_CTL) + 1024, MISC + 8);
    unsigned long long tacc = 0;
    const int wave0 = __builtin_amdgcn_readfirstlane(threadIdx.x >> 6);
    for (int step = args.step_lo; step < args.step_hi; ++step) {
        int btid; { int w0 = wave0; unsigned z = 0u; asm volatile("" : "+s"(w0), "+s"(z)); btid = w0 * 64 + (int)__builtin_amdgcn_mbcnt_hi(~0u, __builtin_amdgcn_mbcnt_lo(~0u, z)); }
        unsigned long long t0_ = 0; if (PROBE_TSTEP >= 0) t0_ = __builtin_amdgcn_s_memrealtime();
        asm volatile("s_waitcnt vmcnt(0) lgkmcnt(0)" ::: "memory");
        const int kprobe = probe_key(step);
        const int nrep = ((PROBE_MASK >> kprobe) & 1) ? 2 : 1;
      for (int rep = 0; rep < nrep; ++rep) {
        unsigned char* ws = args.ws; float* outp = args.out; int tid_; { int w0 = wave0; unsigned z = 0u; asm volatile("" : "+s"(w0), "+s"(z)); tid_ = w0 * 64 + (int)__builtin_amdgcn_mbcnt_hi(~0u, __builtin_amdgcn_mbcnt_lo(~0u, z)); } int bid_ = blockIdx.x;
        { size_t z = 0; asm volatile("" : "+s"(z), "+v"(tid_), "+s"(bid_)); ws = (unsigned char*)((GAS unsigned char*)ws + z); outp = (float*)((GAS float*)outp + z); }
        Ctx F; F.lds = (LAS unsigned char*)lds_raw; F.tid = tid_; F.lane = F.tid & 63; F.wave = __builtin_amdgcn_readfirstlane(F.tid >> 6);
        F.G = gridDim.x; F.gw = bid_ * 8 + F.wave; F.NGW = F.G * 8; F.out = outp; F.ws = ws; F.bid = bid_;
        int ngemm = 0;
        if (step == 0) prologue(F);
        else if (step == 1) phase_pre(F);
        else if (step == N_STEPS - 1) phase_final(F);
        else {
            const int l = (step - 2) / STEPS_PER_LAYER, k = (step - 2) % STEPS_PER_LAYER;
            unsigned char* wl = ws + WS_W + (size_t)l * W_LAYER;
            const float* modl = (const float*)(ws + WS_MOD) + l * 3 * 6144; (void)modl;
            if (k == 1) phase_prep(F, l); else if (k == 3) phase_attn(F); else ngemm = (k == 2) ? 2 : 1;
            for (int r = 0; r < ngemm; ++r) {
                { unsigned char* w2 = F.ws; float* o2 = F.out; { size_t z = 0; asm volatile("" : "+s"(z)); ws = (unsigned char*)((GAS unsigned char*)w2 + z); F.out = (float*)((GAS float*)o2 + z); } wl = ws + WS_W + (size_t)l * W_LAYER; modl = (const float*)(ws + WS_MOD) + l * 3 * 6144; }
                pg8::Job J{}; J.nZ = 1; J.a_lo = J.a_hi = J.b_lo = J.b_hi = 0; J.zso = 0; J.aux = 0; J.ldc = 0; int single = -1;
                if (k == 0) { J.p2 = ws + WS_SUMSQ + (size_t)(2 * l) * MROWS * 4; J.p3 = ws + WS_BIAS + (size_t)(l * 2) * 3 * BIAS_LD * 4; J.A = (const char*)(ws + WS_XN); J.Bt = (const char*)(wl + W_IN); J.lda = 1024; J.ldb = 1024; J.K = 1024; J.nM = 32; J.nN = 26; J.kind = pg8::EK_PROJ; J.o0 = ws + WS_PROJ; J.o1 = ws + WS_GATES; }
                else if (k == 2) {
                    const int L = F.bid + r * F.G; if (L >= 376) continue;
                    if (L < 128) { single = L; J.A = (const char*)(ws + WS_DFTL); J.Bt = (const char*)(ws + WS_PQL); J.lda = 4096; J.ldb = 4096; J.K = 512; J.nM = 8; J.nN = 1; J.nZ = 16; J.kind = pg8::EK_BF16;
                        J.a_lo = 1024; J.b_lo = 1024; J.b_hi = (long)256 * 4096 * 2; J.o0 = ws + WS_DFTP; J.ldc = 256; J.zso = (long)2048 * 256; }
                    else if (L < 144) { single = L - 128; J.A = (const char*)(ws + WS_DFTC); J.Bt = (const char*)(ws + WS_PQC); J.lda = 512; J.ldb = 512; J.K = 512; J.nM = 1; J.nN = 1; J.nZ = 16; J.kind = pg8::EK_BF16;
                        J.b_lo = (long)256 * 512 * 2; J.b_hi = (long)8 * 256 * 512 * 2; J.o0 = ws + WS_ACAT + AC_F * 2; J.ldc = ACAT_LD; J.zso = (long)256 * ACAT_LD; }
                    else if (L < 240) { single = L - 144; J.A = (const char*)(ws + WS_XN + XN_QN); J.Bt = (const char*)(wl + W_QB); J.lda = 384; J.ldb = 384; J.K = 384; J.nM = 32; J.nN = 3; J.kind = pg8::EK_Q;
                        J.o0 = ws + WS_PROJ + PJ_Q; J.p0 = ws + WS_ROPE; }
                    else { single = L - 240; J.A = (const char*)(ws + WS_XN + XN_CKV); J.Bt = (const char*)(wl + W_KVB); J.lda = 256; J.ldb = 256; J.K = 256; J.nM = 34; J.nN = 4; J.kind = pg8::EK_BF16;
                        J.o0 = ws + WS_PROJ + PJ_KV; J.ldc = 1024; }
                }
                else if (k == 4) { J.A = (const char*)(ws + WS_ACAT); J.Bt = (const char*)(wl + W_CAT); J.lda = 1280; J.ldb = 1280; J.K = 1280; J.nM = 64; J.nN = 4; J.hm = 1; J.kind = pg8::EK_MERGE; J.o0 = ws + WS_PROJ + PJ_Q; J.p0 = ws + WS_GATES; }
                else if (k == 5) { J.o1 = ws + WS_XN; J.o2 = ws + WS_SUMSQ + (size_t)(2 * l + 1) * MROWS * 4; J.p2 = INP(9) + l * D; J.p3 = modl + 4096; J.A = (const char*)(ws + WS_PROJ + PJ_Q); J.Bt = (const char*)(wl + W_OUT); J.lda = 1024; J.ldb = 1024; J.K = 1024; J.nM = 64; J.nN = 4; J.hm = 1; J.kind = pg8::EK_RESID; J.o0 = F.out; J.p1 = F.out; J.p0 = modl; J.aux = 2048; }
                else if (k == 6) { J.p2 = ws + WS_SUMSQ + (size_t)(2 * l + 1) * MROWS * 4; J.p3 = ws + WS_BIAS + (size_t)(l * 2 + 1) * 3 * BIAS_LD * 4; J.A = (const char*)(ws + WS_XN); J.Bt = (const char*)(wl + W_GU); J.lda = 1024; J.ldb = 1024; J.K = 1024; J.nM = 32; J.nN = 22; J.kind = pg8::EK_SWIGLU; J.o0 = ws + WS_GATES; }
                else { if (l + 1 < DEPTH) { J.o1 = ws + WS_XN; J.o2 = ws + WS_SUMSQ + (size_t)(2 * l + 2) * MROWS * 4; J.p2 = INP(8) + (l + 1) * D; J.p3 = modl + 3 * 6144 + 1024; } J.A = (const char*)(ws + WS_GATES); J.Bt = (const char*)(wl + W_DN); J.lda = FF; J.ldb = FF; J.K = FF; J.nM = 64; J.nN = 4; J.hm = 1; J.kind = pg8::EK_RESID; J.o0 = F.out; J.p1 = F.out; J.p0 = modl; J.aux = 5120; }
                if (PROBE_MASK != 0 && rep + 1 < nrep && J.kind == pg8::EK_RESID) J.o0 = ws + WS_ACAT;
                if (((PROBE_MASK >> 19) & 1) && rep + 1 < nrep && !J.hm) J.kind = pg8::EK_NONE;
                pg8::Order S; if (single >= 0) S.init_single(J, single); else S.init(J, F.G, F.bid);
                if (J.hm) pg8::gemm_phase_hm(F.lds, J, S, F.tid); else pg8::gemm_phase(F.lds, J, S, F.tid);
            }
        }
      }
        if (step + 1 < args.step_hi && barrier_after(step)) { xcd_barrier(bar, btid); if ((PROBE_MASK >> 18) & 1) xcd_barrier(bar, btid); }
        if (PROBE_TSTEP >= 0) { const int kp = probe_key(step); if (kp == PROBE_TSTEP) tacc += __builtin_amdgcn_s_memrealtime() - t0_; }
    }
    if (PROBE_TSTEP >= 0 && blockIdx.x == 0 && wave0 == 0 && __builtin_amdgcn_mbcnt_lo(~0u, 0u) == 0) { const unsigned long long te = __builtin_amdgcn_s_memrealtime(); while (__builtin_amdgcn_s_memrealtime() - te < 8ull * tacc) __builtin_amdgcn_s_sleep(8); }
}

extern "C" void kernel_launch(void* const* d_in, const int* in_sizes, int n_in, void* d_out, int out_size, void* d_ws, size_t ws_size, hipStream_t stream) {
    static int grid = 0;
    if (grid == 0) {
        if (n_in != 29 || ws_size < WS_END) { fprintf(stderr, "kernel_launch: expected 29 inputs and >= %zu bytes of workspace; got %d, %zu\n", (size_t)WS_END, n_in, ws_size); grid = -1; return; }
        int dev = 0, cus = 0, per_cu = 0;
        if (hipGetDevice(&dev) != hipSuccess || hipDeviceGetAttribute(&cus, hipDeviceAttributeMultiprocessorCount, dev) != hipSuccess) { grid = -1; return; }
        if (hipFuncSetAttribute((const void*)mk_fwd, hipFuncAttributeMaxDynamicSharedMemorySize, LDS_BYTES) != hipSuccess) { fprintf(stderr, "kernel_launch: hipFuncSetAttribute failed\n"); grid = -1; return; }
        if (hipOccupancyMaxActiveBlocksPerMultiprocessor(&per_cu, (const void*)mk_fwd, 512, LDS_BYTES) != hipSuccess || per_cu < 1) fprintf(stderr, "kernel_launch: occupancy query reports %d\n", per_cu);
        (void)hipGetLastError();
        grid = cus;
    }
    if (grid < 0) return;
    (void)hipMemsetAsync((char*)d_ws + WS_CTL, 0, CTL_ZERO_BYTES, stream);
    Args a{};
    for (int i = 0; i < 29; ++i) a.in[i] = (const float*)d_in[i];
    a.out = (float*)d_out; a.ws = (unsigned char*)d_ws;
    if (MK_N_LAUNCHES == 1) { a.step_lo = 0; a.step_hi = N_STEPS; hipLaunchKernelGGL(mk_fwd, dim3(grid), dim3(512), LDS_BYTES, stream, a); }
    else {
        int lo = 0;
        for (int s = 0; s < N_STEPS; ++s) if (barrier_after(s) || s == N_STEPS - 1) { a.step_lo = lo; a.step_hi = s + 1; hipLaunchKernelGGL(mk_fwd, dim3(grid), dim3(512), LDS_BYTES, stream, a); lo = s + 1; }
    }
}
```
